# Optimizing an MI355X kernel written in HIP

```python
import math
import jax, jax.numpy as jnp
from jax import lax
import numpy as np

D_MODEL = 2048
BATCH = 4
SEQ = 4096
DEPTH = 2

GRID_W = 64
CTX_LEN = 256
N_MIXERS = 2
N_ATTN_LAYERS = (DEPTH + N_MIXERS - 1) // N_MIXERS
N_FOURIER_LAYERS = DEPTH // N_MIXERS
HEAD_DIM = 64
VALUE_DIM = 2 * HEAD_DIM
N_HEADS = D_MODEL // VALUE_DIM
Q_WIDTH = N_HEADS * 2 * HEAD_DIM
ATTN_WIDTH = N_HEADS * VALUE_DIM
ATTN_SCALE = HEAD_DIM ** -0.5
Q_BLOCK = 128
ROPE_THETA = 10000.0
ROPE_FREQS = HEAD_DIM // 4
FOURIER_GROUPS = 8
FOURIER_WIDTH = D_MODEL
FOURIER_GROUP_DIM = FOURIER_WIDTH // FOURIER_GROUPS
FFN_HIDDEN = ((8 * D_MODEL // 3 + 255) // 256) * 256
RMS_EPS = 1e-6

kernel_name = 'hybrid_diffattn_fnet_dit_trunk'


def rms_norm(x, g):
    xf = x.astype(jnp.float32)
    y = xf * lax.rsqrt(jnp.mean(xf * xf, axis=-1, keepdims=True) + RMS_EPS)
    return (y * g.astype(jnp.float32)).astype(x.dtype)


def ada_params(cond, w_mod, b_mod):
    m = jax.nn.silu(cond) @ w_mod + b_mod
    return jnp.split(m[..., None, :], 6, axis=-1)


def modulate(h, shift, scale):
    return h * (1.0 + scale) + shift


def axial_rope_tables(n_tokens):
    rows_count = n_tokens // GRID_W
    row = jnp.repeat(jnp.arange(rows_count), GRID_W)
    col = jnp.tile(jnp.arange(GRID_W), rows_count)
    inv_freq = ROPE_THETA ** (-jnp.arange(ROPE_FREQS, dtype=jnp.float32) / ROPE_FREQS)
    ang = jnp.stack([row[:, None] * inv_freq, col[:, None] * inv_freq], axis=1)
    return jnp.cos(ang), jnp.sin(ang)


def apply_axial_rope(x, cos, sin):
    xs = x.reshape(x.shape[:-1] + (2, 2, ROPE_FREQS))
    xa, xb = xs[..., 0, :], xs[..., 1, :]
    c = cos[None, :, None, None].astype(x.dtype)
    s = sin[None, :, None, None].astype(x.dtype)
    out = jnp.stack([xa * c - xb * s, xb * c + xa * s], axis=-2)
    return out.reshape(x.shape)


def diff_attention(h_lat, h_ctx, w_qkv, w_o, lam, subln_g, lambda_init, cos, sin, with_ctx_queries):
    B, N, _ = h_lat.shape
    Lc = h_ctx.shape[1]
    lf = lam.astype(jnp.float32)
    lam_full = jnp.exp(jnp.sum(lf[0] * lf[1])) - jnp.exp(jnp.sum(lf[2] * lf[3])) + lambda_init

    q_l, k_l, v_l = jnp.split(h_lat @ w_qkv, [Q_WIDTH, 2 * Q_WIDTH], axis=-1)
    q_l = apply_axial_rope(q_l.reshape(B, N, N_HEADS, 2, HEAD_DIM), cos, sin)
    k_l = apply_axial_rope(k_l.reshape(B, N, N_HEADS, 2, HEAD_DIM), cos, sin)
    v_l = v_l.reshape(B, N, N_HEADS, VALUE_DIM)
    k_c, v_c = jnp.split(h_ctx @ w_qkv[:, Q_WIDTH:], 2, axis=-1)
    k_c = k_c.reshape(B, Lc, N_HEADS, 2, HEAD_DIM)
    v_c = v_c.reshape(B, Lc, N_HEADS, VALUE_DIM)
    k_all = jnp.concatenate([k_l, k_c], axis=1)
    v_all = jnp.concatenate([v_l, v_c], axis=1)

    def attend(q, k, v):
        s = jnp.einsum('bqhcd,bkhcd->bhcqk', q, k).astype(jnp.float32) * ATTN_SCALE
        p = jax.nn.softmax(s, axis=-1)
        a = (p[:, :, 0] - lam_full * p[:, :, 1]).astype(v.dtype)
        o = jnp.einsum('bhqk,bkhe->bqhe', a, v)
        o = rms_norm(o, subln_g) * (1.0 - lambda_init)
        return o.reshape(o.shape[0], o.shape[1], ATTN_WIDTH)

    n_blocks = N // Q_BLOCK
    q_blocks = q_l.reshape(B, n_blocks, Q_BLOCK, N_HEADS, 2, HEAD_DIM).swapaxes(0, 1)
    o_l = lax.map(lambda qb: attend(qb, k_all, v_all), q_blocks)
    y_l = o_l.swapaxes(0, 1).reshape(B, N, ATTN_WIDTH) @ w_o
    y_c = None
    if with_ctx_queries:
        q_c = (h_ctx @ w_qkv[:, :Q_WIDTH]).reshape(B, Lc, N_HEADS, 2, HEAD_DIM)
        y_c = attend(q_c, k_c, v_c) @ w_o
    return y_l, y_c


def fourier_mix(h, w_in, w_out):
    B, N, _ = h.shape
    u = (h @ w_in).reshape(B, N, FOURIER_GROUPS, FOURIER_GROUP_DIM).astype(jnp.float32)
    f = jnp.fft.fft2(u, axes=(1, 3), norm='ortho').real
    return f.astype(h.dtype).reshape(B, N, FOURIER_WIDTH) @ w_out


def swiglu(h, w_gu, w_down):
    g, u = jnp.split(h @ w_gu, 2, axis=-1)
    return (jax.nn.silu(g) * u) @ w_down


def setup_inputs(seed: int = 0) -> dict:
    key = jax.random.key(seed)
    ks = jax.random.split(key, 16)
    nrm = jax.random.normal
    D = D_MODEL
    return {
        'x': nrm(ks[0], (BATCH, SEQ, D), jnp.float32),
        'c': nrm(ks[1], (BATCH, D), jnp.float32),
        'ctx': nrm(ks[2], (BATCH, CTX_LEN, D), jnp.float32),
        'c_ctx': nrm(ks[3], (D,), jnp.float32),
        'mod_w': nrm(ks[4], (DEPTH, D, 6 * D), jnp.float32) * (0.5 * D ** -0.5),
        'mod_b': 0.01 * nrm(ks[5], (DEPTH, 6 * D), jnp.float32),
        'norm_g': 1.0 + 0.05 * nrm(ks[6], (DEPTH, 4, D), jnp.float32),
        'ffn_w_gu': nrm(ks[7], (DEPTH, D, 2 * FFN_HIDDEN), jnp.float32) * D ** -0.5,
        'ffn_w_down': nrm(ks[8], (DEPTH, FFN_HIDDEN, D), jnp.float32) * FFN_HIDDEN ** -0.5,
        'attn_w_qkv': nrm(ks[9], (N_ATTN_LAYERS, D, 2 * Q_WIDTH + ATTN_WIDTH), jnp.float32) * D ** -0.5,
        'attn_w_o': nrm(ks[10], (N_ATTN_LAYERS, ATTN_WIDTH, D), jnp.float32) * ATTN_WIDTH ** -0.5,
        'attn_lambda': 0.1 * nrm(ks[11], (N_ATTN_LAYERS, 4, HEAD_DIM), jnp.float32),
        'attn_subln_g': 1.0 + 0.05 * nrm(ks[12], (N_ATTN_LAYERS, VALUE_DIM), jnp.float32),
        'four_w_in': nrm(ks[13], (N_FOURIER_LAYERS, D, FOURIER_WIDTH), jnp.float32) * D ** -0.5,
        'four_w_out': nrm(ks[14], (N_FOURIER_LAYERS, FOURIER_WIDTH, D), jnp.float32) * FOURIER_WIDTH ** -0.5,
    }


def reference(x, c, ctx, c_ctx, mod_w, mod_b, norm_g, ffn_w_gu, ffn_w_down, attn_w_qkv, attn_w_o,
              attn_lambda, attn_subln_g, four_w_in, four_w_out):
    n_tokens = x.shape[1]
    cos, sin = axial_rope_tables(n_tokens)
    x_c = ctx
    last_ctx_reader = max(i for i in range(DEPTH) if i % N_MIXERS == 0)
    for i in range(DEPTH):
        j = i // N_MIXERS
        is_attn = (i % N_MIXERS) == 0
        ctx_update = i < last_ctx_reader
        need_h_c = ctx_update or (is_attn and i <= last_ctx_reader)
        g = norm_g[i]
        sh1, sc1, gt1, sh2, sc2, gt2 = ada_params(c, mod_w[i], mod_b[i])
        h_l = modulate(rms_norm(x, g[0]), sh1, sc1)
        if need_h_c:
            csh1, csc1, cgt1, csh2, csc2, cgt2 = ada_params(c_ctx, mod_w[i], mod_b[i])
            h_c = modulate(rms_norm(x_c, g[0]), csh1, csc1)
        if is_attn:
            lambda_init = 0.8 - 0.6 * math.exp(-0.3 * i)
            y_l, y_c = diff_attention(h_l, h_c, attn_w_qkv[j], attn_w_o[j], attn_lambda[j], attn_subln_g[j],
                                      lambda_init, cos, sin, ctx_update)
        else:
            y_l = fourier_mix(h_l, four_w_in[j], four_w_out[j])
            y_c = fourier_mix(h_c, four_w_in[j], four_w_out[j]) if ctx_update else None
        x = x + gt1 * rms_norm(y_l, g[1])
        x = x + gt2 * rms_norm(swiglu(modulate(rms_norm(x, g[2]), sh2, sc2), ffn_w_gu[i], ffn_w_down[i]), g[3])
        if ctx_update:
            x_c = x_c + cgt1 * rms_norm(y_c, g[1])
            x_c = x_c + cgt2 * rms_norm(swiglu(modulate(rms_norm(x_c, g[2]), csh2, csc2), ffn_w_gu[i], ffn_w_down[i]), g[3])
    return x
```

```cpp
#include <hip/hip_runtime.h>
#include <hip/hip_cooperative_groups.h>
#include <cstdio>
#include <cstdint>
namespace cg = cooperative_groups;

#define LAS __attribute__((address_space(3)))
typedef unsigned short bf16_t;
typedef short bf16x8 __attribute__((ext_vector_type(8)));
typedef short s16x4 __attribute__((ext_vector_type(4)));
typedef float f32x4 __attribute__((ext_vector_type(4)));
typedef float f32x2 __attribute__((ext_vector_type(2)));
typedef float f32x16 __attribute__((ext_vector_type(16)));
typedef unsigned u32x4 __attribute__((ext_vector_type(4)));
typedef unsigned u32x2 __attribute__((ext_vector_type(2)));

constexpr int D = 2048, NB = 4, SEQ = 4096, M = NB * SEQ, LC = 256, MC = NB * LC, MT = M + MC;
constexpr int NH = 16, HD = 64, VD = 128, NQKV = 6144, FF = 5632, NGU = 2 * FF, SK = SEQ + LC;
constexpr float RMS_EPS = 1e-6f;
constexpr float QSCALE = 0.125f * 1.4426950408889634f;

constexpr size_t MiB = 1u << 20;
constexpr size_t WS_ADA = 1 * MiB;
constexpr size_t WS_ROPE = 1 * MiB + 768 * 1024;
constexpr size_t WS_CS = 1 * MiB + 800 * 1024;
constexpr size_t WS_WQKV = 3 * MiB;
constexpr size_t WS_WO = 27 * MiB;
constexpr size_t WS_WIN = 35 * MiB;
constexpr size_t WS_WOUT = 43 * MiB;
constexpr size_t WS_WGU = 51 * MiB;
constexpr size_t WS_WDN = 139 * MiB;
constexpr size_t WS_HB = 183 * MiB;
constexpr size_t WS_YB = 251 * MiB;
constexpr size_t WS_R = 315 * MiB;
constexpr size_t WS_Q = WS_R;
constexpr size_t WS_K = WS_R + 64 * MiB;
constexpr size_t WS_V = WS_R + 132 * MiB;
constexpr size_t WS_O = WS_R + 200 * MiB;
constexpr size_t WS_HID = WS_R;
constexpr size_t WS_U = WS_R + 200 * MiB;
constexpr size_t WS_YT = WS_R;
constexpr size_t WS_F = WS_R + 128 * MiB;
constexpr size_t WS_CSN = WS_R + 264 * MiB;
constexpr size_t WS_END = WS_R + 328 * MiB;

constexpr int LDS_BYTES = 147456;

__device__ __forceinline__ unsigned cvt_pk_bf16(float lo, float hi) { unsigned r; asm volatile("v_cvt_pk_bf16_f32 %0, %1, %2" : "=v"(r) : "v"(lo), "v"(hi)); return r; }
__device__ __forceinline__ float bf2f(unsigned short b) { return __uint_as_float(((unsigned)b) << 16); }
__device__ __forceinline__ float bflo(unsigned w) { return __uint_as_float(w << 16); }
__device__ __forceinline__ float bfhi(unsigned w) { return __uint_as_float(w & 0xffff0000u); }
__device__ __forceinline__ float wave_sum(float v) {
#pragma unroll
    for (int o = 1; o < 64; o <<= 1) v += __shfl_xor(v, o);
    return v;
}
__device__ __forceinline__ float silu_f(float v) { return v / (1.f + __expf(-v)); }

namespace pg8 {
constexpr int BM = 256, BK = 64, HALF = 128, HTB = HALF * BK * 2, NXCD = 8, WGM = 8;
__host__ __device__ __forceinline__ int lds_byte(int r, int c) { const int st = (r >> 4) * 2 + (c >> 5), rr = r & 15, cc = c & 31, ob = rr * 64 + cc * 2; return st * 1024 + (ob ^ (((ob >> 9) & 1) << 5)); }
__host__ __device__ __forceinline__ void stage_rc(int b, int& R, int& C) { const int st = b / 1024, sb = b % 1024, swz = sb ^ (((sb >> 9) & 1) << 5); R = (st >> 1) * 16 + swz / 64; C = (st & 1) * 32 + (swz % 64) / 2; }
__host__ __device__ __forceinline__ int perm32(int rho) { const int n = rho >> 4, i = rho & 15; return 8 * (i >> 2) + 4 * n + (i & 3); }

struct Unit { int pm, pn; size_t aoff, boff, coff; };
struct Gemm { const bf16_t* A; const bf16_t* Bt; int lda, ldb, K; };

__device__ __forceinline__ void swz_order(int L, int nM, int nN, int& pm, int& pn) {
    const int nwg = nM * nN; int wgid = L;
    { const int q = nwg / NXCD, r = nwg % NXCD, xcd = wgid % NXCD, off = wgid / NXCD; wgid = (xcd < r ? xcd * (q + 1) : r * (q + 1) + (xcd - r) * q) + off; }
    const int nig = WGM * nN, gid = wgid / nig, fm = gid * WGM, gsz = (nM - fm) < WGM ? (nM - fm) : WGM;
    pm = fm + ((wgid % nig) % gsz); pn = (wgid % nig) / gsz;
}

template <class Epi, class Sched>
__device__ __forceinline__ void gemm_phase(LAS unsigned char* lds, const Gemm g, const Sched& S, const Epi& E) {
    int tid = threadIdx.x; asm volatile("" : "+v"(tid));
    const int wid = __builtin_amdgcn_readfirstlane(tid >> 6), lane = tid & 63, wr = wid >> 2, wc = wid & 3, fr = lane & 15, fq = lane >> 4;
    const int nt = g.K / BK;
    unsigned voffA[2], voffB[2];
#pragma unroll
    for (int i = 0; i < 2; ++i) { int R, C; stage_rc(tid * 16 + i * 8192, R, C); const int Rb = (R & ~31) + perm32(R & 31);
        voffA[i] = (unsigned)(R * g.lda + C) * 2u; voffB[i] = (unsigned)(Rb * g.ldb + C) * 2u; }
    const size_t kstep = (size_t)(BK * 2);
    const size_t hstepA = (size_t)HALF * g.lda * 2, hstepB = (size_t)HALF * g.ldb * 2;
    const unsigned ldsw = (unsigned)wid * 1024u;
    const int aoff = lds_byte(wr * 64 + fr, fq * 8), boff = lds_byte(wc * 32 + fr, fq * 8);
#define PG8_SA(b, h) (((b) * 2 + (h)) * HTB)
#define PG8_SB(b, h) ((4 + (b) * 2 + (h)) * HTB)
#define PG8_STAGE(bufoff, gbase, voff) do { _Pragma("unroll") for (int _i = 0; _i < 2; ++_i) \
        __builtin_amdgcn_global_load_lds((const unsigned*)((const char*)(gbase) + (voff)[_i]), (LAS unsigned*)(lds + (bufoff) + ldsw + _i * 8192), 16, 0, 0); } while (0)
#define PG8_LDA(dst, b, h) do { _Pragma("unroll") for (int m = 0; m < 4; ++m) _Pragma("unroll") for (int k = 0; k < 2; ++k) dst[m][k] = *(const LAS bf16x8*)(lds + PG8_SA(b, h) + aoff + m * 2048 + k * 1024); } while (0)
#define PG8_LDB(dst, b, h) do { _Pragma("unroll") for (int n = 0; n < 2; ++n) _Pragma("unroll") for (int k = 0; k < 2; ++k) dst[n][k] = *(const LAS bf16x8*)(lds + PG8_SB(b, h) + boff + n * 2048 + k * 1024); } while (0)
#define PG8_MMA(ai, bj, At, Bt) do { __builtin_amdgcn_s_setprio(1); _Pragma("unroll") for (int m = 0; m < 4; ++m) _Pragma("unroll") for (int n = 0; n < 2; ++n) _Pragma("unroll") for (int k = 0; k < 2; ++k) \
        acc[ai][bj][m][n] = __builtin_amdgcn_mfma_f32_16x16x32_bf16(Bt[n][k], At[m][k], acc[ai][bj][m][n], 0, 0, 0); __builtin_amdgcn_s_setprio(0); } while (0)
#define PG8_WAIT_V(n) asm volatile("s_waitcnt vmcnt(" #n ")" ::: "memory")
#define PG8_WAIT_L(n) asm volatile("s_waitcnt lgkmcnt(" #n ")" ::: "memory")
#define PG8_BAR __builtin_amdgcn_s_barrier()
#define PG8_SCHED __builtin_amdgcn_sched_barrier(0)
    Unit cur, nxt; int ui = 0;
    if (!S.next(0, cur)) return;
    f32x4 acc[2][2][4][2];
#pragma unroll
    for (int a = 0; a < 2; ++a)
#pragma unroll
        for (int b = 0; b < 2; ++b)
#pragma unroll
            for (int m = 0; m < 4; ++m)
#pragma unroll
                for (int n = 0; n < 2; ++n) acc[a][b][m][n] = (f32x4){0.f, 0.f, 0.f, 0.f};
    bf16x8 At[4][2], B0[2][2], B1[2][2];
    const char* cA = (const char*)g.A + cur.aoff; const char* cB = (const char*)g.Bt + cur.boff;
    PG8_STAGE(PG8_SB(0, 0), cB, voffB); PG8_STAGE(PG8_SB(0, 1), cB + hstepB, voffB); PG8_STAGE(PG8_SA(0, 0), cA, voffA); PG8_STAGE(PG8_SA(0, 1), cA + hstepA, voffA);
    if (wr == 1) PG8_BAR;
    PG8_WAIT_V(2); PG8_BAR;
    PG8_STAGE(PG8_SB(1, 0), cB + kstep, voffB); PG8_STAGE(PG8_SA(1, 0), cA + kstep, voffA); PG8_STAGE(PG8_SB(1, 1), cB + hstepB + kstep, voffB);
    PG8_WAIT_V(6); PG8_BAR;
    for (;;) {
        const bool has_next = S.next(ui + 1, nxt);
        const char* nA = has_next ? (const char*)g.A + nxt.aoff : cA; const char* nB = has_next ? (const char*)g.Bt + nxt.boff : cB;
        for (int t = 0; t < nt; t += 2) {
            const bool last = (t == nt - 2);
            const char* a1 = cA + (size_t)(t + 1) * kstep;
            const char* a2 = last ? nA : cA + (size_t)(t + 2) * kstep; const char* b2 = last ? nB : cB + (size_t)(t + 2) * kstep;
            const char* a3 = a2 + kstep; const char* b3 = b2 + kstep;
            PG8_LDB(B0, 0, 0); PG8_LDB(B1, 0, 1); PG8_SCHED; PG8_LDA(At, 0, 0); PG8_STAGE(PG8_SA(1, 1), a1 + hstepA, voffA);
            PG8_WAIT_V(8); PG8_WAIT_L(0); PG8_BAR; PG8_MMA(0, 0, At, B0); PG8_MMA(0, 1, At, B1); PG8_BAR; PG8_SCHED;
            PG8_LDA(At, 0, 1); PG8_STAGE(PG8_SB(0, 0), b2, voffB); PG8_STAGE(PG8_SB(0, 1), b2 + hstepB, voffB); PG8_STAGE(PG8_SA(0, 0), a2, voffA);
            PG8_WAIT_V(8); PG8_WAIT_L(0); PG8_BAR; PG8_MMA(1, 0, At, B0); PG8_MMA(1, 1, At, B1); PG8_BAR; PG8_SCHED;
            PG8_LDB(B0, 1, 0); PG8_LDB(B1, 1, 1); PG8_SCHED; PG8_LDA(At, 1, 0); PG8_STAGE(PG8_SA(0, 1), a2 + hstepA, voffA);
            PG8_WAIT_V(8); PG8_WAIT_L(0); PG8_BAR; PG8_MMA(0, 0, At, B0); PG8_MMA(0, 1, At, B1); PG8_BAR; PG8_SCHED;
            PG8_LDA(At, 1, 1); PG8_STAGE(PG8_SB(1, 0), b3, voffB); PG8_STAGE(PG8_SB(1, 1), b3 + hstepB, voffB); PG8_STAGE(PG8_SA(1, 0), a3, voffA);
            PG8_WAIT_V(8); PG8_WAIT_L(0); PG8_BAR; PG8_MMA(1, 0, At, B0); PG8_MMA(1, 1, At, B1); PG8_BAR; PG8_SCHED;
        }
        if (wr == 0) PG8_BAR;
        E(acc, cur, wr, wc, fr, fq);
        if (!has_next) break;
#pragma unroll
        for (int a = 0; a < 2; ++a)
#pragma unroll
            for (int b = 0; b < 2; ++b)
#pragma unroll
                for (int m = 0; m < 4; ++m)
#pragma unroll
                    for (int n = 0; n < 2; ++n) acc[a][b][m][n] = (f32x4){0.f, 0.f, 0.f, 0.f};
        cur = nxt; cA = nA; cB = nB; ++ui;
        if (wr == 1) PG8_BAR;
    }
    PG8_WAIT_V(0);
    PG8_BAR;
#undef PG8_SA
#undef PG8_SB
#undef PG8_STAGE
#undef PG8_LDA
#undef PG8_LDB
#undef PG8_MMA
#undef PG8_WAIT_V
#undef PG8_WAIT_L
#undef PG8_BAR
#undef PG8_SCHED
}

struct SchedStd {
    int nM, nN, G, c, lda, ldb, ldc;
    __device__ __forceinline__ bool next(int i, Unit& u) const {
        const int L = i * G + c; if (L >= nM * nN) return false;
        swz_order(L, nM, nN, u.pm, u.pn);
        u.aoff = (size_t)u.pm * BM * lda * 2; u.boff = (size_t)u.pn * BM * ldb * 2; u.coff = (size_t)u.pm * BM * ldc + (size_t)u.pn * BM; return true;
    }
};
struct SchedQKV {
    int G, c;
    __device__ __forceinline__ bool next(int i, Unit& u) const {
        const int L = i * G + c; if (L >= 1536 + 64) return false;
        if (L < 1536) swz_order(L, 64, 24, u.pm, u.pn); else { const int l2 = L - 1536; u.pm = 64 + (l2 & 3); u.pn = 8 + (l2 >> 2); }
        u.aoff = (size_t)u.pm * BM * D * 2; u.boff = (size_t)u.pn * BM * D * 2; u.coff = 0; return true;
    }
};
struct SchedDft1 {
    int G, c;
    __device__ __forceinline__ bool next(int i, Unit& u) const {
        const int L = i * G + c; if (L >= 1024) return false;
        const int b = L >> 8, rem = L & 255, gq = rem >> 5, part = (rem >> 4) & 1, pn = rem & 15;
        u.pm = part; u.pn = pn;
        u.aoff = (size_t)part * 256 * 256 * 2; u.boff = ((size_t)(b * SEQ + pn * 256) * D + gq * 256) * 2;
        u.coff = ((size_t)(b * D + gq * 256) * 2 + part) * SEQ + pn * 256; return true;
    }
};
struct SchedDft2 {
    int G, c;
    __device__ __forceinline__ bool next(int i, Unit& u) const {
        const int L = i * G + c; if (L >= 512) return false;
        const int b = L >> 7; swz_order(L & 127, 16, 8, u.pm, u.pn);
        u.aoff = (size_t)u.pm * 256 * 8192 * 2; u.boff = (size_t)(b * D + u.pn * 256) * 8192 * 2;
        u.coff = (size_t)(b * SEQ + u.pm * 256) * D + u.pn * 256; return true;
    }
};

struct EpiPlain {
    bf16_t* O; int ldc;
    __device__ __forceinline__ void operator()(const f32x4 (&acc)[2][2][4][2], const Unit& u, int wr, int wc, int fr, int fq) const {
        bf16_t* base = O + u.coff + (size_t)(wr * 64 + fr) * ldc + wc * 32 + 8 * fq;
#pragma unroll
        for (int ai = 0; ai < 2; ++ai)
#pragma unroll
            for (int m = 0; m < 4; ++m) { bf16_t* rowp = base + (size_t)(ai * HALF + m * 16) * ldc;
#pragma unroll
                for (int bj = 0; bj < 2; ++bj) { const f32x4 v0 = acc[ai][bj][m][0], v1 = acc[ai][bj][m][1];
                    u32x4 w; w.x = cvt_pk_bf16(v0[0], v0[1]); w.y = cvt_pk_bf16(v0[2], v0[3]); w.z = cvt_pk_bf16(v1[0], v1[1]); w.w = cvt_pk_bf16(v1[2], v1[3]);
                    *(u32x4*)(rowp + bj * HALF) = w; } }
    }
};
struct EpiSwiGLU {
    bf16_t* O;
    __device__ __forceinline__ void operator()(const f32x4 (&acc)[2][2][4][2], const Unit& u, int wr, int wc, int fr, int fq) const {
        bf16_t* base = O + (size_t)(u.pm * BM + wr * 64 + fr) * FF + u.pn * 128 + wc * 32 + 8 * fq;
#pragma unroll
        for (int ai = 0; ai < 2; ++ai)
#pragma unroll
            for (int m = 0; m < 4; ++m) { bf16_t* rowp = base + (size_t)(ai * HALF + m * 16) * FF;
                float o[8];
#pragma unroll
                for (int n = 0; n < 2; ++n)
#pragma unroll
                    for (int j = 0; j < 4; ++j) { const float gv = acc[ai][0][m][n][j], uv = acc[ai][1][m][n][j];
                        o[n * 4 + j] = gv * uv * __builtin_amdgcn_rcpf(1.f + __builtin_amdgcn_exp2f(-1.4426950408889634f * gv)); }
                u32x4 w; w.x = cvt_pk_bf16(o[0], o[1]); w.y = cvt_pk_bf16(o[2], o[3]); w.z = cvt_pk_bf16(o[4], o[5]); w.w = cvt_pk_bf16(o[6], o[7]);
                *(u32x4*)rowp = w; }
    }
};
struct EpiQKV {
    bf16_t *Q, *K, *V; const float* rope;
    __device__ __forceinline__ void operator()(const f32x4 (&acc)[2][2][4][2], const Unit& u, int wr, int wc, int fr, int fq) const {
        const int sec = u.pn >> 3, h0 = (u.pn & 7) * 2;
        const bool latent = u.pm < 64;
        const int b = latent ? (u.pm >> 4) : (u.pm - 64);
        const int tok0 = (latent ? (u.pm & 15) * 256 : SEQ) + wr * 64 + fr;
        const int cm = wc >> 1, axis = wc & 1;
#pragma unroll
        for (int ai = 0; ai < 2; ++ai)
#pragma unroll
            for (int m = 0; m < 4; ++m) {
                const int tok = tok0 + ai * HALF + m * 16;
                f32x4 c4 = {1.f, 1.f, 1.f, 1.f}, s4 = {0.f, 0.f, 0.f, 0.f};
                if (sec < 2 && latent) { const int pos = axis ? (tok & 63) : (tok >> 6); c4 = *(const f32x4*)(rope + pos * 16 + 4 * fq); s4 = *(const f32x4*)(rope + 1024 + pos * 16 + 4 * fq); }
#pragma unroll
                for (int bj = 0; bj < 2; ++bj) {
                    const int h = h0 + bj;
                    f32x4 v0 = acc[ai][bj][m][0], v1 = acc[ai][bj][m][1];
                    bf16_t* dst;
                    if (sec < 2) {
                        const f32x4 a = v0 * c4 - v1 * s4, bb = v1 * c4 + v0 * s4; v0 = a; v1 = bb;
                        if (sec == 0) { v0 = v0 * QSCALE; v1 = v1 * QSCALE; dst = Q + ((size_t)(((b * NH + h) * 2 + cm) * SEQ + tok)) * HD + axis * 32 + 8 * fq; }
                        else dst = K + ((size_t)(((b * NH + h) * 2 + cm) * SK + tok)) * HD + axis * 32 + 8 * fq;
                    } else dst = V + ((size_t)((b * NH + h) * SK + tok)) * VD + wc * 32 + 8 * fq;
                    u32x4 w; w.x = cvt_pk_bf16(v0[0], v0[1]); w.y = cvt_pk_bf16(v0[2], v0[3]); w.z = cvt_pk_bf16(v1[0], v1[1]); w.w = cvt_pk_bf16(v1[2], v1[3]);
                    *(u32x4*)dst = w;
                }
            }
    }
};
}

namespace att {
constexpr int NT = SK / 64;
constexpr int STG = 32768;
constexpr int XCH = 0, OST = 65536, SUBG = 120 * 1024, LAMO = SUBG + 512;
__device__ __forceinline__ int crow(int r, int hi) { return (r & 3) + 8 * (r >> 2) + 4 * hi; }
__device__ __forceinline__ float xhalf(float v) { return __shfl_xor(v, 32); }

__device__ __forceinline__ void attn_unit(int b, int h, int qb, const bf16_t* Q, const bf16_t* K, const bf16_t* V, bf16_t* O, LAS unsigned char* lds) {
    int tid = threadIdx.x; asm volatile("" : "+v"(tid));
    const int lane = tid & 63, r32 = lane & 31, hi = lane >> 5; const int wid = __builtin_amdgcn_readfirstlane(tid >> 6);
    const int cm = wid >> 2, wq = wid & 3;
    const bf16_t* Qp = Q + ((size_t)(((b * NH + h) * 2 + cm) * SEQ + qb * 128 + wq * 32 + r32)) * HD + hi * 8;
    const bf16_t* K0g = K + ((size_t)((b * NH + h) * 2) * SK) * HD + (size_t)(tid & 63) * HD + (tid >> 6) * 8;
    const bf16_t* K1g = K0g + (size_t)SK * HD;
    const bf16_t* Vg = V + (size_t)((b * NH + h) * SK) * VD;
    const bf16_t* Vg0 = Vg + (size_t)((((tid >> 6) & 3) * 16) + ((tid >> 2) & 15)) * VD + (tid >> 8) * 32 + (tid & 3) * 8;
    const bf16_t* Vg1 = Vg0 + 64;
    bf16x8 qr[4];
#pragma unroll
    for (int d0 = 0; d0 < 4; ++d0) qr[d0] = *(const bf16x8*)(Qp + d0 * 16);
    u32x4 sk0, sk1, sv0, sv1;
    sk0 = *(const u32x4*)K0g; sk1 = *(const u32x4*)K1g; sv0 = *(const u32x4*)Vg0; sv1 = *(const u32x4*)Vg1;
    *(LAS u32x4*)(lds + tid * 16) = sk0; *(LAS u32x4*)(lds + 8192 + tid * 16) = sk1;
    *(LAS u32x4*)(lds + 16384 + tid * 16) = sv0; *(LAS u32x4*)(lds + 16384 + 8192 + tid * 16) = sv1;
    f32x16 o[4];
#pragma unroll
    for (int e = 0; e < 4; ++e) o[e] = (f32x16){};
    float mrun = -1e30f, lsum = 0.f;
    const int kro = cm * 8192 + hi * 1024 + r32 * 16;
    const int vro = 16384 + ((lane >> 4) & 1) * 32 + (lane & 3) * 8 + (4 * hi + ((lane & 15) >> 2)) * 64;
    __syncthreads();
    for (int t = 0; t < NT; ++t) {
        LAS unsigned char* st = lds + (t & 1) * STG;
        if (t + 1 < NT) { const size_t ko = (size_t)(t + 1) * 64 * HD, vo = (size_t)(t + 1) * 64 * VD;
            sk0 = *(const u32x4*)(K0g + ko); sk1 = *(const u32x4*)(K1g + ko); sv0 = *(const u32x4*)(Vg0 + vo); sv1 = *(const u32x4*)(Vg1 + vo); }
        f32x16 p0 = (f32x16){}, p1 = (f32x16){};
#pragma unroll
        for (int d0 = 0; d0 < 4; ++d0) {
            const bf16x8 k0 = *(const LAS bf16x8*)(st + kro + d0 * 2048);
            const bf16x8 k1 = *(const LAS bf16x8*)(st + kro + d0 * 2048 + 512);
            p0 = __builtin_amdgcn_mfma_f32_32x32x16_bf16(k0, qr[d0], p0, 0, 0, 0);
            p1 = __builtin_amdgcn_mfma_f32_32x32x16_bf16(k1, qr[d0], p1, 0, 0, 0);
        }
        float mx = fmaxf(p0[0], p1[0]);
#pragma unroll
        for (int i = 1; i < 16; ++i) mx = fmaxf(mx, fmaxf(p0[i], p1[i]));
        mx = fmaxf(mx, xhalf(mx));
        if (__any(mx > mrun)) {
            const float mn = fmaxf(mrun, mx), al = __builtin_amdgcn_exp2f(mrun - mn);
            mrun = mn; lsum *= al;
#pragma unroll
            for (int e = 0; e < 4; ++e)
#pragma unroll
                for (int i = 0; i < 16; ++i) o[e][i] *= al;
        }
        float ls = 0.f;
#pragma unroll
        for (int i = 0; i < 16; ++i) { p0[i] = __builtin_amdgcn_exp2f(p0[i] - mrun); p1[i] = __builtin_amdgcn_exp2f(p1[i] - mrun); ls += p0[i] + p1[i]; }
        lsum += ls;
        bf16x8 pa[4];
#pragma unroll
        for (int s = 0; s < 2; ++s) {
            u32x4 w0, w1;
            w0.x = cvt_pk_bf16(p0[8 * s + 0], p0[8 * s + 1]); w0.y = cvt_pk_bf16(p0[8 * s + 2], p0[8 * s + 3]); w0.z = cvt_pk_bf16(p0[8 * s + 4], p0[8 * s + 5]); w0.w = cvt_pk_bf16(p0[8 * s + 6], p0[8 * s + 7]);
            w1.x = cvt_pk_bf16(p1[8 * s + 0], p1[8 * s + 1]); w1.y = cvt_pk_bf16(p1[8 * s + 2], p1[8 * s + 3]); w1.z = cvt_pk_bf16(p1[8 * s + 4], p1[8 * s + 5]); w1.w = cvt_pk_bf16(p1[8 * s + 6], p1[8 * s + 7]);
            pa[s] = __builtin_bit_cast(bf16x8, w0); pa[2 + s] = __builtin_bit_cast(bf16x8, w1);
        }
#pragma unroll
        for (int eb = 0; eb < 4; ++eb)
#pragma unroll
            for (int ks = 0; ks < 4; ++ks) {
                const s16x4 lo = __builtin_bit_cast(s16x4, __builtin_amdgcn_ds_read_tr16_b64_v4i16((LAS s16x4*)(st + vro + eb * 4096 + ks * 1024)));
                const s16x4 hh = __builtin_bit_cast(s16x4, __builtin_amdgcn_ds_read_tr16_b64_v4i16((LAS s16x4*)(st + vro + eb * 4096 + ks * 1024 + 512)));
                const bf16x8 vf = (bf16x8){lo[0], lo[1], lo[2], lo[3], hh[0], hh[1], hh[2], hh[3]};
                o[eb] = __builtin_amdgcn_mfma_f32_32x32x16_bf16(vf, pa[ks], o[eb], 0, 0, 0);
            }
        if (t + 1 < NT) { LAS unsigned char* sn = lds + ((t + 1) & 1) * STG;
            *(LAS u32x4*)(sn + tid * 16) = sk0; *(LAS u32x4*)(sn + 8192 + tid * 16) = sk1;
            *(LAS u32x4*)(sn + 16384 + tid * 16) = sv0; *(LAS u32x4*)(sn + 16384 + 8192 + tid * 16) = sv1; }
        __syncthreads();
    }
    const float linv = 1.f / (lsum + xhalf(lsum));
    LAS float* xch = (LAS float*)(lds + XCH) + wq * 64 * 64 + lane;
    if (cm == 1) {
#pragma unroll
        for (int e = 0; e < 4; ++e)
#pragma unroll
            for (int i = 0; i < 16; ++i) xch[(e * 16 + i) * 64] = o[e][i] * linv;
    }
    __syncthreads();
    if (cm == 0) {
        const float lam = *(const LAS float*)(lds + LAMO);
        float ss = 0.f;
#pragma unroll
        for (int e = 0; e < 4; ++e)
#pragma unroll
            for (int i = 0; i < 16; ++i) { const float v = o[e][i] * linv - lam * xch[(e * 16 + i) * 64]; o[e][i] = v; ss += v * v; }
        ss += xhalf(ss);
        const float rn = __builtin_amdgcn_rsqf(ss * (1.f / VD) + RMS_EPS);
        const LAS float* sg = (const LAS float*)(lds + SUBG);
        LAS unsigned char* stg = lds + OST + wq * (32 * 272);
#pragma unroll
        for (int e = 0; e < 4; ++e)
#pragma unroll
            for (int i4 = 0; i4 < 4; ++i4) { const int e0 = 32 * e + 8 * i4 + 4 * hi;
                const f32x4 g4 = *(const LAS f32x4*)(sg + e0);
                u32x2 w; w.x = cvt_pk_bf16(o[e][4 * i4] * rn * g4[0], o[e][4 * i4 + 1] * rn * g4[1]); w.y = cvt_pk_bf16(o[e][4 * i4 + 2] * rn * g4[2], o[e][4 * i4 + 3] * rn * g4[3]);
                *(LAS u32x2*)(stg + r32 * 272 + e0 * 2) = w; }
        asm volatile("s_waitcnt lgkmcnt(0)" ::: "memory");
        bf16_t* Ow = O + ((size_t)(b * SEQ + qb * 128 + wq * 32)) * D + h * VD;
#pragma unroll
        for (int it = 0; it < 8; ++it) { const int id = it * 64 + lane, row = id >> 4, ch = id & 15;
            const u32x4 v = *(const LAS u32x4*)(stg + row * 272 + ch * 16);
            *(u32x4*)(Ow + (size_t)row * D + ch * 8) = v; }
    }
    __syncthreads();
}
}

#ifndef PH_MASK
#define PH_MASK 0xFFFFFFu
#endif
#define PH(k) if constexpr ((PH_MASK >> (k)) & 1u)
struct Args {
    const float *x, *c, *ctx, *c_ctx, *mod_w, *mod_b, *norm_g, *w_gu, *w_dn, *w_qkv, *w_o, *lam, *subg, *w_in, *w_out;
    float* out; unsigned char* ws;
};

__device__ __forceinline__ void transpose_item(const float* W, int K, int Nsrc, int Ndst, bf16_t* WT, int mode, LAS float* scr, int item, int lane) {
    const int nblk = Ndst / 32, kb = item / nblk, nb = item % nblk, k0 = 64 * kb, n0 = 32 * nb, i = lane & 31;
    int src;
    if (mode == 1 && n0 < 4096) src = n0 + ((i >> 2) & 1) * 16 + ((i >> 3) & 3) * 4 + (i & 3);
    else if (mode == 2) { const int tile = n0 >> 8, r0 = n0 & 255; src = (r0 < 128 ? tile * 128 + r0 : FF + tile * 128 + r0 - 128) + i; }
    else src = n0 + i;
#pragma unroll 8
    for (int q = 0; q < 32; ++q) { const int kk = 2 * q + (lane >> 5); scr[kk * 33 + i] = W[(size_t)(k0 + kk) * Nsrc + src]; }
    asm volatile("s_waitcnt lgkmcnt(0)" ::: "memory");
    const int c = lane & 7;
#pragma unroll
    for (int j = 0; j < 4; ++j) { const int n = (lane >> 3) + 8 * j; const LAS float* s = scr + (8 * c) * 33 + n;
        u32x4 o; o.x = cvt_pk_bf16(s[0 * 33], s[1 * 33]); o.y = cvt_pk_bf16(s[2 * 33], s[3 * 33]); o.z = cvt_pk_bf16(s[4 * 33], s[5 * 33]); o.w = cvt_pk_bf16(s[6 * 33], s[7 * 33]);
        *(u32x4*)(WT + (size_t)(n0 + n) * K + k0 + 8 * c) = o; }
    asm volatile("s_waitcnt lgkmcnt(0)" ::: "memory");
}

__device__ __forceinline__ void row_op(int lane, const bf16_t* y, const float* xin, const float* gate, const float* gy, float* xout,
                                       const float* gh, const float* sh, const float* sc, bf16_t* hb) {
    asm volatile("" : "+v"(lane));
    f32x4 v[8];
#pragma unroll
    for (int j = 0; j < 8; ++j) v[j] = *(const f32x4*)(xin + j * 256 + lane * 4);
    if (y) {
        u32x2 yw[8]; float ss = 0.f;
#pragma unroll
        for (int j = 0; j < 8; ++j) { yw[j] = *(const u32x2*)(y + j * 256 + lane * 4);
            const float a = bflo(yw[j].x), b = bfhi(yw[j].x), c = bflo(yw[j].y), d = bfhi(yw[j].y); ss += (a * a + b * b) + (c * c + d * d); }
        const float ry = __builtin_amdgcn_rsqf(wave_sum(ss) * (1.f / D) + RMS_EPS);
#pragma unroll
        for (int j = 0; j < 8; ++j) { const f32x4 g4 = *(const f32x4*)(gate + j * 256 + lane * 4), w4 = *(const f32x4*)(gy + j * 256 + lane * 4);
            const f32x4 yv = {bflo(yw[j].x), bfhi(yw[j].x), bflo(yw[j].y), bfhi(yw[j].y)};
            v[j] = v[j] + g4 * (yv * ry * w4); }
#pragma unroll
        for (int j = 0; j < 8; ++j) *(f32x4*)(xout + j * 256 + lane * 4) = v[j];
    }
    if (hb) {
        float ss = 0.f;
#pragma unroll
        for (int j = 0; j < 8; ++j) ss += (v[j].x * v[j].x + v[j].y * v[j].y) + (v[j].z * v[j].z + v[j].w * v[j].w);
        const float r = __builtin_amdgcn_rsqf(wave_sum(ss) * (1.f / D) + RMS_EPS);
#pragma unroll
        for (int j = 0; j < 8; ++j) { const f32x4 g4 = *(const f32x4*)(gh + j * 256 + lane * 4), s4 = *(const f32x4*)(sh + j * 256 + lane * 4), c4 = *(const f32x4*)(sc + j * 256 + lane * 4);
            const f32x4 hv = v[j] * r * g4 * (c4 + 1.f) + s4;
            u32x2 w; w.x = cvt_pk_bf16(hv.x, hv.y); w.y = cvt_pk_bf16(hv.z, hv.w);
            *(u32x2*)(hb + j * 256 + lane * 4) = w; }
    }
}

__global__ void __launch_bounds__(512, 2) fwd_megakernel(Args a) {
    extern __shared__ __attribute__((aligned(16))) unsigned char lds_raw[];
    LAS unsigned char* lds = (LAS unsigned char*)lds_raw;
    cg::grid_group grid = cg::this_grid();
    const int tid = threadIdx.x, lane = tid & 63, wave = __builtin_amdgcn_readfirstlane(tid >> 6);
    const int G = gridDim.x, bx = blockIdx.x;
    const int gw = bx * 8 + wave, NGW = G * 8;
#define WSB ({ unsigned char* _w = a.ws; asm volatile("" : "+s"(_w)); _w; })
#define ADA ((float*)(WSB + WS_ADA))
#define ROPE ((float*)(WSB + WS_ROPE))
#define CS ((bf16_t*)(WSB + WS_CS))
#define CSN ((bf16_t*)(WSB + WS_CSN))
#define Wqkv ((bf16_t*)(WSB + WS_WQKV))
#define Wo ((bf16_t*)(WSB + WS_WO))
#define Win ((bf16_t*)(WSB + WS_WIN))
#define Wout ((bf16_t*)(WSB + WS_WOUT))
#define Wgu ((bf16_t*)(WSB + WS_WGU))
#define Wdn ((bf16_t*)(WSB + WS_WDN))
#define HB ((bf16_t*)(WSB + WS_HB))
#define YB ((bf16_t*)(WSB + WS_YB))
#define Qb ((bf16_t*)(WSB + WS_Q))
#define Kb ((bf16_t*)(WSB + WS_K))
#define Vb ((bf16_t*)(WSB + WS_V))
#define Ob ((bf16_t*)(WSB + WS_O))
#define HID ((bf16_t*)(WSB + WS_HID))
#define Ub ((bf16_t*)(WSB + WS_U))
#define YT ((bf16_t*)(WSB + WS_YT))
#define Fb ((bf16_t*)(WSB + WS_F))

    {
        LAS float* sl = (LAS float*)(lds + 69632);
        LAS float* red = (LAS float*)lds;
        if (bx < 192) {
            for (int i = tid; i < 5 * D; i += 512) { const float cv = (i < 4 * D) ? a.c[i] : a.c_ctx[i - 4 * D]; sl[i] = silu_f(cv); }
            __syncthreads();
            for (int it = bx; it < 192; it += G) {
                const int layer = it / 96, n0 = (it % 96) * 128;
                const float* wp = a.mod_w + (size_t)layer * D * 6 * D + (size_t)(wave * 256) * 6 * D + n0 + lane * 2;
                float ac[5][2];
#pragma unroll
                for (int r = 0; r < 5; ++r) { ac[r][0] = 0.f; ac[r][1] = 0.f; }
#pragma unroll 8
                for (int k = 0; k < 256; ++k) { const f32x2 w = *(const f32x2*)(wp + (size_t)k * 6 * D);
#pragma unroll
                    for (int r = 0; r < 5; ++r) { const float s = sl[r * D + wave * 256 + k]; ac[r][0] += s * w.x; ac[r][1] += s * w.y; } }
#pragma unroll
                for (int r = 0; r < 5; ++r) { red[(wave * 5 + r) * 128 + lane * 2] = ac[r][0]; red[(wave * 5 + r) * 128 + lane * 2 + 1] = ac[r][1]; }
                __syncthreads();
                for (int i = tid; i < 5 * 128; i += 512) { const int r = i >> 7, cc = i & 127; float s = a.mod_b[layer * 6 * D + n0 + cc];
#pragma unroll
                    for (int w = 0; w < 8; ++w) s += red[(w * 5 + r) * 128 + cc];
                    ADA[(size_t)(layer * 5 + r) * 6 * D + n0 + cc] = s; }
                __syncthreads();
            }
        }
        __syncthreads();
        LAS float* scr = (LAS float*)(lds + wave * 8704);
        constexpr int I_QKV = 32 * 192, I_SQ = 32 * 64, I_GU = 32 * 352, I_DN = 88 * 64;
        constexpr int NITEMS = I_QKV + 3 * I_SQ + 2 * I_GU + 2 * I_DN;
        for (int it = gw; it < NITEMS; it += NGW) {
            int r = it;
            if (r < I_QKV) { transpose_item(a.w_qkv, D, NQKV, NQKV, Wqkv, 1, scr, r, lane); continue; } r -= I_QKV;
            if (r < I_SQ) { transpose_item(a.w_o, D, D, D, Wo, 0, scr, r, lane); continue; } r -= I_SQ;
            if (r < I_SQ) { transpose_item(a.w_in, D, D, D, Win, 0, scr, r, lane); continue; } r -= I_SQ;
            if (r < I_SQ) { transpose_item(a.w_out, D, D, D, Wout, 0, scr, r, lane); continue; } r -= I_SQ;
            if (r < 2 * I_GU) { const int l = r / I_GU; transpose_item(a.w_gu + (size_t)l * D * NGU, D, NGU, NGU, Wgu + (size_t)l * NGU * D, 2, scr, r % I_GU, lane); continue; } r -= 2 * I_GU;
            { const int l = r / I_DN; transpose_item(a.w_dn + (size_t)l * FF * D, FF, D, D, Wdn + (size_t)l * D * FF, 0, scr, r % I_DN, lane); }
        }
        const int gt = bx * 512 + tid, NGT = G * 512;
        if (gt < 1024) { const int pos = gt >> 4, f = gt & 15; const float inv = powf(10000.f, -(float)f / 16.f); const float ang = (float)pos * inv;
            ROPE[gt] = cosf(ang); ROPE[1024 + gt] = sinf(ang); }
        for (int i = gt; i < 512 * 256; i += NGT) { const int m = i >> 8, cc = i & 255, part = m >> 8, kc = m & 255; const int idx = (kc * cc) & 255;
            float sv, cv; sincospif((float)idx * (1.f / 128.f), &sv, &cv); const float v = (part ? sv : cv) * (1.f / 16.f);
            CS[i] = (bf16_t)(cvt_pk_bf16(v, v) & 0xffffu); }
        for (int i = gt; i < 4096 * 1024; i += NGT) { const int kn = i >> 10, j0 = (i & 1023) * 8, part = j0 >> 12, n0 = j0 & 4095;
            float vv[8];
#pragma unroll
            for (int q = 0; q < 8; ++q) { const int idx = (kn * (n0 + q)) & 4095; float sv, cv; sincospif((float)idx * (1.f / 2048.f), &sv, &cv); vv[q] = (part ? -sv : cv) * (1.f / 64.f); }
            u32x4 w; w.x = cvt_pk_bf16(vv[0], vv[1]); w.y = cvt_pk_bf16(vv[2], vv[3]); w.z = cvt_pk_bf16(vv[4], vv[5]); w.w = cvt_pk_bf16(vv[6], vv[7]);
            *(u32x4*)(CSN + (size_t)kn * 8192 + j0) = w; }
    }
    grid.sync();

    for (int row = gw; row < MT; row += NGW) {
        const bool lat = row < M; const int r = lat ? (row >> 12) : 4;
        const float* xin = lat ? a.x + (size_t)row * D : a.ctx + (size_t)(row - M) * D;
        const float* ad = ADA + (size_t)r * 6 * D;
        row_op(lane, nullptr, xin, nullptr, nullptr, nullptr, a.norm_g, ad, ad + D, HB + (size_t)row * D);
    }
    grid.sync();

    PH(0) { pg8::Gemm g{HB, Wqkv, D, D, D}; pg8::SchedQKV S{G, bx}; pg8::EpiQKV E{Qb, Kb, Vb, ROPE};
      pg8::gemm_phase(lds, g, S, E); }
    grid.sync();

    {
        if (tid < 128) ((LAS float*)(lds + att::SUBG))[tid] = a.subg[tid] * 0.8f;
        if (wave == 0) { const float p01 = wave_sum(a.lam[lane] * a.lam[64 + lane]), p23 = wave_sum(a.lam[128 + lane] * a.lam[192 + lane]);
            if (lane == 0) *(LAS float*)(lds + att::LAMO) = expf(p01) - expf(p23) + 0.2f; }
        __syncthreads();
        if (G == 256) { for (int i = 0; i < 8; ++i) { const int bh = (bx & 7) * 8 + i, qb = bx >> 3; att::attn_unit(bh >> 4, bh & 15, qb, Qb, Kb, Vb, Ob, lds); } }
        else { for (int u = bx; u < 2048; u += G) { const int bh = u >> 5, qb = u & 31; att::attn_unit(bh >> 4, bh & 15, qb, Qb, Kb, Vb, Ob, lds); } }
    }
    grid.sync();

    PH(1) { pg8::Gemm g{Ob, Wo, D, D, D}; pg8::SchedStd S{64, 8, G, bx, D, D, D}; pg8::EpiPlain E{YB, D}; pg8::gemm_phase(lds, g, S, E); }
    grid.sync();

    for (int row = gw; row < M; row += NGW) { const float* ad = ADA + (size_t)(row >> 12) * 6 * D;
        row_op(lane, YB + (size_t)row * D, a.x + (size_t)row * D, ad + 2 * D, a.norm_g + D, a.out + (size_t)row * D, a.norm_g + 2 * D, ad + 3 * D, ad + 4 * D, HB + (size_t)row * D); }
    grid.sync();

    PH(2) { pg8::Gemm g{HB, Wgu, D, D, D}; pg8::SchedStd S{64, 44, G, bx, D, D, 0}; pg8::EpiSwiGLU E{HID}; pg8::gemm_phase(lds, g, S, E); }
    grid.sync();
    PH(3) { pg8::Gemm g{HID, Wdn, FF, FF, FF}; pg8::SchedStd S{64, 8, G, bx, FF, FF, D}; pg8::EpiPlain E{YB, D}; pg8::gemm_phase(lds, g, S, E); }
    grid.sync();

    for (int row = gw; row < M; row += NGW) { const float* ad = ADA + (size_t)(row >> 12) * 6 * D; const float* ad1 = ADA + (size_t)(5 + (row >> 12)) * 6 * D;
        row_op(lane, YB + (size_t)row * D, a.out + (size_t)row * D, ad + 5 * D, a.norm_g + 3 * D, a.out + (size_t)row * D, a.norm_g + 4 * D, ad1, ad1 + D, HB + (size_t)row * D); }
    grid.sync();

    PH(4) { pg8::Gemm g{HB, Win, D, D, D}; pg8::SchedStd S{64, 8, G, bx, D, D, D}; pg8::EpiPlain E{Ub, D}; pg8::gemm_phase(lds, g, S, E); }
    grid.sync();
    PH(5) { pg8::Gemm g{CS, Ub, 256, D, 256}; pg8::SchedDft1 S{G, bx}; pg8::EpiPlain E{YT, 2 * SEQ}; pg8::gemm_phase(lds, g, S, E); }
    grid.sync();
    PH(6) { pg8::Gemm g{CSN, YT, 8192, 8192, 8192}; pg8::SchedDft2 S{G, bx}; pg8::EpiPlain E{Fb, D}; pg8::gemm_phase(lds, g, S, E); }
    grid.sync();
    PH(7) { pg8::Gemm g{Fb, Wout, D, D, D}; pg8::SchedStd S{64, 8, G, bx, D, D, D}; pg8::EpiPlain E{YB, D}; pg8::gemm_phase(lds, g, S, E); }
    grid.sync();

    for (int row = gw; row < M; row += NGW) { const float* ad = ADA + (size_t)(5 + (row >> 12)) * 6 * D; const float* ng = a.norm_g + 4 * D;
        row_op(lane, YB + (size_t)row * D, a.out + (size_t)row * D, ad + 2 * D, ng + D, a.out + (size_t)row * D, ng + 2 * D, ad + 3 * D, ad + 4 * D, HB + (size_t)row * D); }
    grid.sync();

    PH(8) { pg8::Gemm g{HB, Wgu + (size_t)NGU * D, D, D, D}; pg8::SchedStd S{64, 44, G, bx, D, D, 0}; pg8::EpiSwiGLU E{HID}; pg8::gemm_phase(lds, g, S, E); }
    grid.sync();
    PH(9) { pg8::Gemm g{HID, Wdn + (size_t)D * FF, FF, FF, FF}; pg8::SchedStd S{64, 8, G, bx, FF, FF, D}; pg8::EpiPlain E{YB, D}; pg8::gemm_phase(lds, g, S, E); }
    grid.sync();

    for (int row = gw; row < M; row += NGW) { const float* ad = ADA + (size_t)(5 + (row >> 12)) * 6 * D; const float* ng = a.norm_g + 4 * D;
        row_op(lane, YB + (size_t)row * D, a.out + (size_t)row * D, ad + 5 * D, ng + 3 * D, a.out + (size_t)row * D, nullptr, nullptr, nullptr, nullptr); }
}

extern "C" void kernel_launch(void* const* d_in, const int* in_sizes, int n_in, void* d_out, int out_size, void* d_ws, size_t ws_size, hipStream_t stream) {
    static int grid = 0;
    if (grid == 0) {
        if (n_in != 15 || in_sizes[0] != M * D || out_size != M * D || ws_size < WS_END) {
            fprintf(stderr, "kernel_launch: unexpected shapes / workspace (n_in %d, in0 %d, out %d, ws %zu, need %zu)\n", n_in, n_in > 0 ? in_sizes[0] : -1, out_size, ws_size, (size_t)WS_END);
            grid = -1; return; }
        int dev = 0, cus = 0, per_cu = 0;
        hipGetDevice(&dev);
        hipDeviceGetAttribute(&cus, hipDeviceAttributeMultiprocessorCount, dev);
        if (hipFuncSetAttribute((const void*)fwd_megakernel, hipFuncAttributeMaxDynamicSharedMemorySize, LDS_BYTES) != hipSuccess) { fprintf(stderr, "kernel_launch: hipFuncSetAttribute failed\n"); grid = -1; return; }
        hipOccupancyMaxActiveBlocksPerMultiprocessor(&per_cu, (const void*)fwd_megakernel, 512, LDS_BYTES);
        if (per_cu < 1) { fprintf(stderr, "kernel_launch: occupancy query says %d blocks per CU\n", per_cu); per_cu = 1; }
        (void)hipGetLastError();
        grid = cus * 1;
    }
    if (grid < 0) return;
    Args a{};
    a.x = (const float*)d_in[0]; a.c = (const float*)d_in[1]; a.ctx = (const float*)d_in[2]; a.c_ctx = (const float*)d_in[3];
    a.mod_w = (const float*)d_in[4]; a.mod_b = (const float*)d_in[5]; a.norm_g = (const float*)d_in[6]; a.w_gu = (const float*)d_in[7]; a.w_dn = (const float*)d_in[8];
    a.w_qkv = (const float*)d_in[9]; a.w_o = (const float*)d_in[10]; a.lam = (const float*)d_in[11]; a.subg = (const float*)d_in[12]; a.w_in = (const float*)d_in[13]; a.w_out = (const float*)d_in[14];
    a.out = (float*)d_out; a.ws = (unsigned char*)d_ws;
    void* args[] = {&a};
    hipError_t e = hipLaunchCooperativeKernel((const void*)fwd_megakernel, dim3(grid), dim3(512), args, LDS_BYTES, stream);
    if (e != hipSuccess) fprintf(stderr, "cooperative launch failed: %s (grid %d)\n", hipGetErrorString(e), grid);
}
```

```cpp
#include <hip/hip_runtime.h>
#include <hip/hip_cooperative_groups.h>
#include <cstdio>
#include <cstdint>
namespace cg = cooperative_groups;

#define LAS __attribute__((address_space(3)))
typedef unsigned short bf16_t;
typedef short bf16x8 __attribute__((ext_vector_type(8)));
typedef short s16x4 __attribute__((ext_vector_type(4)));
typedef float f32x4 __attribute__((ext_vector_type(4)));
typedef float f32x2 __attribute__((ext_vector_type(2)));
typedef float f32x16 __attribute__((ext_vector_type(16)));
typedef unsigned u32x4 __attribute__((ext_vector_type(4)));
typedef unsigned u32x2 __attribute__((ext_vector_type(2)));

constexpr int D = 2048, NB = 4, SEQ = 4096, M = NB * SEQ, LC = 256, MC = NB * LC, MT = M + MC;
constexpr int NH = 16, HD = 64, VD = 128, NQKV = 6144, FF = 5632, NGU = 2 * FF, SK = SEQ + LC;
constexpr float RMS_EPS = 1e-6f;
constexpr float QSCALE = 0.125f * 1.4426950408889634f;

constexpr size_t MiB = 1u << 20;
constexpr size_t WS_ADA = 1 * MiB;
constexpr size_t WS_ROPE = 1 * MiB + 768 * 1024;
constexpr size_t WS_D1 = 2 * MiB;
constexpr size_t WS_D2 = 2 * MiB + 64 * 1024;
constexpr size_t WS_CS2 = 2 * MiB + 192 * 1024;
constexpr size_t WS_TW = 2 * MiB + 448 * 1024;
constexpr size_t WS_WQKV = 3 * MiB;
constexpr size_t WS_WO = 27 * MiB;
constexpr size_t WS_WIN = 35 * MiB;
constexpr size_t WS_WOUT = 43 * MiB;
constexpr size_t WS_WGU = 51 * MiB;
constexpr size_t WS_WDN = 139 * MiB;
constexpr size_t WS_HB = 183 * MiB;
constexpr size_t WS_YB = 251 * MiB;
constexpr size_t WS_R = 315 * MiB;
constexpr size_t WS_Q = WS_R;
constexpr size_t WS_K = WS_R + 64 * MiB;
constexpr size_t WS_V = WS_R + 132 * MiB;
constexpr size_t WS_O = WS_R + 200 * MiB;
constexpr size_t WS_HID = WS_R;
constexpr size_t WS_U = WS_R + 200 * MiB;
constexpr size_t WS_A2 = WS_R;
constexpr size_t WS_X = WS_R + 128 * MiB;
constexpr size_t WS_F = WS_R;
constexpr size_t WS_END = WS_R + 264 * MiB;

constexpr int LDS_BYTES = 147456;

__device__ __forceinline__ unsigned cvt_pk_bf16(float lo, float hi) { unsigned r; asm volatile("v_cvt_pk_bf16_f32 %0, %1, %2" : "=v"(r) : "v"(lo), "v"(hi)); return r; }
__device__ __forceinline__ float bf2f(unsigned short b) { return __uint_as_float(((unsigned)b) << 16); }
__device__ __forceinline__ float bflo(unsigned w) { return __uint_as_float(w << 16); }
__device__ __forceinline__ float bfhi(unsigned w) { return __uint_as_float(w & 0xffff0000u); }
__device__ __forceinline__ float wave_sum(float v) {
#pragma unroll
    for (int o = 1; o < 64; o <<= 1) v += __shfl_xor(v, o);
    return v;
}
__device__ __forceinline__ float silu_f(float v) { return v / (1.f + __expf(-v)); }

namespace pg8 {
constexpr int BM = 256, BK = 64, HALF = 128, HTB = HALF * BK * 2, NXCD = 8, WGM = 8;
__host__ __device__ __forceinline__ int lds_byte(int r, int c) { const int st = (r >> 4) * 2 + (c >> 5), rr = r & 15, cc = c & 31, ob = rr * 64 + cc * 2; return st * 1024 + (ob ^ (((ob >> 9) & 1) << 5)); }
__host__ __device__ __forceinline__ void stage_rc(int b, int& R, int& C) { const int st = b / 1024, sb = b % 1024, swz = sb ^ (((sb >> 9) & 1) << 5); R = (st >> 1) * 16 + swz / 64; C = (st & 1) * 32 + (swz % 64) / 2; }
__host__ __device__ __forceinline__ int perm32(int rho) { const int n = rho >> 4, i = rho & 15; return 8 * (i >> 2) + 4 * n + (i & 3); }

struct Unit { int pm, pn; size_t aoff, boff, coff; };
struct Gemm { const bf16_t* A; const bf16_t* Bt; int lda, ldb, K; };

__device__ __forceinline__ void swz_order(int L, int nM, int nN, int& pm, int& pn) {
    const int nwg = nM * nN; int wgid = L;
    { const int q = nwg / NXCD, r = nwg % NXCD, xcd = wgid % NXCD, off = wgid / NXCD; wgid = (xcd < r ? xcd * (q + 1) : r * (q + 1) + (xcd - r) * q) + off; }
    const int nig = WGM * nN, gid = wgid / nig, fm = gid * WGM, gsz = (nM - fm) < WGM ? (nM - fm) : WGM;
    pm = fm + ((wgid % nig) % gsz); pn = (wgid % nig) / gsz;
}

template <class Epi, class Sched>
__device__ __forceinline__ void gemm_phase(LAS unsigned char* lds, const Gemm g, const Sched& S, const Epi& E) {
    int tid = threadIdx.x; asm volatile("" : "+v"(tid));
    const int wid = __builtin_amdgcn_readfirstlane(tid >> 6), lane = tid & 63, wr = wid >> 2, wc = wid & 3, fr = lane & 15, fq = lane >> 4;
    int nt = g.K / BK; asm volatile("" : "+s"(nt));
    unsigned voffA[2], voffB[2];
#pragma unroll
    for (int i = 0; i < 2; ++i) { int R, C; stage_rc(tid * 16 + i * 8192, R, C); const int Rb = (R & ~31) + perm32(R & 31);
        voffA[i] = (unsigned)(R * g.lda + C) * 2u; voffB[i] = (unsigned)(Rb * g.ldb + C) * 2u; }
    const size_t kstep = (size_t)(BK * 2);
    const size_t hstepA = (size_t)HALF * g.lda * 2, hstepB = (size_t)HALF * g.ldb * 2;
    const unsigned ldsw = (unsigned)wid * 1024u;
    const int aoff = lds_byte(wr * 64 + fr, fq * 8), boff = lds_byte(wc * 32 + fr, fq * 8);
#define PG8_SA(b, h) (((b) * 2 + (h)) * HTB)
#define PG8_SB(b, h) ((4 + (b) * 2 + (h)) * HTB)
#define PG8_STAGE(bufoff, gbase, voff) do { _Pragma("unroll") for (int _i = 0; _i < 2; ++_i) \
        __builtin_amdgcn_global_load_lds((const unsigned*)((const char*)(gbase) + (voff)[_i]), (LAS unsigned*)(lds + (bufoff) + ldsw + _i * 8192), 16, 0, 0); } while (0)
#define PG8_LDA(dst, b, h) do { _Pragma("unroll") for (int m = 0; m < 4; ++m) _Pragma("unroll") for (int k = 0; k < 2; ++k) dst[m][k] = *(const LAS bf16x8*)(lds + PG8_SA(b, h) + aoff + m * 2048 + k * 1024); } while (0)
#define PG8_LDB(dst, b, h) do { _Pragma("unroll") for (int n = 0; n < 2; ++n) _Pragma("unroll") for (int k = 0; k < 2; ++k) dst[n][k] = *(const LAS bf16x8*)(lds + PG8_SB(b, h) + boff + n * 2048 + k * 1024); } while (0)
#define PG8_MMA(ai, bj, At, Bt) do { __builtin_amdgcn_s_setprio(1); _Pragma("unroll") for (int m = 0; m < 4; ++m) _Pragma("unroll") for (int n = 0; n < 2; ++n) _Pragma("unroll") for (int k = 0; k < 2; ++k) \
        acc[ai][bj][m][n] = __builtin_amdgcn_mfma_f32_16x16x32_bf16(Bt[n][k], At[m][k], acc[ai][bj][m][n], 0, 0, 0); __builtin_amdgcn_s_setprio(0); } while (0)
#define PG8_WAIT_V(n) asm volatile("s_waitcnt vmcnt(" #n ")" ::: "memory")
#define PG8_WAIT_L(n) asm volatile("s_waitcnt lgkmcnt(" #n ")" ::: "memory")
#define PG8_BAR __builtin_amdgcn_s_barrier()
#define PG8_SCHED __builtin_amdgcn_sched_barrier(0)
    Unit cur, nxt; int ui = 0;
    if (!S.next(0, cur)) return;
    f32x4 acc[2][2][4][2];
#pragma unroll
    for (int a = 0; a < 2; ++a)
#pragma unroll
        for (int b = 0; b < 2; ++b)
#pragma unroll
            for (int m = 0; m < 4; ++m)
#pragma unroll
                for (int n = 0; n < 2; ++n) acc[a][b][m][n] = (f32x4){0.f, 0.f, 0.f, 0.f};
    bf16x8 At[4][2], B0[2][2], B1[2][2];
    const char* cA = (const char*)g.A + cur.aoff; const char* cB = (const char*)g.Bt + cur.boff;
    PG8_STAGE(PG8_SB(0, 0), cB, voffB); PG8_STAGE(PG8_SB(0, 1), cB + hstepB, voffB); PG8_STAGE(PG8_SA(0, 0), cA, voffA); PG8_STAGE(PG8_SA(0, 1), cA + hstepA, voffA);
    if (wr == 1) PG8_BAR;
    PG8_WAIT_V(2); PG8_BAR;
    PG8_STAGE(PG8_SB(1, 0), cB + kstep, voffB); PG8_STAGE(PG8_SA(1, 0), cA + kstep, voffA); PG8_STAGE(PG8_SB(1, 1), cB + hstepB + kstep, voffB);
    PG8_WAIT_V(6); PG8_BAR;
    for (;;) {
        const bool has_next = S.next(ui + 1, nxt);
        const char* nA = has_next ? (const char*)g.A + nxt.aoff : cA; const char* nB = has_next ? (const char*)g.Bt + nxt.boff : cB;
        for (int t = 0; t < nt; t += 2) {
            const bool last = (t == nt - 2);
            const char* a1 = cA + (size_t)(t + 1) * kstep;
            const char* a2 = last ? nA : cA + (size_t)(t + 2) * kstep; const char* b2 = last ? nB : cB + (size_t)(t + 2) * kstep;
            const char* a3 = a2 + kstep; const char* b3 = b2 + kstep;
            PG8_LDB(B0, 0, 0); PG8_LDB(B1, 0, 1); PG8_SCHED; PG8_LDA(At, 0, 0); PG8_STAGE(PG8_SA(1, 1), a1 + hstepA, voffA);
            PG8_WAIT_V(8); PG8_WAIT_L(0); PG8_BAR; PG8_MMA(0, 0, At, B0); PG8_MMA(0, 1, At, B1); PG8_BAR; PG8_SCHED;
            PG8_LDA(At, 0, 1); PG8_STAGE(PG8_SB(0, 0), b2, voffB); PG8_STAGE(PG8_SB(0, 1), b2 + hstepB, voffB); PG8_STAGE(PG8_SA(0, 0), a2, voffA);
            PG8_WAIT_V(8); PG8_WAIT_L(0); PG8_BAR; PG8_MMA(1, 0, At, B0); PG8_MMA(1, 1, At, B1); PG8_BAR; PG8_SCHED;
            PG8_LDB(B0, 1, 0); PG8_LDB(B1, 1, 1); PG8_SCHED; PG8_LDA(At, 1, 0); PG8_STAGE(PG8_SA(0, 1), a2 + hstepA, voffA);
            PG8_WAIT_V(8); PG8_WAIT_L(0); PG8_BAR; PG8_MMA(0, 0, At, B0); PG8_MMA(0, 1, At, B1); PG8_BAR; PG8_SCHED;
            PG8_LDA(At, 1, 1); PG8_STAGE(PG8_SB(1, 0), b3, voffB); PG8_STAGE(PG8_SB(1, 1), b3 + hstepB, voffB); PG8_STAGE(PG8_SA(1, 0), a3, voffA);
            PG8_WAIT_V(8); PG8_WAIT_L(0); PG8_BAR; PG8_MMA(1, 0, At, B0); PG8_MMA(1, 1, At, B1); PG8_BAR; PG8_SCHED;
        }
        if (wr == 0) PG8_BAR;
        { int t2 = threadIdx.x; asm volatile("" : "+v"(t2)); const int fr2 = t2 & 15, fq2 = (t2 >> 4) & 3;
          E(acc, cur, wr, wc, fr2, fq2); }
        if (!has_next) break;
#pragma unroll
        for (int a = 0; a < 2; ++a)
#pragma unroll
            for (int b = 0; b < 2; ++b)
#pragma unroll
                for (int m = 0; m < 4; ++m)
#pragma unroll
                    for (int n = 0; n < 2; ++n) acc[a][b][m][n] = (f32x4){0.f, 0.f, 0.f, 0.f};
        cur = nxt; cA = nA; cB = nB; ++ui;
        if (wr == 1) PG8_BAR;
    }
    PG8_WAIT_V(0);
    PG8_BAR;
#undef PG8_SA
#undef PG8_SB
#undef PG8_STAGE
#undef PG8_LDA
#undef PG8_LDB
#undef PG8_MMA
#undef PG8_WAIT_V
#undef PG8_WAIT_L
#undef PG8_BAR
#undef PG8_SCHED
}

struct SchedStd {
    int nM, nN, G, c, lda, ldb, ldc;
    __device__ __forceinline__ bool next(int i, Unit& u) const {
        const int L = i * G + c; if (L >= nM * nN) return false;
        swz_order(L, nM, nN, u.pm, u.pn);
        u.aoff = (size_t)u.pm * BM * lda * 2; u.boff = (size_t)u.pn * BM * ldb * 2; u.coff = (size_t)u.pm * BM * ldc + (size_t)u.pn * BM; return true;
    }
};
struct SchedQKV {
    int G, c;
    __device__ __forceinline__ bool next(int i, Unit& u) const {
        const int L = i * G + c; if (L >= 1536 + 64) return false;
        if (L < 1536) swz_order(L, 64, 24, u.pm, u.pn); else { const int l2 = L - 1536; u.pm = 64 + (l2 & 3); u.pn = 8 + (l2 >> 2); }
        u.aoff = (size_t)u.pm * BM * D * 2; u.boff = (size_t)u.pn * BM * D * 2; u.coff = 0; return true;
    }
};
struct SchedInT {
    int G, c;
    __device__ __forceinline__ bool next(int i, Unit& u) const {
        const int L = i * G + c; if (L >= 512) return false;
        swz_order(L, 8, 64, u.pm, u.pn);
        u.aoff = (size_t)u.pm * BM * D * 2; u.boff = (size_t)u.pn * BM * D * 2;
        u.coff = ((size_t)((u.pn >> 4) * D + u.pm * BM)) * SEQ + (u.pn & 15) * BM; return true;
    }
};
struct SchedCols {
    int G, c, nU, ldb;
    __device__ __forceinline__ bool next(int i, Unit& u) const {
        const int L = i * G + c; if (L >= nU) return false;
        size_t z = 0; asm volatile("" : "+s"(z));
        u.pm = 0; u.pn = L; u.aoff = z; u.boff = (size_t)L * BM * ldb * 2; u.coff = 0; return true;
    }
};
struct SchedChan {
    int G, c;
    __device__ __forceinline__ bool next(int i, Unit& u) const {
        const int L = i * G + c; if (L >= 512) return false;
        u.pm = L >> 3; u.pn = L & 7;
        size_t z = 0; asm volatile("" : "+s"(z));
        u.aoff = ((size_t)u.pm * BM * 4096 + u.pn * 512) * 2; u.boff = z; u.coff = (size_t)u.pm * BM * D + u.pn * BM; return true;
    }
};

struct EpiPlain {
    bf16_t* O; int ldc;
    __device__ __forceinline__ void operator()(const f32x4 (&acc)[2][2][4][2], const Unit& u, int wr, int wc, int fr, int fq) const {
        bf16_t* base = O + u.coff + (size_t)(wr * 64 + fr) * ldc + wc * 32 + 8 * fq;
#pragma unroll
        for (int ai = 0; ai < 2; ++ai)
#pragma unroll
            for (int m = 0; m < 4; ++m) { bf16_t* rowp = base + (size_t)(ai * HALF + m * 16) * ldc;
#pragma unroll
                for (int bj = 0; bj < 2; ++bj) { const f32x4 v0 = acc[ai][bj][m][0], v1 = acc[ai][bj][m][1];
                    u32x4 w; w.x = cvt_pk_bf16(v0[0], v0[1]); w.y = cvt_pk_bf16(v0[2], v0[3]); w.z = cvt_pk_bf16(v1[0], v1[1]); w.w = cvt_pk_bf16(v1[2], v1[3]);
                    *(u32x4*)(rowp + bj * HALF) = w; } }
    }
};
struct EpiSwiGLU {
    bf16_t* O;
    __device__ __forceinline__ void operator()(const f32x4 (&acc)[2][2][4][2], const Unit& u, int wr, int wc, int fr, int fq) const {
        bf16_t* base = O + (size_t)(u.pm * BM + wr * 64 + fr) * FF + u.pn * 128 + wc * 32 + 8 * fq;
#pragma unroll
        for (int ai = 0; ai < 2; ++ai)
#pragma unroll
            for (int m = 0; m < 4; ++m) { bf16_t* rowp = base + (size_t)(ai * HALF + m * 16) * FF;
                float o[8];
#pragma unroll
                for (int n = 0; n < 2; ++n)
#pragma unroll
                    for (int j = 0; j < 4; ++j) { const float gv = acc[ai][0][m][n][j], uv = acc[ai][1][m][n][j];
                        o[n * 4 + j] = gv * uv * __builtin_amdgcn_rcpf(1.f + __builtin_amdgcn_exp2f(-1.4426950408889634f * gv)); }
                u32x4 w; w.x = cvt_pk_bf16(o[0], o[1]); w.y = cvt_pk_bf16(o[2], o[3]); w.z = cvt_pk_bf16(o[4], o[5]); w.w = cvt_pk_bf16(o[6], o[7]);
                *(u32x4*)rowp = w; }
    }
};
struct EpiFft1 {
    bf16_t* A2; const f32x2* tw;
    __device__ __forceinline__ void operator()(const f32x4 (&acc)[2][2][4][2], const Unit& u, int wr, int wc, int fr, int fq) const {
#pragma unroll
        for (int bj = 0; bj < 2; ++bj) { const int gcol = u.pn * 8 + 4 * bj + wc, b = gcol >> 11, col = gcol & 2047;
#pragma unroll
            for (int m = 0; m < 4; ++m) { const int k1 = 16 * m + fr; float re[8], im[8];
#pragma unroll
                for (int n = 0; n < 2; ++n)
#pragma unroll
                    for (int j = 0; j < 4; ++j) { const int r = 2 * (8 * fq + 4 * n + j) + wr; const f32x2 t = tw[k1 * r];
                        const float ar = acc[0][bj][m][n][j], ai = acc[1][bj][m][n][j];
                        re[n * 4 + j] = ar * t.x + ai * t.y; im[n * 4 + j] = ai * t.x - ar * t.y; }
                bf16_t* dst = A2 + (((size_t)(b * 32 + (k1 >> 1)) * D + col) * 256) + (k1 & 1) * 128 + wr * 32 + 8 * fq;
                u32x4 w; w.x = cvt_pk_bf16(re[0], re[1]); w.y = cvt_pk_bf16(re[2], re[3]); w.z = cvt_pk_bf16(re[4], re[5]); w.w = cvt_pk_bf16(re[6], re[7]);
                *(u32x4*)dst = w;
                w.x = cvt_pk_bf16(im[0], im[1]); w.y = cvt_pk_bf16(im[2], im[3]); w.z = cvt_pk_bf16(im[4], im[5]); w.w = cvt_pk_bf16(im[6], im[7]);
                *(u32x4*)(dst + 64) = w; } }
    }
};
struct EpiFft2 {
    bf16_t* X;
    __device__ __forceinline__ void operator()(const f32x4 (&acc)[2][2][4][2], const Unit& u, int wr, int wc, int fr, int fq) const {
        const int bk = u.pn >> 3, b = bk >> 5, k1p = bk & 31, gq = u.pn & 7;
#pragma unroll
        for (int ai = 0; ai < 2; ++ai)
#pragma unroll
            for (int m = 0; m < 4; ++m) { const int k2 = 16 * m + fr, tok = b * SEQ + 2 * k1p + ai + 64 * k2;
                bf16_t* rowp = X + (size_t)tok * 4096 + gq * 512 + wr * 256 + wc * 32 + 8 * fq;
#pragma unroll
                for (int bj = 0; bj < 2; ++bj) { const f32x4 v0 = acc[ai][bj][m][0], v1 = acc[ai][bj][m][1];
                    u32x4 w; w.x = cvt_pk_bf16(v0[0], v0[1]); w.y = cvt_pk_bf16(v0[2], v0[3]); w.z = cvt_pk_bf16(v1[0], v1[1]); w.w = cvt_pk_bf16(v1[2], v1[3]);
                    *(u32x4*)(rowp + bj * HALF) = w; } }
    }
};
struct EpiQKV {
    bf16_t *Q, *K, *V; const float* rope;
    __device__ __forceinline__ void operator()(const f32x4 (&acc)[2][2][4][2], const Unit& u, int wr, int wc, int fr, int fq) const {
        const int sec = u.pn >> 3, h0 = (u.pn & 7) * 2;
        const bool latent = u.pm < 64;
        const int b = latent ? (u.pm >> 4) : (u.pm - 64);
        const int tok0 = (latent ? (u.pm & 15) * 256 : SEQ) + wr * 64 + fr;
        const int cm = wc >> 1, axis = wc & 1;
#pragma unroll
        for (int ai = 0; ai < 2; ++ai)
#pragma unroll
            for (int m = 0; m < 4; ++m) {
                const int tok = tok0 + ai * HALF + m * 16;
                f32x4 c4 = {1.f, 1.f, 1.f, 1.f}, s4 = {0.f, 0.f, 0.f, 0.f};
                if (sec < 2 && latent) { const int pos = axis ? (tok & 63) : (tok >> 6); c4 = *(const f32x4*)(rope + pos * 16 + 4 * fq); s4 = *(const f32x4*)(rope + 1024 + pos * 16 + 4 * fq); }
#pragma unroll
                for (int bj = 0; bj < 2; ++bj) {
                    const int h = h0 + bj;
                    f32x4 v0 = acc[ai][bj][m][0], v1 = acc[ai][bj][m][1];
                    bf16_t* dst;
                    if (sec < 2) {
                        const f32x4 a = v0 * c4 - v1 * s4, bb = v1 * c4 + v0 * s4; v0 = a; v1 = bb;
                        if (sec == 0) { v0 = v0 * QSCALE; v1 = v1 * QSCALE; dst = Q + ((size_t)(((b * NH + h) * 2 + cm) * SEQ + tok)) * HD + axis * 32 + 8 * fq; }
                        else dst = K + ((size_t)(((b * NH + h) * 2 + cm) * SK + tok)) * HD + axis * 32 + 8 * fq;
                    } else dst = V + ((size_t)((b * NH + h) * SK + tok)) * VD + wc * 32 + 8 * fq;
                    u32x4 w; w.x = cvt_pk_bf16(v0[0], v0[1]); w.y = cvt_pk_bf16(v0[2], v0[3]); w.z = cvt_pk_bf16(v1[0], v1[1]); w.w = cvt_pk_bf16(v1[2], v1[3]);
                    *(u32x4*)dst = w;
                }
            }
    }
};
}

namespace att {
constexpr int NT = SK / 64;
constexpr int STG = 32768;
constexpr int XCH = 0, OST = 65536, SUBG = 120 * 1024, LAMO = SUBG + 512;
__device__ __forceinline__ int crow(int r, int hi) { return (r & 3) + 8 * (r >> 2) + 4 * hi; }
__device__ __forceinline__ float xhalf(float v) { return __shfl_xor(v, 32); }

__device__ __forceinline__ void attn_unit(int b, int h, int qb, const bf16_t* Q, const bf16_t* K, const bf16_t* V, bf16_t* O, LAS unsigned char* lds) {
    int tid = threadIdx.x; asm volatile("" : "+v"(tid));
    const int lane = tid & 63, r32 = lane & 31, hi = lane >> 5; const int wid = __builtin_amdgcn_readfirstlane(tid >> 6);
    const int cm = wid >> 2, wq = wid & 3;
    const bf16_t* Qp = Q + ((size_t)(((b * NH + h) * 2 + cm) * SEQ + qb * 128 + wq * 32 + r32)) * HD + hi * 8;
    const bf16_t* K0g = K + ((size_t)((b * NH + h) * 2) * SK) * HD + (size_t)(tid & 63) * HD + (tid >> 6) * 8;
    const bf16_t* K1g = K0g + (size_t)SK * HD;
    const bf16_t* Vg = V + (size_t)((b * NH + h) * SK) * VD;
    const bf16_t* Vg0 = Vg + (size_t)((((tid >> 6) & 3) * 16) + ((tid >> 2) & 15)) * VD + (tid >> 8) * 32 + (tid & 3) * 8;
    const bf16_t* Vg1 = Vg0 + 64;
    bf16x8 qr[4];
#pragma unroll
    for (int d0 = 0; d0 < 4; ++d0) qr[d0] = *(const bf16x8*)(Qp + d0 * 16);
    u32x4 sk0, sk1, sv0, sv1;
    sk0 = *(const u32x4*)K0g; sk1 = *(const u32x4*)K1g; sv0 = *(const u32x4*)Vg0; sv1 = *(const u32x4*)Vg1;
    *(LAS u32x4*)(lds + tid * 16) = sk0; *(LAS u32x4*)(lds + 8192 + tid * 16) = sk1;
    *(LAS u32x4*)(lds + 16384 + tid * 16) = sv0; *(LAS u32x4*)(lds + 16384 + 8192 + tid * 16) = sv1;
    f32x16 o[4];
#pragma unroll
    for (int e = 0; e < 4; ++e) o[e] = (f32x16){};
    float mrun = -1e30f, lsum = 0.f;
    const int kro = cm * 8192 + hi * 1024 + r32 * 16;
    const int vro = 16384 + ((lane >> 4) & 1) * 32 + (lane & 3) * 8 + (4 * hi + ((lane & 15) >> 2)) * 64;
    __syncthreads();
    for (int t = 0; t < NT; ++t) {
        LAS unsigned char* st = lds + (t & 1) * STG;
        if (t + 1 < NT) { const size_t ko = (size_t)(t + 1) * 64 * HD, vo = (size_t)(t + 1) * 64 * VD;
            sk0 = *(const u32x4*)(K0g + ko); sk1 = *(const u32x4*)(K1g + ko); sv0 = *(const u32x4*)(Vg0 + vo); sv1 = *(const u32x4*)(Vg1 + vo); }
        f32x16 p0 = (f32x16){}, p1 = (f32x16){};
#pragma unroll
        for (int d0 = 0; d0 < 4; ++d0) {
            const bf16x8 k0 = *(const LAS bf16x8*)(st + kro + d0 * 2048);
            const bf16x8 k1 = *(const LAS bf16x8*)(st + kro + d0 * 2048 + 512);
            p0 = __builtin_amdgcn_mfma_f32_32x32x16_bf16(k0, qr[d0], p0, 0, 0, 0);
            p1 = __builtin_amdgcn_mfma_f32_32x32x16_bf16(k1, qr[d0], p1, 0, 0, 0);
        }
        float mx = fmaxf(p0[0], p1[0]);
#pragma unroll
        for (int i = 1; i < 16; ++i) mx = fmaxf(mx, fmaxf(p0[i], p1[i]));
        mx = fmaxf(mx, xhalf(mx));
        if (__any(mx > mrun)) {
            const float mn = fmaxf(mrun, mx), al = __builtin_amdgcn_exp2f(mrun - mn);
            mrun = mn; lsum *= al;
#pragma unroll
            for (int e = 0; e < 4; ++e)
#pragma unroll
                for (int i = 0; i < 16; ++i) o[e][i] *= al;
        }
        float ls = 0.f;
#pragma unroll
        for (int i = 0; i < 16; ++i) { p0[i] = __builtin_amdgcn_exp2f(p0[i] - mrun); p1[i] = __builtin_amdgcn_exp2f(p1[i] - mrun); ls += p0[i] + p1[i]; }
        lsum += ls;
        bf16x8 pa[4];
#pragma unroll
        for (int s = 0; s < 2; ++s) {
            u32x4 w0, w1;
            w0.x = cvt_pk_bf16(p0[8 * s + 0], p0[8 * s + 1]); w0.y = cvt_pk_bf16(p0[8 * s + 2], p0[8 * s + 3]); w0.z = cvt_pk_bf16(p0[8 * s + 4], p0[8 * s + 5]); w0.w = cvt_pk_bf16(p0[8 * s + 6], p0[8 * s + 7]);
            w1.x = cvt_pk_bf16(p1[8 * s + 0], p1[8 * s + 1]); w1.y = cvt_pk_bf16(p1[8 * s + 2], p1[8 * s + 3]); w1.z = cvt_pk_bf16(p1[8 * s + 4], p1[8 * s + 5]); w1.w = cvt_pk_bf16(p1[8 * s + 6], p1[8 * s + 7]);
            pa[s] = __builtin_bit_cast(bf16x8, w0); pa[2 + s] = __builtin_bit_cast(bf16x8, w1);
        }
#pragma unroll
        for (int eb = 0; eb < 4; ++eb)
#pragma unroll
            for (int ks = 0; ks < 4; ++ks) {
                const s16x4 lo = __builtin_bit_cast(s16x4, __builtin_amdgcn_ds_read_tr16_b64_v4i16((LAS s16x4*)(st + vro + eb * 4096 + ks * 1024)));
                const s16x4 hh = __builtin_bit_cast(s16x4, __builtin_amdgcn_ds_read_tr16_b64_v4i16((LAS s16x4*)(st + vro + eb * 4096 + ks * 1024 + 512)));
                const bf16x8 vf = (bf16x8){lo[0], lo[1], lo[2], lo[3], hh[0], hh[1], hh[2], hh[3]};
                o[eb] = __builtin_amdgcn_mfma_f32_32x32x16_bf16(vf, pa[ks], o[eb], 0, 0, 0);
            }
        if (t + 1 < NT) { LAS unsigned char* sn = lds + ((t + 1) & 1) * STG;
            *(LAS u32x4*)(sn + tid * 16) = sk0; *(LAS u32x4*)(sn + 8192 + tid * 16) = sk1;
            *(LAS u32x4*)(sn + 16384 + tid * 16) = sv0; *(LAS u32x4*)(sn + 16384 + 8192 + tid * 16) = sv1; }
        __syncthreads();
    }
    const float linv = 1.f / (lsum + xhalf(lsum));
    LAS float* xch = (LAS float*)(lds + XCH) + wq * 64 * 64 + lane;
    if (cm == 1) {
#pragma unroll
        for (int e = 0; e < 4; ++e)
#pragma unroll
            for (int i = 0; i < 16; ++i) xch[(e * 16 + i) * 64] = o[e][i] * linv;
    }
    __syncthreads();
    if (cm == 0) {
        const float lam = *(const LAS float*)(lds + LAMO);
        float ss = 0.f;
#pragma unroll
        for (int e = 0; e < 4; ++e)
#pragma unroll
            for (int i = 0; i < 16; ++i) { const float v = o[e][i] * linv - lam * xch[(e * 16 + i) * 64]; o[e][i] = v; ss += v * v; }
        ss += xhalf(ss);
        const float rn = __builtin_amdgcn_rsqf(ss * (1.f / VD) + RMS_EPS);
        const LAS float* sg = (const LAS float*)(lds + SUBG);
        LAS unsigned char* stg = lds + OST + wq * (32 * 272);
#pragma unroll
        for (int e = 0; e < 4; ++e)
#pragma unroll
            for (int i4 = 0; i4 < 4; ++i4) { const int e0 = 32 * e + 8 * i4 + 4 * hi;
                const f32x4 g4 = *(const LAS f32x4*)(sg + e0);
                u32x2 w; w.x = cvt_pk_bf16(o[e][4 * i4] * rn * g4[0], o[e][4 * i4 + 1] * rn * g4[1]); w.y = cvt_pk_bf16(o[e][4 * i4 + 2] * rn * g4[2], o[e][4 * i4 + 3] * rn * g4[3]);
                *(LAS u32x2*)(stg + r32 * 272 + e0 * 2) = w; }
        asm volatile("s_waitcnt lgkmcnt(0)" ::: "memory");
        bf16_t* Ow = O + ((size_t)(b * SEQ + qb * 128 + wq * 32)) * D + h * VD;
#pragma unroll
        for (int it = 0; it < 8; ++it) { const int id = it * 64 + lane, row = id >> 4, ch = id & 15;
            const u32x4 v = *(const LAS u32x4*)(stg + row * 272 + ch * 16);
            *(u32x4*)(Ow + (size_t)row * D + ch * 8) = v; }
    }
    __syncthreads();
}
}

#ifndef PH_MASK
#define PH_MASK 0xFFFFFFu
#endif
#ifndef REP_ATT
#define REP_ATT 1
#endif
#ifndef REP_P0
#define REP_P0 1
#endif
#define PH(k) if constexpr ((PH_MASK >> (k)) & 1u)
struct Args {
    const float *x, *c, *ctx, *c_ctx, *mod_w, *mod_b, *norm_g, *w_gu, *w_dn, *w_qkv, *w_o, *lam, *subg, *w_in, *w_out;
    float* out; unsigned char* ws;
};

__device__ __forceinline__ void transpose_item(const float* W, int K, int Nsrc, int Ndst, bf16_t* WT, int mode, LAS float* scr, int item, int lane) {
    const int nblk = Ndst / 32, kb = item / nblk, nb = item % nblk, k0 = 64 * kb, n0 = 32 * nb, i = lane & 31;
    int src;
    if (mode == 1 && n0 < 4096) src = n0 + ((i >> 2) & 1) * 16 + ((i >> 3) & 3) * 4 + (i & 3);
    else if (mode == 2) { const int tile = n0 >> 8, r0 = n0 & 255; src = (r0 < 128 ? tile * 128 + r0 : FF + tile * 128 + r0 - 128) + i; }
    else src = n0 + i;
#pragma unroll 8
    for (int q = 0; q < 32; ++q) { const int kk = 2 * q + (lane >> 5); scr[kk * 33 + i] = W[(size_t)(k0 + kk) * Nsrc + src]; }
    asm volatile("s_waitcnt lgkmcnt(0)" ::: "memory");
    const int c = lane & 7;
#pragma unroll
    for (int j = 0; j < 4; ++j) { const int n = (lane >> 3) + 8 * j; const LAS float* s = scr + (8 * c) * 33 + n;
        u32x4 o; o.x = cvt_pk_bf16(s[0 * 33], s[1 * 33]); o.y = cvt_pk_bf16(s[2 * 33], s[3 * 33]); o.z = cvt_pk_bf16(s[4 * 33], s[5 * 33]); o.w = cvt_pk_bf16(s[6 * 33], s[7 * 33]);
        *(u32x4*)(WT + (size_t)(n0 + n) * K + k0 + 8 * c) = o; }
    asm volatile("s_waitcnt lgkmcnt(0)" ::: "memory");
}

__device__ __forceinline__ void row_op(int lane, const bf16_t* y, const float* xin, const float* gate, const float* gy, float* xout,
                                       const float* gh, const float* sh, const float* sc, bf16_t* hb) {
    asm volatile("" : "+v"(lane));
    f32x4 v[8];
#pragma unroll
    for (int j = 0; j < 8; ++j) v[j] = *(const f32x4*)(xin + j * 256 + lane * 4);
    if (y) {
        u32x2 yw[8]; float ss = 0.f;
#pragma unroll
        for (int j = 0; j < 8; ++j) { yw[j] = *(const u32x2*)(y + j * 256 + lane * 4);
            const float a = bflo(yw[j].x), b = bfhi(yw[j].x), c = bflo(yw[j].y), d = bfhi(yw[j].y); ss += (a * a + b * b) + (c * c + d * d); }
        const float ry = __builtin_amdgcn_rsqf(wave_sum(ss) * (1.f / D) + RMS_EPS);
#pragma unroll
        for (int j = 0; j < 8; ++j) { const f32x4 g4 = *(const f32x4*)(gate + j * 256 + lane * 4), w4 = *(const f32x4*)(gy + j * 256 + lane * 4);
            const f32x4 yv = {bflo(yw[j].x), bfhi(yw[j].x), bflo(yw[j].y), bfhi(yw[j].y)};
            v[j] = v[j] + g4 * (yv * ry * w4); }
#pragma unroll
        for (int j = 0; j < 8; ++j) *(f32x4*)(xout + j * 256 + lane * 4) = v[j];
    }
    if (hb) {
        float ss = 0.f;
#pragma unroll
        for (int j = 0; j < 8; ++j) ss += (v[j].x * v[j].x + v[j].y * v[j].y) + (v[j].z * v[j].z + v[j].w * v[j].w);
        const float r = __builtin_amdgcn_rsqf(wave_sum(ss) * (1.f / D) + RMS_EPS);
#pragma unroll
        for (int j = 0; j < 8; ++j) { const f32x4 g4 = *(const f32x4*)(gh + j * 256 + lane * 4), s4 = *(const f32x4*)(sh + j * 256 + lane * 4), c4 = *(const f32x4*)(sc + j * 256 + lane * 4);
            const f32x4 hv = v[j] * r * g4 * (c4 + 1.f) + s4;
            u32x2 w; w.x = cvt_pk_bf16(hv.x, hv.y); w.y = cvt_pk_bf16(hv.z, hv.w);
            *(u32x2*)(hb + j * 256 + lane * 4) = w; }
    }
}

__global__ void __launch_bounds__(512, 2) fwd_megakernel(Args a) {
    extern __shared__ __attribute__((aligned(16))) unsigned char lds_raw[];
    LAS unsigned char* lds = (LAS unsigned char*)lds_raw;
    cg::grid_group grid = cg::this_grid();
    const int tid = threadIdx.x, lane = tid & 63, wave = __builtin_amdgcn_readfirstlane(tid >> 6);
    const int G = gridDim.x, bx = blockIdx.x;
    const int gw = bx * 8 + wave, NGW = G * 8;
#define WSB ({ unsigned char* _w = a.ws; asm volatile("" : "+s"(_w)); _w; })
#define ADA ((float*)(WSB + WS_ADA))
#define ROPE ((float*)(WSB + WS_ROPE))
#define D1T ((bf16_t*)(WSB + WS_D1))
#define D2T ((bf16_t*)(WSB + WS_D2))
#define CS2 ((bf16_t*)(WSB + WS_CS2))
#define TWT ((f32x2*)(WSB + WS_TW))
#define Wqkv ((bf16_t*)(WSB + WS_WQKV))
#define Wo ((bf16_t*)(WSB + WS_WO))
#define Win ((bf16_t*)(WSB + WS_WIN))
#define Wout ((bf16_t*)(WSB + WS_WOUT))
#define Wgu ((bf16_t*)(WSB + WS_WGU))
#define Wdn ((bf16_t*)(WSB + WS_WDN))
#define HB ((bf16_t*)(WSB + WS_HB))
#define YB ((bf16_t*)(WSB + WS_YB))
#define Qb ((bf16_t*)(WSB + WS_Q))
#define Kb ((bf16_t*)(WSB + WS_K))
#define Vb ((bf16_t*)(WSB + WS_V))
#define Ob ((bf16_t*)(WSB + WS_O))
#define HID ((bf16_t*)(WSB + WS_HID))
#define Ub ((bf16_t*)(WSB + WS_U))
#define A2b ((bf16_t*)(WSB + WS_A2))
#define Xb ((bf16_t*)(WSB + WS_X))
#define Fb ((bf16_t*)(WSB + WS_F))

    for (int rep0 = 0; rep0 < REP_P0; ++rep0) {
        LAS float* sl = (LAS float*)(lds + 69632);
        LAS float* red = (LAS float*)lds;
        if (bx < 192) {
            for (int i = tid; i < 5 * D; i += 512) { const float cv = (i < 4 * D) ? a.c[i] : a.c_ctx[i - 4 * D]; sl[i] = silu_f(cv); }
            __syncthreads();
            for (int it = bx; it < 192; it += G) {
                const int layer = it / 96, n0 = (it % 96) * 128;
                const float* wp = a.mod_w + (size_t)layer * D * 6 * D + (size_t)(wave * 256) * 6 * D + n0 + lane * 2;
                float ac[5][2];
#pragma unroll
                for (int r = 0; r < 5; ++r) { ac[r][0] = 0.f; ac[r][1] = 0.f; }
#pragma unroll 8
                for (int k = 0; k < 256; ++k) { const f32x2 w = *(const f32x2*)(wp + (size_t)k * 6 * D);
#pragma unroll
                    for (int r = 0; r < 5; ++r) { const float s = sl[r * D + wave * 256 + k]; ac[r][0] += s * w.x; ac[r][1] += s * w.y; } }
#pragma unroll
                for (int r = 0; r < 5; ++r) { red[(wave * 5 + r) * 128 + lane * 2] = ac[r][0]; red[(wave * 5 + r) * 128 + lane * 2 + 1] = ac[r][1]; }
                __syncthreads();
                for (int i = tid; i < 5 * 128; i += 512) { const int r = i >> 7, cc = i & 127; float s = a.mod_b[layer * 6 * D + n0 + cc];
#pragma unroll
                    for (int w = 0; w < 8; ++w) s += red[(w * 5 + r) * 128 + cc];
                    ADA[(size_t)(layer * 5 + r) * 6 * D + n0 + cc] = s; }
                __syncthreads();
            }
        }
        __syncthreads();
        LAS float* scr = (LAS float*)(lds + wave * 8704);
        constexpr int I_QKV = 32 * 192, I_SQ = 32 * 64, I_GU = 32 * 352, I_DN = 88 * 64;
        constexpr int NITEMS = I_QKV + 3 * I_SQ + 2 * I_GU + 2 * I_DN;
        for (int it = gw; it < NITEMS; it += NGW) {
            int r = it;
            if (r < I_QKV) { transpose_item(a.w_qkv, D, NQKV, NQKV, Wqkv, 1, scr, r, lane); continue; } r -= I_QKV;
            if (r < I_SQ) { transpose_item(a.w_o, D, D, D, Wo, 0, scr, r, lane); continue; } r -= I_SQ;
            if (r < I_SQ) { transpose_item(a.w_in, D, D, D, Win, 0, scr, r, lane); continue; } r -= I_SQ;
            if (r < I_SQ) { transpose_item(a.w_out, D, D, D, Wout, 0, scr, r, lane); continue; } r -= I_SQ;
            if (r < 2 * I_GU) { const int l = r / I_GU; transpose_item(a.w_gu + (size_t)l * D * NGU, D, NGU, NGU, Wgu + (size_t)l * NGU * D, 2, scr, r % I_GU, lane); continue; } r -= 2 * I_GU;
            { const int l = r / I_DN; transpose_item(a.w_dn + (size_t)l * FF * D, FF, D, D, Wdn + (size_t)l * D * FF, 0, scr, r % I_DN, lane); }
        }
        const int gt = bx * 512 + tid, NGT = G * 512;
        if (gt < 1024) { const int pos = gt >> 4, f = gt & 15; const float inv = powf(10000.f, -(float)f / 16.f); const float ang = (float)pos * inv;
            ROPE[gt] = cosf(ang); ROPE[1024 + gt] = sinf(ang); }
        for (int i = gt; i < 256 * 128; i += NGT) { const int m = i >> 7, k = i & 127, part = m >> 7, rp = (m >> 6) & 1, k1 = m & 63, rp2 = k >> 6, aa = k & 63;
            float sv, cv; sincospif((float)((k1 * aa) & 63) * (1.f / 32.f), &sv, &cv); const float v = (rp == rp2) ? (part ? -sv : cv) * 0.125f : 0.f;
            D1T[i] = (bf16_t)(cvt_pk_bf16(v, v) & 0xffffu); }
        for (int i = gt; i < 256 * 256; i += NGT) { const int m = i >> 8, k = i & 255, kp = m >> 7, po = (m >> 6) & 1, k2 = m & 63, kp2 = k >> 7, part = (k >> 6) & 1, rp = (k >> 5) & 1, r = 2 * (k & 31) + rp;
            float sv, cv; sincospif((float)((k2 * r) & 63) * (1.f / 32.f), &sv, &cv);
            const float v = (kp == kp2) ? (po == 0 ? (part == 0 ? cv : sv) : (part == 0 ? -sv : cv)) * 0.125f : 0.f;
            D2T[i] = (bf16_t)(cvt_pk_bf16(v, v) & 0xffffu); }
        for (int i = gt; i < 256 * 512; i += NGT) { const int kc = i >> 9, k = i & 511, part = k >> 8, cc = k & 255;
            float sv, cv; sincospif((float)((kc * cc) & 255) * (1.f / 128.f), &sv, &cv); const float v = (part ? sv : cv) * (1.f / 16.f);
            CS2[i] = (bf16_t)(cvt_pk_bf16(v, v) & 0xffffu); }
        for (int i = gt; i < 4096; i += NGT) { float sv, cv; sincospif((float)i * (1.f / 2048.f), &sv, &cv); TWT[i] = (f32x2){cv, sv}; }
    }
    grid.sync();

    for (int row = gw; row < MT; row += NGW) {
        const bool lat = row < M; const int r = lat ? (row >> 12) : 4;
        const float* xin = lat ? a.x + (size_t)row * D : a.ctx + (size_t)(row - M) * D;
        const float* ad = ADA + (size_t)r * 6 * D;
        row_op(lane, nullptr, xin, nullptr, nullptr, nullptr, a.norm_g, ad, ad + D, HB + (size_t)row * D);
    }
    grid.sync();

    PH(0) { pg8::Gemm g{HB, Wqkv, D, D, D}; pg8::SchedQKV S{G, bx}; pg8::EpiQKV E{Qb, Kb, Vb, ROPE};
      pg8::gemm_phase(lds, g, S, E); }
    grid.sync();

    {
        if (tid < 128) ((LAS float*)(lds + att::SUBG))[tid] = a.subg[tid] * 0.8f;
        if (wave == 0) { const float p01 = wave_sum(a.lam[lane] * a.lam[64 + lane]), p23 = wave_sum(a.lam[128 + lane] * a.lam[192 + lane]);
            if (lane == 0) *(LAS float*)(lds + att::LAMO) = expf(p01) - expf(p23) + 0.2f; }
        __syncthreads();
        for (int rep = 0; rep < REP_ATT; ++rep)
        if (G == 256) { for (int i = 0; i < 8; ++i) { const int bh = (bx & 7) * 8 + i, qb = bx >> 3; att::attn_unit(bh >> 4, bh & 15, qb, Qb, Kb, Vb, Ob, lds); } }
        else { for (int u = bx; u < 2048; u += G) { const int bh = u >> 5, qb = u & 31; att::attn_unit(bh >> 4, bh & 15, qb, Qb, Kb, Vb, Ob, lds); } }
    }
    grid.sync();

    PH(1) { pg8::Gemm g{Ob, Wo, D, D, D}; pg8::SchedStd S{64, 8, G, bx, D, D, D}; pg8::EpiPlain E{YB, D}; pg8::gemm_phase(lds, g, S, E); }
    grid.sync();

    for (int row = gw; row < M; row += NGW) { const float* ad = ADA + (size_t)(row >> 12) * 6 * D;
        row_op(lane, YB + (size_t)row * D, a.x + (size_t)row * D, ad + 2 * D, a.norm_g + D, a.out + (size_t)row * D, a.norm_g + 2 * D, ad + 3 * D, ad + 4 * D, HB + (size_t)row * D); }
    grid.sync();

    PH(2) { pg8::Gemm g{HB, Wgu, D, D, D}; pg8::SchedStd S{64, 44, G, bx, D, D, 0}; pg8::EpiSwiGLU E{HID}; pg8::gemm_phase(lds, g, S, E); }
    grid.sync();
    PH(3) { pg8::Gemm g{HID, Wdn, FF, FF, FF}; pg8::SchedStd S{64, 8, G, bx, FF, FF, D}; pg8::EpiPlain E{YB, D}; pg8::gemm_phase(lds, g, S, E); }
    grid.sync();

    for (int row = gw; row < M; row += NGW) { const float* ad = ADA + (size_t)(row >> 12) * 6 * D; const float* ad1 = ADA + (size_t)(5 + (row >> 12)) * 6 * D;
        row_op(lane, YB + (size_t)row * D, a.out + (size_t)row * D, ad + 5 * D, a.norm_g + 3 * D, a.out + (size_t)row * D, a.norm_g + 4 * D, ad1, ad1 + D, HB + (size_t)((row & ~4095) + (row & 63) * 64 + ((row & 4095) >> 6)) * D); }
    grid.sync();

    PH(4) { pg8::Gemm g{Win, HB, D, D, D}; pg8::SchedInT S{G, bx}; pg8::EpiPlain E{Ub, SEQ}; pg8::gemm_phase(lds, g, S, E); }
    grid.sync();
    PH(5) { pg8::Gemm g{D1T, Ub, 128, 128, 128}; pg8::SchedCols S{G, bx, 1024, 128}; pg8::EpiFft1 E{A2b, TWT}; pg8::gemm_phase(lds, g, S, E); }
    grid.sync();
    PH(6) { pg8::Gemm g{D2T, A2b, 256, 256, 256}; pg8::SchedCols S{G, bx, 1024, 256}; pg8::EpiFft2 E{Xb}; pg8::gemm_phase(lds, g, S, E); }
    grid.sync();
    PH(10) { pg8::Gemm g{Xb, CS2, 4096, 512, 512}; pg8::SchedChan S{G, bx}; pg8::EpiPlain E{Fb, D}; pg8::gemm_phase(lds, g, S, E); }
    grid.sync();
    PH(7) { pg8::Gemm g{Fb, Wout, D, D, D}; pg8::SchedStd S{64, 8, G, bx, D, D, D}; pg8::EpiPlain E{YB, D}; pg8::gemm_phase(lds, g, S, E); }
    grid.sync();

    for (int row = gw; row < M; row += NGW) { const float* ad = ADA + (size_t)(5 + (row >> 12)) * 6 * D; const float* ng = a.norm_g + 4 * D;
        row_op(lane, YB + (size_t)row * D, a.out + (size_t)row * D, ad + 2 * D, ng + D, a.out + (size_t)row * D, ng + 2 * D, ad + 3 * D, ad + 4 * D, HB + (size_t)row * D); }
    grid.sync();

    PH(8) { pg8::Gemm g{HB, Wgu + (size_t)NGU * D, D, D, D}; pg8::SchedStd S{64, 44, G, bx, D, D, 0}; pg8::EpiSwiGLU E{HID}; pg8::gemm_phase(lds, g, S, E); }
    grid.sync();
    PH(9) { pg8::Gemm g{HID, Wdn + (size_t)D * FF, FF, FF, FF}; pg8::SchedStd S{64, 8, G, bx, FF, FF, D}; pg8::EpiPlain E{YB, D}; pg8::gemm_phase(lds, g, S, E); }
    grid.sync();

    for (int row = gw; row < M; row += NGW) { const float* ad = ADA + (size_t)(5 + (row >> 12)) * 6 * D; const float* ng = a.norm_g + 4 * D;
        row_op(lane, YB + (size_t)row * D, a.out + (size_t)row * D, ad + 5 * D, ng + 3 * D, a.out + (size_t)row * D, nullptr, nullptr, nullptr, nullptr); }
}

extern "C" void kernel_launch(void* const* d_in, const int* in_sizes, int n_in, void* d_out, int out_size, void* d_ws, size_t ws_size, hipStream_t stream) {
    static int grid = 0;
    if (grid == 0) {
        if (n_in != 15 || in_sizes[0] != M * D || out_size != M * D || ws_size < WS_END) {
            fprintf(stderr, "kernel_launch: unexpected shapes / workspace (n_in %d, in0 %d, out %d, ws %zu, need %zu)\n", n_in, n_in > 0 ? in_sizes[0] : -1, out_size, ws_size, (size_t)WS_END);
            grid = -1; return; }
        int dev = 0, cus = 0, per_cu = 0;
        hipGetDevice(&dev);
        hipDeviceGetAttribute(&cus, hipDeviceAttributeMultiprocessorCount, dev);
        if (hipFuncSetAttribute((const void*)fwd_megakernel, hipFuncAttributeMaxDynamicSharedMemorySize, LDS_BYTES) != hipSuccess) { fprintf(stderr, "kernel_launch: hipFuncSetAttribute failed\n"); grid = -1; return; }
        hipOccupancyMaxActiveBlocksPerMultiprocessor(&per_cu, (const void*)fwd_megakernel, 512, LDS_BYTES);
        if (per_cu < 1) { fprintf(stderr, "kernel_launch: occupancy query says %d blocks per CU\n", per_cu); per_cu = 1; }
        (void)hipGetLastError();
        grid = cus * 1;
    }
    if (grid < 0) return;
    Args a{};
    a.x = (const float*)d_in[0]; a.c = (const float*)d_in[1]; a.ctx = (const float*)d_in[2]; a.c_ctx = (const float*)d_in[3];
    a.mod_w = (const float*)d_in[4]; a.mod_b = (const float*)d_in[5]; a.norm_g = (const float*)d_in[6]; a.w_gu = (const float*)d_in[7]; a.w_dn = (const float*)d_in[8];
    a.w_qkv = (const float*)d_in[9]; a.w_o = (const float*)d_in[10]; a.lam = (const float*)d_in[11]; a.subg = (const float*)d_in[12]; a.w_in = (const float*)d_in[13]; a.w_out = (const float*)d_in[14];
    a.out = (float*)d_out; a.ws = (unsigned char*)d_ws;
    void* args[] = {&a};
    hipError_t e = hipLaunchCooperativeKernel((const void*)fwd_megakernel, dim3(grid), dim3(512), args, LDS_BYTES, stream);
    if (e != hipSuccess) fprintf(stderr, "cooperative launch failed: %s (grid %d)\n", hipGetErrorString(e), grid);
}
```

```cpp
#include <hip/hip_runtime.h>
#include <hip/hip_cooperative_groups.h>
#include <cstdio>
#include <cstdint>
namespace cg = cooperative_groups;

#define LAS __attribute__((address_space(3)))
typedef unsigned short bf16_t;
typedef short bf16x8 __attribute__((ext_vector_type(8)));
typedef short s16x4 __attribute__((ext_vector_type(4)));
typedef float f32x4 __attribute__((ext_vector_type(4)));
typedef float f32x2 __attribute__((ext_vector_type(2)));
typedef float f32x16 __attribute__((ext_vector_type(16)));
typedef unsigned u32x4 __attribute__((ext_vector_type(4)));
typedef unsigned u32x2 __attribute__((ext_vector_type(2)));

constexpr int D = 2048, NB = 4, SEQ = 4096, M = NB * SEQ, LC = 256, MC = NB * LC, MT = M + MC;
constexpr int NH = 16, HD = 64, VD = 128, NQKV = 6144, FF = 5632, NGU = 2 * FF, SK = SEQ + LC;
constexpr float RMS_EPS = 1e-6f;
constexpr float QSCALE = 0.125f * 1.4426950408889634f;

constexpr size_t MiB = 1u << 20;
constexpr size_t WS_ADA = 1 * MiB;
constexpr size_t WS_ROPE = 1 * MiB + 768 * 1024;
constexpr size_t WS_D1 = 2 * MiB;
constexpr size_t WS_D2 = 2 * MiB + 64 * 1024;
constexpr size_t WS_CS2 = 2 * MiB + 192 * 1024;
constexpr size_t WS_TW = 2 * MiB + 448 * 1024;
constexpr size_t WS_WQKV = 3 * MiB;
constexpr size_t WS_WO = 27 * MiB;
constexpr size_t WS_WIN = 35 * MiB;
constexpr size_t WS_WOUT = 43 * MiB;
constexpr size_t WS_WGU = 51 * MiB;
constexpr size_t WS_WDN = 139 * MiB;
constexpr size_t WS_HB = 183 * MiB;
constexpr size_t WS_YB = 251 * MiB;
constexpr size_t WS_R = 315 * MiB;
constexpr size_t WS_Q = WS_R;
constexpr size_t WS_K = WS_R + 64 * MiB;
constexpr size_t WS_V = WS_R + 132 * MiB;
constexpr size_t WS_O = WS_R + 200 * MiB;
constexpr size_t WS_HID = WS_R;
constexpr size_t WS_U = WS_R + 200 * MiB;
constexpr size_t WS_A2 = WS_R;
constexpr size_t WS_X = WS_R + 128 * MiB;
constexpr size_t WS_F = WS_R;
constexpr size_t WS_END = WS_R + 264 * MiB;

constexpr int LDS_BYTES = 147456;

typedef __bf16 bf16x2_t __attribute__((ext_vector_type(2)));
__device__ __forceinline__ unsigned cvt_pk_bf16(float lo, float hi) { const f32x2 v = {lo, hi}; const bf16x2_t b = __builtin_convertvector(v, bf16x2_t); return __builtin_bit_cast(unsigned, b); }
__device__ __forceinline__ float bf2f(unsigned short b) { return __uint_as_float(((unsigned)b) << 16); }
__device__ __forceinline__ float bflo(unsigned w) { return __uint_as_float(w << 16); }
__device__ __forceinline__ float bfhi(unsigned w) { return __uint_as_float(w & 0xffff0000u); }
__device__ __forceinline__ float wave_sum(float v) {
#pragma unroll
    for (int o = 1; o < 64; o <<= 1) v += __shfl_xor(v, o);
    return v;
}
__device__ __forceinline__ float silu_f(float v) { return v / (1.f + __expf(-v)); }

namespace pg8 {
constexpr int BM = 256, BK = 64, HALF = 128, HTB = HALF * BK * 2, NXCD = 8, WGM = 8;
__host__ __device__ __forceinline__ int lds_byte(int r, int c) { const int st = (r >> 4) * 2 + (c >> 5), rr = r & 15, cc = c & 31, ob = rr * 64 + cc * 2; return st * 1024 + (ob ^ (((ob >> 9) & 1) << 5)); }
__host__ __device__ __forceinline__ void stage_rc(int b, int& R, int& C) { const int st = b / 1024, sb = b % 1024, swz = sb ^ (((sb >> 9) & 1) << 5); R = (st >> 1) * 16 + swz / 64; C = (st & 1) * 32 + (swz % 64) / 2; }
__host__ __device__ __forceinline__ int perm32(int rho) { const int n = rho >> 4, i = rho & 15; return 8 * (i >> 2) + 4 * n + (i & 3); }

struct Unit { int pm, pn; size_t aoff, boff, coff; };
struct Gemm { const bf16_t* A; const bf16_t* Bt; int lda, ldb, K; };

__device__ __forceinline__ void swz_order(int L, int nM, int nN, int& pm, int& pn) {
    const int nwg = nM * nN; int wgid = L;
    { const int q = nwg / NXCD, r = nwg % NXCD, xcd = wgid % NXCD, off = wgid / NXCD; wgid = (xcd < r ? xcd * (q + 1) : r * (q + 1) + (xcd - r) * q) + off; }
    const int nig = WGM * nN, gid = wgid / nig, fm = gid * WGM, gsz = (nM - fm) < WGM ? (nM - fm) : WGM;
    pm = fm + ((wgid % nig) % gsz); pn = (wgid % nig) / gsz;
}

template <class Epi, class Sched>
__device__ __forceinline__ void gemm_phase(LAS unsigned char* lds, const Gemm g, const Sched& S, const Epi& E) {
    int tid = threadIdx.x; asm volatile("" : "+v"(tid));
    const int wid = __builtin_amdgcn_readfirstlane(tid >> 6), lane = tid & 63, wr = wid >> 2, wc = wid & 3, fr = lane & 15, fq = lane >> 4;
    int nt = g.K / BK; asm volatile("" : "+s"(nt));
    unsigned voffA[2], voffB[2];
#pragma unroll
    for (int i = 0; i < 2; ++i) { int R, C; stage_rc(tid * 16 + i * 8192, R, C); const int Rb = (R & ~31) + perm32(R & 31);
        voffA[i] = (unsigned)(R * g.lda + C) * 2u; voffB[i] = (unsigned)(Rb * g.ldb + C) * 2u; }
    const size_t kstep = (size_t)(BK * 2);
    const size_t hstepA = (size_t)HALF * g.lda * 2, hstepB = (size_t)HALF * g.ldb * 2;
    const unsigned ldsw = (unsigned)wid * 1024u;
    const int aoff = lds_byte(wr * 64 + fr, fq * 8), boff = lds_byte(wc * 32 + fr, fq * 8);
#define PG8_SA(b, h) (((b) * 2 + (h)) * HTB)
#define PG8_SB(b, h) ((4 + (b) * 2 + (h)) * HTB)
#define PG8_STAGE(bufoff, gbase, voff) do { _Pragma("unroll") for (int _i = 0; _i < 2; ++_i) \
        __builtin_amdgcn_global_load_lds((const unsigned*)((const char*)(gbase) + (voff)[_i]), (LAS unsigned*)(lds + (bufoff) + ldsw + _i * 8192), 16, 0, 0); } while (0)
#define PG8_LDA(dst, b, h) do { _Pragma("unroll") for (int m = 0; m < 4; ++m) _Pragma("unroll") for (int k = 0; k < 2; ++k) dst[m][k] = *(const LAS bf16x8*)(lds + PG8_SA(b, h) + aoff + m * 2048 + k * 1024); } while (0)
#define PG8_LDB(dst, b, h) do { _Pragma("unroll") for (int n = 0; n < 2; ++n) _Pragma("unroll") for (int k = 0; k < 2; ++k) dst[n][k] = *(const LAS bf16x8*)(lds + PG8_SB(b, h) + boff + n * 2048 + k * 1024); } while (0)
#define PG8_MMA(ai, bj, At, Bt) do { __builtin_amdgcn_s_setprio(1); _Pragma("unroll") for (int m = 0; m < 4; ++m) _Pragma("unroll") for (int n = 0; n < 2; ++n) _Pragma("unroll") for (int k = 0; k < 2; ++k) \
        acc[ai][bj][m][n] = __builtin_amdgcn_mfma_f32_16x16x32_bf16(Bt[n][k], At[m][k], acc[ai][bj][m][n], 0, 0, 0); __builtin_amdgcn_s_setprio(0); } while (0)
#define PG8_WAIT_V(n) asm volatile("s_waitcnt vmcnt(" #n ")" ::: "memory")
#define PG8_WAIT_L(n) asm volatile("s_waitcnt lgkmcnt(" #n ")" ::: "memory")
#define PG8_BAR __builtin_amdgcn_s_barrier()
#define PG8_SCHED __builtin_amdgcn_sched_barrier(0)
    Unit cur, nxt; int ui = 0;
    if (!S.next(0, cur)) return;
    f32x4 acc[2][2][4][2];
#pragma unroll
    for (int a = 0; a < 2; ++a)
#pragma unroll
        for (int b = 0; b < 2; ++b)
#pragma unroll
            for (int m = 0; m < 4; ++m)
#pragma unroll
                for (int n = 0; n < 2; ++n) acc[a][b][m][n] = (f32x4){0.f, 0.f, 0.f, 0.f};
    bf16x8 At[4][2], B0[2][2], B1[2][2];
    const char* cA = (const char*)g.A + cur.aoff; const char* cB = (const char*)g.Bt + cur.boff;
    PG8_STAGE(PG8_SB(0, 0), cB, voffB); PG8_STAGE(PG8_SB(0, 1), cB + hstepB, voffB); PG8_STAGE(PG8_SA(0, 0), cA, voffA); PG8_STAGE(PG8_SA(0, 1), cA + hstepA, voffA);
    if (wr == 1) PG8_BAR;
    PG8_WAIT_V(2); PG8_BAR;
    PG8_STAGE(PG8_SB(1, 0), cB + kstep, voffB); PG8_STAGE(PG8_SA(1, 0), cA + kstep, voffA); PG8_STAGE(PG8_SB(1, 1), cB + hstepB + kstep, voffB);
    PG8_WAIT_V(6); PG8_BAR;
    for (;;) {
        const bool has_next = S.next(ui + 1, nxt);
        const char* nA = has_next ? (const char*)g.A + nxt.aoff : cA; const char* nB = has_next ? (const char*)g.Bt + nxt.boff : cB;
        for (int t = 0; t < nt; t += 2) {
            const bool last = (t == nt - 2);
            const char* a1 = cA + (size_t)(t + 1) * kstep;
            const char* a2 = last ? nA : cA + (size_t)(t + 2) * kstep; const char* b2 = last ? nB : cB + (size_t)(t + 2) * kstep;
            const char* a3 = a2 + kstep; const char* b3 = b2 + kstep;
            PG8_LDB(B0, 0, 0); PG8_LDB(B1, 0, 1); PG8_SCHED; PG8_LDA(At, 0, 0); PG8_STAGE(PG8_SA(1, 1), a1 + hstepA, voffA);
            PG8_WAIT_V(8); PG8_WAIT_L(0); PG8_BAR; PG8_MMA(0, 0, At, B0); PG8_MMA(0, 1, At, B1); PG8_BAR; PG8_SCHED;
            PG8_LDA(At, 0, 1); PG8_STAGE(PG8_SB(0, 0), b2, voffB); PG8_STAGE(PG8_SB(0, 1), b2 + hstepB, voffB); PG8_STAGE(PG8_SA(0, 0), a2, voffA);
            PG8_WAIT_V(8); PG8_WAIT_L(0); PG8_BAR; PG8_MMA(1, 0, At, B0); PG8_MMA(1, 1, At, B1); PG8_BAR; PG8_SCHED;
            PG8_LDB(B0, 1, 0); PG8_LDB(B1, 1, 1); PG8_SCHED; PG8_LDA(At, 1, 0); PG8_STAGE(PG8_SA(0, 1), a2 + hstepA, voffA);
            PG8_WAIT_V(8); PG8_WAIT_L(0); PG8_BAR; PG8_MMA(0, 0, At, B0); PG8_MMA(0, 1, At, B1); PG8_BAR; PG8_SCHED;
            PG8_LDA(At, 1, 1); PG8_STAGE(PG8_SB(1, 0), b3, voffB); PG8_STAGE(PG8_SB(1, 1), b3 + hstepB, voffB); PG8_STAGE(PG8_SA(1, 0), a3, voffA);
            PG8_WAIT_V(8); PG8_WAIT_L(0); PG8_BAR; PG8_MMA(1, 0, At, B0); PG8_MMA(1, 1, At, B1); PG8_BAR; PG8_SCHED;
        }
        if (wr == 0) PG8_BAR;
        { int t2 = threadIdx.x; asm volatile("" : "+v"(t2)); const int fr2 = t2 & 15, fq2 = (t2 >> 4) & 3;
          E(acc, cur, wr, wc, fr2, fq2); }
        if (!has_next) break;
#pragma unroll
        for (int a = 0; a < 2; ++a)
#pragma unroll
            for (int b = 0; b < 2; ++b)
#pragma unroll
                for (int m = 0; m < 4; ++m)
#pragma unroll
                    for (int n = 0; n < 2; ++n) acc[a][b][m][n] = (f32x4){0.f, 0.f, 0.f, 0.f};
        cur = nxt; cA = nA; cB = nB; ++ui;
        if (wr == 1) PG8_BAR;
    }
    PG8_WAIT_V(0);
    PG8_BAR;
#undef PG8_SA
#undef PG8_SB
#undef PG8_STAGE
#undef PG8_LDA
#undef PG8_LDB
#undef PG8_MMA
#undef PG8_WAIT_V
#undef PG8_WAIT_L
#undef PG8_BAR
#undef PG8_SCHED
}

struct SchedStd {
    int nM, nN, G, c, lda, ldb, ldc;
    __device__ __forceinline__ bool next(int i, Unit& u) const {
        const int L = i * G + c; if (L >= nM * nN) return false;
        swz_order(L, nM, nN, u.pm, u.pn);
        u.aoff = (size_t)u.pm * BM * lda * 2; u.boff = (size_t)u.pn * BM * ldb * 2; u.coff = (size_t)u.pm * BM * ldc + (size_t)u.pn * BM; return true;
    }
};
struct SchedQKV {
    int G, c;
    __device__ __forceinline__ bool next(int i, Unit& u) const {
        const int L = i * G + c; if (L >= 1536 + 64) return false;
        if (L < 1536) swz_order(L, 64, 24, u.pm, u.pn); else { const int l2 = L - 1536; u.pm = 64 + (l2 & 3); u.pn = 8 + (l2 >> 2); }
        u.aoff = (size_t)u.pm * BM * D * 2; u.boff = (size_t)u.pn * BM * D * 2; u.coff = 0; return true;
    }
};
struct SchedInT {
    int G, c;
    __device__ __forceinline__ bool next(int i, Unit& u) const {
        const int L = i * G + c; if (L >= 512) return false;
        swz_order(L, 8, 64, u.pm, u.pn);
        u.aoff = (size_t)u.pm * BM * D * 2; u.boff = (size_t)u.pn * BM * D * 2;
        u.coff = ((size_t)((u.pn >> 4) * D + u.pm * BM)) * SEQ + (u.pn & 15) * BM; return true;
    }
};
struct SchedCols {
    int G, c, nU, ldb;
    __device__ __forceinline__ bool next(int i, Unit& u) const {
        const int L = i * G + c; if (L >= nU) return false;
        size_t z = 0; asm volatile("" : "+s"(z));
        u.pm = 0; u.pn = L; u.aoff = z; u.boff = (size_t)L * BM * ldb * 2; u.coff = 0; return true;
    }
};
struct SchedChan {
    int G, c;
    __device__ __forceinline__ bool next(int i, Unit& u) const {
        const int L = i * G + c; if (L >= 512) return false;
        u.pm = L >> 3; u.pn = L & 7;
        size_t z = 0; asm volatile("" : "+s"(z));
        u.aoff = ((size_t)u.pm * BM * 4096 + u.pn * 512) * 2; u.boff = z; u.coff = (size_t)u.pm * BM * D + u.pn * BM; return true;
    }
};

struct EpiPlain {
    bf16_t* O; int ldc;
    __device__ __forceinline__ void operator()(const f32x4 (&acc)[2][2][4][2], const Unit& u, int wr, int wc, int fr, int fq) const {
        bf16_t* base = O + u.coff + (size_t)(wr * 64 + fr) * ldc + wc * 32 + 8 * fq;
#pragma unroll
        for (int ai = 0; ai < 2; ++ai)
#pragma unroll
            for (int m = 0; m < 4; ++m) { bf16_t* rowp = base + (size_t)(ai * HALF + m * 16) * ldc;
#pragma unroll
                for (int bj = 0; bj < 2; ++bj) { const f32x4 v0 = acc[ai][bj][m][0], v1 = acc[ai][bj][m][1];
                    u32x4 w; w.x = cvt_pk_bf16(v0[0], v0[1]); w.y = cvt_pk_bf16(v0[2], v0[3]); w.z = cvt_pk_bf16(v1[0], v1[1]); w.w = cvt_pk_bf16(v1[2], v1[3]);
                    *(u32x4*)(rowp + bj * HALF) = w; } }
    }
};
struct EpiSwiGLU {
    bf16_t* O;
    __device__ __forceinline__ void operator()(const f32x4 (&acc)[2][2][4][2], const Unit& u, int wr, int wc, int fr, int fq) const {
        bf16_t* base = O + (size_t)(u.pm * BM + wr * 64 + fr) * FF + u.pn * 128 + wc * 32 + 8 * fq;
#pragma unroll
        for (int ai = 0; ai < 2; ++ai)
#pragma unroll
            for (int m = 0; m < 4; ++m) { bf16_t* rowp = base + (size_t)(ai * HALF + m * 16) * FF;
                float o[8];
#pragma unroll
                for (int n = 0; n < 2; ++n)
#pragma unroll
                    for (int j = 0; j < 4; ++j) { const float gv = acc[ai][0][m][n][j], uv = acc[ai][1][m][n][j];
                        o[n * 4 + j] = gv * uv * __builtin_amdgcn_rcpf(1.f + __builtin_amdgcn_exp2f(-1.4426950408889634f * gv)); }
                u32x4 w; w.x = cvt_pk_bf16(o[0], o[1]); w.y = cvt_pk_bf16(o[2], o[3]); w.z = cvt_pk_bf16(o[4], o[5]); w.w = cvt_pk_bf16(o[6], o[7]);
                *(u32x4*)rowp = w; }
    }
};
struct EpiFft1 {
    bf16_t* A2; const f32x2* tw;
    __device__ __forceinline__ void operator()(const f32x4 (&acc)[2][2][4][2], const Unit& u, int wr, int wc, int fr, int fq) const {
#pragma unroll
        for (int bj = 0; bj < 2; ++bj) { const int gcol = u.pn * 8 + 4 * bj + wc, b = gcol >> 11, col = gcol & 2047;
#pragma unroll
            for (int m = 0; m < 4; ++m) { const int k1 = 16 * m + fr; float re[8], im[8];
#pragma unroll
                for (int n = 0; n < 2; ++n)
#pragma unroll
                    for (int j = 0; j < 4; ++j) { const int r = 2 * (8 * fq + 4 * n + j) + wr; const f32x2 t = tw[k1 * r];
                        const float ar = acc[0][bj][m][n][j], ai = acc[1][bj][m][n][j];
                        re[n * 4 + j] = ar * t.x + ai * t.y; im[n * 4 + j] = ai * t.x - ar * t.y; }
                bf16_t* dst = A2 + (((size_t)(b * 32 + (k1 >> 1)) * D + col) * 256) + (k1 & 1) * 128 + wr * 32 + 8 * fq;
                u32x4 w; w.x = cvt_pk_bf16(re[0], re[1]); w.y = cvt_pk_bf16(re[2], re[3]); w.z = cvt_pk_bf16(re[4], re[5]); w.w = cvt_pk_bf16(re[6], re[7]);
                *(u32x4*)dst = w;
                w.x = cvt_pk_bf16(im[0], im[1]); w.y = cvt_pk_bf16(im[2], im[3]); w.z = cvt_pk_bf16(im[4], im[5]); w.w = cvt_pk_bf16(im[6], im[7]);
                *(u32x4*)(dst + 64) = w; } }
    }
};
struct EpiFft2 {
    bf16_t* X;
    __device__ __forceinline__ void operator()(const f32x4 (&acc)[2][2][4][2], const Unit& u, int wr, int wc, int fr, int fq) const {
        const int bk = u.pn >> 3, b = bk >> 5, k1p = bk & 31, gq = u.pn & 7;
#pragma unroll
        for (int ai = 0; ai < 2; ++ai)
#pragma unroll
            for (int m = 0; m < 4; ++m) { const int k2 = 16 * m + fr, tok = b * SEQ + 2 * k1p + ai + 64 * k2;
                bf16_t* rowp = X + (size_t)tok * 4096 + gq * 512 + wr * 256 + wc * 32 + 8 * fq;
#pragma unroll
                for (int bj = 0; bj < 2; ++bj) { const f32x4 v0 = acc[ai][bj][m][0], v1 = acc[ai][bj][m][1];
                    u32x4 w; w.x = cvt_pk_bf16(v0[0], v0[1]); w.y = cvt_pk_bf16(v0[2], v0[3]); w.z = cvt_pk_bf16(v1[0], v1[1]); w.w = cvt_pk_bf16(v1[2], v1[3]);
                    *(u32x4*)(rowp + bj * HALF) = w; } }
    }
};
struct EpiQKV {
    bf16_t *Q, *K, *V; const float* rope;
    __device__ __forceinline__ void operator()(const f32x4 (&acc)[2][2][4][2], const Unit& u, int wr, int wc, int fr, int fq) const {
        const int sec = u.pn >> 3, h0 = (u.pn & 7) * 2;
        const bool latent = u.pm < 64;
        const int b = latent ? (u.pm >> 4) : (u.pm - 64);
        const int tok0 = (latent ? (u.pm & 15) * 256 : SEQ) + wr * 64 + fr;
        const int cm = wc >> 1, axis = wc & 1;
#pragma unroll
        for (int ai = 0; ai < 2; ++ai)
#pragma unroll
            for (int m = 0; m < 4; ++m) {
                const int tok = tok0 + ai * HALF + m * 16;
                f32x4 c4 = {1.f, 1.f, 1.f, 1.f}, s4 = {0.f, 0.f, 0.f, 0.f};
                if (sec < 2 && latent) { const int pos = axis ? (tok & 63) : (tok >> 6); c4 = *(const f32x4*)(rope + pos * 16 + 4 * fq); s4 = *(const f32x4*)(rope + 1024 + pos * 16 + 4 * fq); }
#pragma unroll
                for (int bj = 0; bj < 2; ++bj) {
                    const int h = h0 + bj;
                    f32x4 v0 = acc[ai][bj][m][0], v1 = acc[ai][bj][m][1];
                    bf16_t* dst;
                    if (sec < 2) {
                        const f32x4 a = v0 * c4 - v1 * s4, bb = v1 * c4 + v0 * s4; v0 = a; v1 = bb;
                        if (sec == 0) { v0 = v0 * QSCALE; v1 = v1 * QSCALE; dst = Q + ((size_t)(((b * NH + h) * 2 + cm) * SEQ + tok)) * HD + axis * 32 + 8 * fq; }
                        else dst = K + ((size_t)(((b * NH + h) * 2 + cm) * SK + tok)) * HD + axis * 32 + 8 * fq;
                    } else dst = V + ((size_t)((b * NH + h) * SK + tok)) * VD + wc * 32 + 8 * fq;
                    u32x4 w; w.x = cvt_pk_bf16(v0[0], v0[1]); w.y = cvt_pk_bf16(v0[2], v0[3]); w.z = cvt_pk_bf16(v1[0], v1[1]); w.w = cvt_pk_bf16(v1[2], v1[3]);
                    *(u32x4*)dst = w;
                }
            }
    }
};
}

namespace att {
constexpr int NT = SK / 64;
constexpr int PD = 3, NS = PD + 1;
constexpr int KSL = 16384, VSL = 16384;
constexpr int KR = 0, VR = NS * KSL;
constexpr int XCH = 0, OST = 65536, SUBG = 132 * 1024, LAMO = SUBG + 512;
static_assert(VR + NS * VSL <= SUBG, "attention rings overlap the constants");
constexpr float THR = 8.f;
__device__ __forceinline__ float xmax(float v) { auto rr = __builtin_amdgcn_permlane32_swap(__float_as_uint(v), __float_as_uint(v), false, false); return fmaxf(__uint_as_float(rr[0]), __uint_as_float(rr[1])); }
__device__ __forceinline__ float xsum(float v) { auto rr = __builtin_amdgcn_permlane32_swap(__float_as_uint(v), __float_as_uint(v), false, false); return __uint_as_float(rr[0]) + __uint_as_float(rr[1]); }
#define MX3(a, b, c) __builtin_fmaxf(__builtin_fmaxf((a), (b)), (c))

__device__ __forceinline__ void attn_unit(int b, int h, int qb, const bf16_t* Q, const bf16_t* K, const bf16_t* V, bf16_t* O, LAS unsigned char* lds) {
    int tid = threadIdx.x; asm volatile("" : "+v"(tid));
    const int lane = tid & 63, r32 = lane & 31, hi = lane >> 5; const int wid = __builtin_amdgcn_readfirstlane(tid >> 6);
    const int cm = wid >> 2, wq = wid & 3;
    const bf16_t* Qp = Q + ((size_t)(((b * NH + h) * 2 + cm) * SEQ + qb * 128 + wq * 32 + r32)) * HD + hi * 8;
    const int kkey = tid >> 3;
    const bf16_t* K0g = K + ((size_t)((b * NH + h) * 2) * SK) * HD + (size_t)kkey * HD + (((tid & 7) ^ ((kkey >> 1) & 7)) * 8);
    const bf16_t* K1g = K0g + (size_t)SK * HD;
    const bf16_t* Vg0 = V + (size_t)((b * NH + h) * SK) * VD + (size_t)((((tid >> 6) & 3) * 16) + ((tid >> 2) & 15)) * VD + (tid >> 8) * 32 + (tid & 3) * 8;
    const bf16_t* Vg1 = Vg0 + 64;
    const unsigned wbase = (unsigned)wid * 1024u;
    const unsigned lds_base = (unsigned)(size_t)lds;
#define GLDS16(gsrc, ldsoff) do { unsigned keep_; const unsigned dst_ = (unsigned)__builtin_amdgcn_readfirstlane((int)(lds_base + (ldsoff))); \
        asm volatile("s_mov_b32 %0, m0\n\ts_mov_b32 m0, %2\n\ts_nop 0\n\tglobal_load_lds_dwordx4 %1, off\n\ts_mov_b32 m0, %0" : "=&s"(keep_) : "v"(gsrc), "s"(dst_) : "memory"); } while (0)
#define ATT_DMAK(t, sl) do { const size_t ko_ = (size_t)(t) * 64 * HD; \
        GLDS16(K0g + ko_, KR + (sl) * KSL + wbase); GLDS16(K1g + ko_, KR + (sl) * KSL + 8192 + wbase); } while (0)
#define ATT_DMAV(t, sl) do { const size_t vo_ = (size_t)(t) * 64 * VD; \
        GLDS16(Vg0 + vo_, VR + (sl) * VSL + wbase); GLDS16(Vg1 + vo_, VR + (sl) * VSL + 8192 + wbase); } while (0)
#define ATT_WAITBAR(N) do { asm volatile("s_waitcnt vmcnt(%0)" :: "n"(N) : "memory"); __builtin_amdgcn_s_barrier(); } while (0)
    ATT_DMAK(0, 0);
#pragma unroll
    for (int j = 0; j < PD; ++j) { ATT_DMAV(j, j); ATT_DMAK(j + 1, j + 1); }
    bf16x8 qr[4];
#pragma unroll
    for (int d0 = 0; d0 < 4; ++d0) qr[d0] = *(const bf16x8*)(Qp + d0 * 16);
    f32x16 o[4];
#pragma unroll
    for (int e = 0; e < 4; ++e) o[e] = (f32x16){};
    float mrun = -1e30f, lsum = 0.f;
    int kro4[4];
#pragma unroll
    for (int d0 = 0; d0 < 4; ++d0) kro4[d0] = cm * 8192 + r32 * 128 + (((2 * d0 + hi) ^ ((r32 >> 1) & 7)) * 16);
    const int vro = VR + ((lane >> 4) & 1) * 32 + (lane & 3) * 8 + (4 * hi + ((lane & 15) >> 2)) * 64;
#define ATT_QK(P0, P1, so) do { P0 = (f32x16){}; P1 = (f32x16){}; _Pragma("unroll") for (int d0 = 0; d0 < 4; ++d0) { \
        const bf16x8 k0_ = *(const LAS bf16x8*)(lds + (so) + kro4[d0]); const bf16x8 k1_ = *(const LAS bf16x8*)(lds + (so) + kro4[d0] + 4096); \
        P0 = __builtin_amdgcn_mfma_f32_32x32x16_bf16(k0_, qr[d0], P0, 0, 0, 0); P1 = __builtin_amdgcn_mfma_f32_32x32x16_bf16(k1_, qr[d0], P1, 0, 0, 0); } } while (0)
    f32x16 pA0, pA1, pB0, pB1;
    ATT_WAITBAR(4 * PD);
    ATT_QK(pA0, pA1, KR);
    float mxc;
    { float a_ = -1e30f;
#pragma unroll
      for (int j = 0; j < 16; ++j) a_ = MX3(a_, pA0[j], pA1[j]);
      mxc = xmax(a_); }
    ATT_WAITBAR(4 * (PD - 1));
    int sl0 = 0, sl1 = 1;
#define SBAR() __builtin_amdgcn_sched_barrier(0)
#define VTR(ks, eb, half) __builtin_bit_cast(s16x4, __builtin_amdgcn_ds_read_tr16_b64_v4i16((LAS s16x4*)(lds + sl0 * VSL + vro + (eb) * 4096 + (ks) * 1024 + (half) * 512)))
#define ATT_STEP(P0, P1, N0, N1, t) do { \
        if (__any(mxc > mrun + THR)) { const float mn_ = fmaxf(mrun, mxc), al_ = __builtin_amdgcn_exp2f(mrun - mn_); mrun = mn_; lsum *= al_; \
            _Pragma("unroll") for (int e = 0; e < 4; ++e) _Pragma("unroll") for (int i = 0; i < 16; ++i) o[e][i] *= al_; } \
        SBAR(); \
        ATT_DMAK((t) + 1 + PD, sl0); ATT_DMAV((t) + PD, (sl0 == 0 ? NS - 1 : sl0 - 1)); \
        bf16x8 kf_[8]; \
        _Pragma("unroll") for (int d0 = 0; d0 < 4; ++d0) { kf_[2 * d0] = *(const LAS bf16x8*)(lds + KR + sl1 * KSL + kro4[d0]); kf_[2 * d0 + 1] = *(const LAS bf16x8*)(lds + KR + sl1 * KSL + kro4[d0] + 4096); } \
        s16x4 vl_[4][4], vh_[4][4]; \
        _Pragma("unroll") for (int eb = 0; eb < 4; ++eb) { vl_[0][eb] = VTR(0, eb, 0); vh_[0][eb] = VTR(0, eb, 1); } \
        SBAR(); \
        N0 = (f32x16){}; N1 = (f32x16){}; \
        float ls_ = 0.f; unsigned w0_[8], w1_[8]; \
        _Pragma("unroll") for (int i = 0; i < 8; ++i) { \
            if ((i & 1) == 0) N0 = __builtin_amdgcn_mfma_f32_32x32x16_bf16(kf_[i], qr[i >> 1], N0, 0, 0, 0); \
            else              N1 = __builtin_amdgcn_mfma_f32_32x32x16_bf16(kf_[i], qr[i >> 1], N1, 0, 0, 0); \
            P0[2 * i] = __builtin_amdgcn_exp2f(P0[2 * i] - mrun); P0[2 * i + 1] = __builtin_amdgcn_exp2f(P0[2 * i + 1] - mrun); \
            P1[2 * i] = __builtin_amdgcn_exp2f(P1[2 * i] - mrun); P1[2 * i + 1] = __builtin_amdgcn_exp2f(P1[2 * i + 1] - mrun); \
            ls_ += (P0[2 * i] + P0[2 * i + 1]) + (P1[2 * i] + P1[2 * i + 1]); \
            w0_[i] = cvt_pk_bf16(P0[2 * i], P0[2 * i + 1]); w1_[i] = cvt_pk_bf16(P1[2 * i], P1[2 * i + 1]); \
            SBAR(); } \
        lsum += ls_; \
        bf16x8 pa_[4]; \
        pa_[0] = __builtin_bit_cast(bf16x8, (u32x4){w0_[0], w0_[1], w0_[2], w0_[3]}); pa_[1] = __builtin_bit_cast(bf16x8, (u32x4){w0_[4], w0_[5], w0_[6], w0_[7]}); \
        pa_[2] = __builtin_bit_cast(bf16x8, (u32x4){w1_[0], w1_[1], w1_[2], w1_[3]}); pa_[3] = __builtin_bit_cast(bf16x8, (u32x4){w1_[4], w1_[5], w1_[6], w1_[7]}); \
        float mxn_ = -1e30f; \
        _Pragma("unroll") for (int ks = 0; ks < 4; ++ks) { \
            _Pragma("unroll") for (int eb = 0; eb < 4; ++eb) { \
                const bf16x8 vf_ = (bf16x8){vl_[ks][eb][0], vl_[ks][eb][1], vl_[ks][eb][2], vl_[ks][eb][3], vh_[ks][eb][0], vh_[ks][eb][1], vh_[ks][eb][2], vh_[ks][eb][3]}; \
                o[eb] = __builtin_amdgcn_mfma_f32_32x32x16_bf16(vf_, pa_[ks], o[eb], 0, 0, 0); \
                if (ks < 3) { vl_[ks + 1][eb] = VTR(ks + 1, eb, 0); vh_[ks + 1][eb] = VTR(ks + 1, eb, 1); } \
                mxn_ = MX3(mxn_, N0[ks * 4 + eb], N1[ks * 4 + eb]); \
                SBAR(); } } \
        mxc = xmax(mxn_); \
        SBAR(); \
        asm volatile("s_waitcnt vmcnt(%0) lgkmcnt(0)" :: "n"(4 * (PD - 1)) : "memory"); __builtin_amdgcn_s_barrier(); \
        SBAR(); \
        sl0 = sl1; sl1 = (sl1 == NS - 1) ? 0 : sl1 + 1; \
    } while (0)
    for (int t = 0; t < NT; t += 2) {
        ATT_STEP(pA0, pA1, pB0, pB1, t);
        ATT_STEP(pB0, pB1, pA0, pA1, t + 1);
    }
    asm volatile("s_waitcnt vmcnt(0)" ::: "memory"); __builtin_amdgcn_s_barrier();
#undef SBAR
#undef VTR
#undef ATT_STEP
#undef ATT_QK
#undef ATT_DMAK
#undef GLDS16
#undef ATT_DMAV
#undef ATT_WAITBAR
    const float linv = 1.f / xsum(lsum);
    LAS float* xch = (LAS float*)(lds + XCH) + wq * 64 * 64 + lane;
    if (cm == 1) {
#pragma unroll
        for (int e = 0; e < 4; ++e)
#pragma unroll
            for (int i = 0; i < 16; ++i) xch[(e * 16 + i) * 64] = o[e][i] * linv;
    }
    __syncthreads();
    if (cm == 0) {
        const float lam = *(const LAS float*)(lds + LAMO);
        float ss = 0.f;
#pragma unroll
        for (int e = 0; e < 4; ++e)
#pragma unroll
            for (int i = 0; i < 16; ++i) { const float v = o[e][i] * linv - lam * xch[(e * 16 + i) * 64]; o[e][i] = v; ss += v * v; }
        ss = xsum(ss);
        const float rn = __builtin_amdgcn_rsqf(ss * (1.f / VD) + RMS_EPS);
        const LAS float* sg = (const LAS float*)(lds + SUBG);
        LAS unsigned char* stg = lds + OST + wq * (32 * 272);
#pragma unroll
        for (int e = 0; e < 4; ++e)
#pragma unroll
            for (int i4 = 0; i4 < 4; ++i4) { const int e0 = 32 * e + 8 * i4 + 4 * hi;
                const f32x4 g4 = *(const LAS f32x4*)(sg + e0);
                u32x2 w; w.x = cvt_pk_bf16(o[e][4 * i4] * rn * g4[0], o[e][4 * i4 + 1] * rn * g4[1]); w.y = cvt_pk_bf16(o[e][4 * i4 + 2] * rn * g4[2], o[e][4 * i4 + 3] * rn * g4[3]);
                *(LAS u32x2*)(stg + r32 * 272 + e0 * 2) = w; }
        asm volatile("s_waitcnt lgkmcnt(0)" ::: "memory");
        bf16_t* Ow = O + ((size_t)(b * SEQ + qb * 128 + wq * 32)) * D + h * VD;
#pragma unroll
        for (int it = 0; it < 8; ++it) { const int id = it * 64 + lane, row = id >> 4, ch = id & 15;
            const u32x4 v = *(const LAS u32x4*)(stg + row * 272 + ch * 16);
            *(u32x4*)(Ow + (size_t)row * D + ch * 8) = v; }
    }
    __syncthreads();
}
}

#ifndef PH_MASK
#define PH_MASK 0xFFFFFFu
#endif
#ifndef REP_ATT
#define REP_ATT 1
#endif
#ifndef REP_P0
#define REP_P0 1
#endif
#define PH(k) if constexpr ((PH_MASK >> (k)) & 1u)
struct Args {
    const float *x, *c, *ctx, *c_ctx, *mod_w, *mod_b, *norm_g, *w_gu, *w_dn, *w_qkv, *w_o, *lam, *subg, *w_in, *w_out;
    float* out; unsigned char* ws;
};

__device__ __forceinline__ void transpose_item(const float* W, int K, int Nsrc, int Ndst, bf16_t* WT, int mode, LAS float* scr, int item, int lane) {
    const int nblk = Ndst / 32, kb = item / nblk, nb = item % nblk, k0 = 64 * kb, n0 = 32 * nb, i = lane & 31;
    int src;
    if (mode == 1 && n0 < 4096) src = n0 + ((i >> 2) & 1) * 16 + ((i >> 3) & 3) * 4 + (i & 3);
    else if (mode == 2) { const int tile = n0 >> 8, r0 = n0 & 255; src = (r0 < 128 ? tile * 128 + r0 : FF + tile * 128 + r0 - 128) + i; }
    else src = n0 + i;
#pragma unroll 8
    for (int q = 0; q < 32; ++q) { const int kk = 2 * q + (lane >> 5); scr[kk * 33 + i] = W[(size_t)(k0 + kk) * Nsrc + src]; }
    asm volatile("s_waitcnt lgkmcnt(0)" ::: "memory");
    const int c = lane & 7;
#pragma unroll
    for (int j = 0; j < 4; ++j) { const int n = (lane >> 3) + 8 * j; const LAS float* s = scr + (8 * c) * 33 + n;
        u32x4 o; o.x = cvt_pk_bf16(s[0 * 33], s[1 * 33]); o.y = cvt_pk_bf16(s[2 * 33], s[3 * 33]); o.z = cvt_pk_bf16(s[4 * 33], s[5 * 33]); o.w = cvt_pk_bf16(s[6 * 33], s[7 * 33]);
        *(u32x4*)(WT + (size_t)(n0 + n) * K + k0 + 8 * c) = o; }
    asm volatile("s_waitcnt lgkmcnt(0)" ::: "memory");
}

__device__ __forceinline__ void row_op(int lane, const bf16_t* y, const float* xin, const float* gate, const float* gy, float* xout,
                                       const float* gh, const float* sh, const float* sc, bf16_t* hb) {
    asm volatile("" : "+v"(lane));
    f32x4 v[8];
#pragma unroll
    for (int j = 0; j < 8; ++j) v[j] = *(const f32x4*)(xin + j * 256 + lane * 4);
    if (y) {
        u32x2 yw[8]; float ss = 0.f;
#pragma unroll
        for (int j = 0; j < 8; ++j) { yw[j] = *(const u32x2*)(y + j * 256 + lane * 4);
            const float a = bflo(yw[j].x), b = bfhi(yw[j].x), c = bflo(yw[j].y), d = bfhi(yw[j].y); ss += (a * a + b * b) + (c * c + d * d); }
        const float ry = __builtin_amdgcn_rsqf(wave_sum(ss) * (1.f / D) + RMS_EPS);
#pragma unroll
        for (int j = 0; j < 8; ++j) { const f32x4 g4 = *(const f32x4*)(gate + j * 256 + lane * 4), w4 = *(const f32x4*)(gy + j * 256 + lane * 4);
            const f32x4 yv = {bflo(yw[j].x), bfhi(yw[j].x), bflo(yw[j].y), bfhi(yw[j].y)};
            v[j] = v[j] + g4 * (yv * ry * w4); }
#pragma unroll
        for (int j = 0; j < 8; ++j) *(f32x4*)(xout + j * 256 + lane * 4) = v[j];
    }
    if (hb) {
        float ss = 0.f;
#pragma unroll
        for (int j = 0; j < 8; ++j) ss += (v[j].x * v[j].x + v[j].y * v[j].y) + (v[j].z * v[j].z + v[j].w * v[j].w);
        const float r = __builtin_amdgcn_rsqf(wave_sum(ss) * (1.f / D) + RMS_EPS);
#pragma unroll
        for (int j = 0; j < 8; ++j) { const f32x4 g4 = *(const f32x4*)(gh + j * 256 + lane * 4), s4 = *(const f32x4*)(sh + j * 256 + lane * 4), c4 = *(const f32x4*)(sc + j * 256 + lane * 4);
            const f32x4 hv = v[j] * r * g4 * (c4 + 1.f) + s4;
            u32x2 w; w.x = cvt_pk_bf16(hv.x, hv.y); w.y = cvt_pk_bf16(hv.z, hv.w);
            *(u32x2*)(hb + j * 256 + lane * 4) = w; }
    }
}

__global__ void __launch_bounds__(512, 2) fwd_megakernel(Args a) {
    extern __shared__ __attribute__((aligned(16))) unsigned char lds_raw[];
    LAS unsigned char* lds = (LAS unsigned char*)lds_raw;
    cg::grid_group grid = cg::this_grid();
    const int tid = threadIdx.x, lane = tid & 63, wave = __builtin_amdgcn_readfirstlane(tid >> 6);
    const int G = gridDim.x, bx = blockIdx.x;
    const int gw = bx * 8 + wave, NGW = G * 8;
#define WSB ({ unsigned char* _w = a.ws; asm volatile("" : "+s"(_w)); _w; })
#define ADA ((float*)(WSB + WS_ADA))
#define ROPE ((float*)(WSB + WS_ROPE))
#define D1T ((bf16_t*)(WSB + WS_D1))
#define D2T ((bf16_t*)(WSB + WS_D2))
#define CS2 ((bf16_t*)(WSB + WS_CS2))
#define TWT ((f32x2*)(WSB + WS_TW))
#define Wqkv ((bf16_t*)(WSB + WS_WQKV))
#define Wo ((bf16_t*)(WSB + WS_WO))
#define Win ((bf16_t*)(WSB + WS_WIN))
#define Wout ((bf16_t*)(WSB + WS_WOUT))
#define Wgu ((bf16_t*)(WSB + WS_WGU))
#define Wdn ((bf16_t*)(WSB + WS_WDN))
#define HB ((bf16_t*)(WSB + WS_HB))
#define YB ((bf16_t*)(WSB + WS_YB))
#define Qb ((bf16_t*)(WSB + WS_Q))
#define Kb ((bf16_t*)(WSB + WS_K))
#define Vb ((bf16_t*)(WSB + WS_V))
#define Ob ((bf16_t*)(WSB + WS_O))
#define HID ((bf16_t*)(WSB + WS_HID))
#define Ub ((bf16_t*)(WSB + WS_U))
#define A2b ((bf16_t*)(WSB + WS_A2))
#define Xb ((bf16_t*)(WSB + WS_X))
#define Fb ((bf16_t*)(WSB + WS_F))

    for (int rep0 = 0; rep0 < REP_P0; ++rep0) {
        LAS float* sl = (LAS float*)(lds + 69632);
        LAS float* red = (LAS float*)lds;
        if (bx < 192) {
            for (int i = tid; i < 5 * D; i += 512) { const float cv = (i < 4 * D) ? a.c[i] : a.c_ctx[i - 4 * D]; sl[i] = silu_f(cv); }
            __syncthreads();
            for (int it = bx; it < 192; it += G) {
                const int layer = it / 96, n0 = (it % 96) * 128;
                const float* wp = a.mod_w + (size_t)layer * D * 6 * D + (size_t)(wave * 256) * 6 * D + n0 + lane * 2;
                float ac[5][2];
#pragma unroll
                for (int r = 0; r < 5; ++r) { ac[r][0] = 0.f; ac[r][1] = 0.f; }
#pragma unroll 8
                for (int k = 0; k < 256; ++k) { const f32x2 w = *(const f32x2*)(wp + (size_t)k * 6 * D);
#pragma unroll
                    for (int r = 0; r < 5; ++r) { const float s = sl[r * D + wave * 256 + k]; ac[r][0] += s * w.x; ac[r][1] += s * w.y; } }
#pragma unroll
                for (int r = 0; r < 5; ++r) { red[(wave * 5 + r) * 128 + lane * 2] = ac[r][0]; red[(wave * 5 + r) * 128 + lane * 2 + 1] = ac[r][1]; }
                __syncthreads();
                for (int i = tid; i < 5 * 128; i += 512) { const int r = i >> 7, cc = i & 127; float s = a.mod_b[layer * 6 * D + n0 + cc];
#pragma unroll
                    for (int w = 0; w < 8; ++w) s += red[(w * 5 + r) * 128 + cc];
                    ADA[(size_t)(layer * 5 + r) * 6 * D + n0 + cc] = s; }
                __syncthreads();
            }
        }
        __syncthreads();
        LAS float* scr = (LAS float*)(lds + wave * 8704);
        constexpr int I_QKV = 32 * 192, I_SQ = 32 * 64, I_GU = 32 * 352, I_DN = 88 * 64;
        constexpr int NITEMS = I_QKV + 3 * I_SQ + 2 * I_GU + 2 * I_DN;
        for (int it = gw; it < NITEMS; it += NGW) {
            int r = it;
            if (r < I_QKV) { transpose_item(a.w_qkv, D, NQKV, NQKV, Wqkv, 1, scr, r, lane); continue; } r -= I_QKV;
            if (r < I_SQ) { transpose_item(a.w_o, D, D, D, Wo, 0, scr, r, lane); continue; } r -= I_SQ;
            if (r < I_SQ) { transpose_item(a.w_in, D, D, D, Win, 0, scr, r, lane); continue; } r -= I_SQ;
            if (r < I_SQ) { transpose_item(a.w_out, D, D, D, Wout, 0, scr, r, lane); continue; } r -= I_SQ;
            if (r < 2 * I_GU) { const int l = r / I_GU; transpose_item(a.w_gu + (size_t)l * D * NGU, D, NGU, NGU, Wgu + (size_t)l * NGU * D, 2, scr, r % I_GU, lane); continue; } r -= 2 * I_GU;
            { const int l = r / I_DN; transpose_item(a.w_dn + (size_t)l * FF * D, FF, D, D, Wdn + (size_t)l * D * FF, 0, scr, r % I_DN, lane); }
        }
        const int gt = bx * 512 + tid, NGT = G * 512;
        if (gt < 1024) { const int pos = gt >> 4, f = gt & 15; const float inv = powf(10000.f, -(float)f / 16.f); const float ang = (float)pos * inv;
            ROPE[gt] = cosf(ang); ROPE[1024 + gt] = sinf(ang); }
        for (int i = gt; i < 256 * 128; i += NGT) { const int m = i >> 7, k = i & 127, part = m >> 7, rp = (m >> 6) & 1, k1 = m & 63, rp2 = k >> 6, aa = k & 63;
            float sv, cv; sincospif((float)((k1 * aa) & 63) * (1.f / 32.f), &sv, &cv); const float v = (rp == rp2) ? (part ? -sv : cv) * 0.125f : 0.f;
            D1T[i] = (bf16_t)(cvt_pk_bf16(v, v) & 0xffffu); }
        for (int i = gt; i < 256 * 256; i += NGT) { const int m = i >> 8, k = i & 255, kp = m >> 7, po = (m >> 6) & 1, k2 = m & 63, kp2 = k >> 7, part = (k >> 6) & 1, rp = (k >> 5) & 1, r = 2 * (k & 31) + rp;
            float sv, cv; sincospif((float)((k2 * r) & 63) * (1.f / 32.f), &sv, &cv);
            const float v = (kp == kp2) ? (po == 0 ? (part == 0 ? cv : sv) : (part == 0 ? -sv : cv)) * 0.125f : 0.f;
            D2T[i] = (bf16_t)(cvt_pk_bf16(v, v) & 0xffffu); }
        for (int i = gt; i < 256 * 512; i += NGT) { const int kc = i >> 9, k = i & 511, part = k >> 8, cc = k & 255;
            float sv, cv; sincospif((float)((kc * cc) & 255) * (1.f / 128.f), &sv, &cv); const float v = (part ? sv : cv) * (1.f / 16.f);
            CS2[i] = (bf16_t)(cvt_pk_bf16(v, v) & 0xffffu); }
        for (int i = gt; i < 4096; i += NGT) { float sv, cv; sincospif((float)i * (1.f / 2048.f), &sv, &cv); TWT[i] = (f32x2){cv, sv}; }
    }
    grid.sync();

    for (int row = gw; row < MT; row += NGW) {
        const bool lat = row < M; const int r = lat ? (row >> 12) : 4;
        const float* xin = lat ? a.x + (size_t)row * D : a.ctx + (size_t)(row - M) * D;
        const float* ad = ADA + (size_t)r * 6 * D;
        row_op(lane, nullptr, xin, nullptr, nullptr, nullptr, a.norm_g, ad, ad + D, HB + (size_t)row * D);
    }
    grid.sync();

    PH(0) { pg8::Gemm g{HB, Wqkv, D, D, D}; pg8::SchedQKV S{G, bx}; pg8::EpiQKV E{Qb, Kb, Vb, ROPE};
      pg8::gemm_phase(lds, g, S, E); }
    grid.sync();

    {
        if (tid < 128) ((LAS float*)(lds + att::SUBG))[tid] = a.subg[tid] * 0.8f;
        if (wave == 0) { const float p01 = wave_sum(a.lam[lane] * a.lam[64 + lane]), p23 = wave_sum(a.lam[128 + lane] * a.lam[192 + lane]);
            if (lane == 0) *(LAS float*)(lds + att::LAMO) = expf(p01) - expf(p23) + 0.2f; }
        __syncthreads();
        for (int rep = 0; rep < REP_ATT; ++rep)
        if (G == 256) { for (int i = 0; i < 8; ++i) { const int bh = (bx & 7) * 8 + i, qb = bx >> 3; att::attn_unit(bh >> 4, bh & 15, qb, Qb, Kb, Vb, Ob, lds); } }
        else { for (int u = bx; u < 2048; u += G) { const int bh = u >> 5, qb = u & 31; att::attn_unit(bh >> 4, bh & 15, qb, Qb, Kb, Vb, Ob, lds); } }
    }
    grid.sync();

    PH(1) { pg8::Gemm g{Ob, Wo, D, D, D}; pg8::SchedStd S{64, 8, G, bx, D, D, D}; pg8::EpiPlain E{YB, D}; pg8::gemm_phase(lds, g, S, E); }
    grid.sync();

    for (int row = gw; row < M; row += NGW) { const float* ad = ADA + (size_t)(row >> 12) * 6 * D;
        row_op(lane, YB + (size_t)row * D, a.x + (size_t)row * D, ad + 2 * D, a.norm_g + D, a.out + (size_t)row * D, a.norm_g + 2 * D, ad + 3 * D, ad + 4 * D, HB + (size_t)row * D); }
    grid.sync();

    PH(2) { pg8::Gemm g{HB, Wgu, D, D, D}; pg8::SchedStd S{64, 44, G, bx, D, D, 0}; pg8::EpiSwiGLU E{HID}; pg8::gemm_phase(lds, g, S, E); }
    grid.sync();
    PH(3) { pg8::Gemm g{HID, Wdn, FF, FF, FF}; pg8::SchedStd S{64, 8, G, bx, FF, FF, D}; pg8::EpiPlain E{YB, D}; pg8::gemm_phase(lds, g, S, E); }
    grid.sync();

    for (int row = gw; row < M; row += NGW) { const float* ad = ADA + (size_t)(row >> 12) * 6 * D; const float* ad1 = ADA + (size_t)(5 + (row >> 12)) * 6 * D;
        row_op(lane, YB + (size_t)row * D, a.out + (size_t)row * D, ad + 5 * D, a.norm_g + 3 * D, a.out + (size_t)row * D, a.norm_g + 4 * D, ad1, ad1 + D, HB + (size_t)((row & ~4095) + (row & 63) * 64 + ((row & 4095) >> 6)) * D); }
    grid.sync();

    PH(4) { pg8::Gemm g{Win, HB, D, D, D}; pg8::SchedInT S{G, bx}; pg8::EpiPlain E{Ub, SEQ}; pg8::gemm_phase(lds, g, S, E); }
    grid.sync();
    PH(5) { pg8::Gemm g{D1T, Ub, 128, 128, 128}; pg8::SchedCols S{G, bx, 1024, 128}; pg8::EpiFft1 E{A2b, TWT}; pg8::gemm_phase(lds, g, S, E); }
    grid.sync();
    PH(6) { pg8::Gemm g{D2T, A2b, 256, 256, 256}; pg8::SchedCols S{G, bx, 1024, 256}; pg8::EpiFft2 E{Xb}; pg8::gemm_phase(lds, g, S, E); }
    grid.sync();
    PH(10) { pg8::Gemm g{Xb, CS2, 4096, 512, 512}; pg8::SchedChan S{G, bx}; pg8::EpiPlain E{Fb, D}; pg8::gemm_phase(lds, g, S, E); }
    grid.sync();
    PH(7) { pg8::Gemm g{Fb, Wout, D, D, D}; pg8::SchedStd S{64, 8, G, bx, D, D, D}; pg8::EpiPlain E{YB, D}; pg8::gemm_phase(lds, g, S, E); }
    grid.sync();

    for (int row = gw; row < M; row += NGW) { const float* ad = ADA + (size_t)(5 + (row >> 12)) * 6 * D; const float* ng = a.norm_g + 4 * D;
        row_op(lane, YB + (size_t)row * D, a.out + (size_t)row * D, ad + 2 * D, ng + D, a.out + (size_t)row * D, ng + 2 * D, ad + 3 * D, ad + 4 * D, HB + (size_t)row * D); }
    grid.sync();

    PH(8) { pg8::Gemm g{HB, Wgu + (size_t)NGU * D, D, D, D}; pg8::SchedStd S{64, 44, G, bx, D, D, 0}; pg8::EpiSwiGLU E{HID}; pg8::gemm_phase(lds, g, S, E); }
    grid.sync();
    PH(9) { pg8::Gemm g{HID, Wdn + (size_t)D * FF, FF, FF, FF}; pg8::SchedStd S{64, 8, G, bx, FF, FF, D}; pg8::EpiPlain E{YB, D}; pg8::gemm_phase(lds, g, S, E); }
    grid.sync();

    for (int row = gw; row < M; row += NGW) { const float* ad = ADA + (size_t)(5 + (row >> 12)) * 6 * D; const float* ng = a.norm_g + 4 * D;
        row_op(lane, YB + (size_t)row * D, a.out + (size_t)row * D, ad + 5 * D, ng + 3 * D, a.out + (size_t)row * D, nullptr, nullptr, nullptr, nullptr); }
}

extern "C" void kernel_launch(void* const* d_in, const int* in_sizes, int n_in, void* d_out, int out_size, void* d_ws, size_t ws_size, hipStream_t stream) {
    static int grid = 0;
    if (grid == 0) {
        if (n_in != 15 || in_sizes[0] != M * D || out_size != M * D || ws_size < WS_END) {
            fprintf(stderr, "kernel_launch: unexpected shapes / workspace (n_in %d, in0 %d, out %d, ws %zu, need %zu)\n", n_in, n_in > 0 ? in_sizes[0] : -1, out_size, ws_size, (size_t)WS_END);
            grid = -1; return; }
        int dev = 0, cus = 0, per_cu = 0;
        hipGetDevice(&dev);
        hipDeviceGetAttribute(&cus, hipDeviceAttributeMultiprocessorCount, dev);
        if (hipFuncSetAttribute((const void*)fwd_megakernel, hipFuncAttributeMaxDynamicSharedMemorySize, LDS_BYTES) != hipSuccess) { fprintf(stderr, "kernel_launch: hipFuncSetAttribute failed\n"); grid = -1; return; }
        hipOccupancyMaxActiveBlocksPerMultiprocessor(&per_cu, (const void*)fwd_megakernel, 512, LDS_BYTES);
        if (per_cu < 1) { fprintf(stderr, "kernel_launch: occupancy query says %d blocks per CU\n", per_cu); per_cu = 1; }
        (void)hipGetLastError();
        grid = cus * 1;
    }
    if (grid < 0) return;
    Args a{};
    a.x = (const float*)d_in[0]; a.c = (const float*)d_in[1]; a.ctx = (const float*)d_in[2]; a.c_ctx = (const float*)d_in[3];
    a.mod_w = (const float*)d_in[4]; a.mod_b = (const float*)d_in[5]; a.norm_g = (const float*)d_in[6]; a.w_gu = (const float*)d_in[7]; a.w_dn = (const float*)d_in[8];
    a.w_qkv = (const float*)d_in[9]; a.w_o = (const float*)d_in[10]; a.lam = (const float*)d_in[11]; a.subg = (const float*)d_in[12]; a.w_in = (const float*)d_in[13]; a.w_out = (const float*)d_in[14];
    a.out = (float*)d_out; a.ws = (unsigned char*)d_ws;
    void* args[] = {&a};
    hipError_t e = hipLaunchCooperativeKernel((const void*)fwd_megakernel, dim3(grid), dim3(512), args, LDS_BYTES, stream);
    if (e != hipSuccess) fprintf(stderr, "cooperative launch failed: %s (grid %d)\n", hipGetErrorString(e), grid);
}
```

```cpp
#include <hip/hip_runtime.h>
#include <hip/hip_cooperative_groups.h>
#include <cstdio>
#include <cstdint>
namespace cg = cooperative_groups;

#define LAS __attribute__((address_space(3)))
typedef unsigned short bf16_t;
typedef short bf16x8 __attribute__((ext_vector_type(8)));
typedef short s16x4 __attribute__((ext_vector_type(4)));
typedef float f32x4 __attribute__((ext_vector_type(4)));
typedef float f32x2 __attribute__((ext_vector_type(2)));
typedef float f32x16 __attribute__((ext_vector_type(16)));
typedef unsigned u32x4 __attribute__((ext_vector_type(4)));
typedef unsigned u32x2 __attribute__((ext_vector_type(2)));

constexpr int D = 2048, NB = 4, SEQ = 4096, M = NB * SEQ, LC = 256, MC = NB * LC, MT = M + MC;
constexpr int NH = 16, HD = 64, VD = 128, NQKV = 6144, FF = 5632, NGU = 2 * FF, SK = SEQ + LC;
constexpr float RMS_EPS = 1e-6f;
constexpr float QSCALE = 0.125f * 1.4426950408889634f;

constexpr size_t MiB = 1u << 20;
constexpr size_t WS_ADA = 1 * MiB;
constexpr size_t WS_ROPE = 1 * MiB + 768 * 1024;
constexpr size_t WS_D1 = 2 * MiB;
constexpr size_t WS_D2 = 2 * MiB + 64 * 1024;
constexpr size_t WS_CS2 = 2 * MiB + 192 * 1024;
constexpr size_t WS_TW = 2 * MiB + 448 * 1024;
constexpr size_t WS_WQKV = 3 * MiB;
constexpr size_t WS_WO = 27 * MiB;
constexpr size_t WS_WIN = 35 * MiB;
constexpr size_t WS_WOUT = 43 * MiB;
constexpr size_t WS_WGU = 51 * MiB;
constexpr size_t WS_WDN = 139 * MiB;
constexpr size_t WS_HB = 183 * MiB;
constexpr size_t WS_YB = 251 * MiB;
constexpr size_t WS_R = 315 * MiB;
constexpr size_t WS_Q = WS_R;
constexpr size_t WS_K = WS_R + 64 * MiB;
constexpr size_t WS_V = WS_R + 132 * MiB;
constexpr size_t WS_O = WS_R + 200 * MiB;
constexpr size_t WS_HID = WS_R;
constexpr size_t WS_U = WS_R + 200 * MiB;
constexpr size_t WS_A2 = WS_R;
constexpr size_t WS_X = WS_R + 128 * MiB;
constexpr size_t WS_F = WS_R;
constexpr size_t WS_END = WS_R + 264 * MiB;

constexpr int LDS_BYTES = 147456;

typedef __bf16 bf16x2_t __attribute__((ext_vector_type(2)));
__device__ __forceinline__ unsigned cvt_pk_bf16(float lo, float hi) { const f32x2 v = {lo, hi}; const bf16x2_t b = __builtin_convertvector(v, bf16x2_t); return __builtin_bit_cast(unsigned, b); }
__device__ __forceinline__ float bf2f(unsigned short b) { return __uint_as_float(((unsigned)b) << 16); }
__device__ __forceinline__ float bflo(unsigned w) { return __uint_as_float(w << 16); }
__device__ __forceinline__ float bfhi(unsigned w) { return __uint_as_float(w & 0xffff0000u); }
__device__ __forceinline__ float wave_sum(float v) {
#pragma unroll
    for (int o = 1; o < 64; o <<= 1) v += __shfl_xor(v, o);
    return v;
}
__device__ __forceinline__ float silu_f(float v) { return v / (1.f + __expf(-v)); }

namespace pg8 {
constexpr int BM = 256, BK = 64, HALF = 128, HTB = HALF * BK * 2, NXCD = 8, WGM = 8;
__host__ __device__ __forceinline__ int lds_byte(int r, int c) { const int st = (r >> 4) * 2 + (c >> 5), rr = r & 15, cc = c & 31, ob = rr * 64 + cc * 2; return st * 1024 + (ob ^ (((ob >> 9) & 1) << 5)); }
__host__ __device__ __forceinline__ void stage_rc(int b, int& R, int& C) { const int st = b / 1024, sb = b % 1024, swz = sb ^ (((sb >> 9) & 1) << 5); R = (st >> 1) * 16 + swz / 64; C = (st & 1) * 32 + (swz % 64) / 2; }
__host__ __device__ __forceinline__ int perm32(int rho) { const int n = rho >> 4, i = rho & 15; return 8 * (i >> 2) + 4 * n + (i & 3); }

struct Unit { int pm, pn; size_t aoff, boff, coff; };
struct Gemm { const bf16_t* A; const bf16_t* Bt; int lda, ldb, K; };

__device__ __forceinline__ void swz_order(int L, int nM, int nN, int& pm, int& pn) {
    const int nwg = nM * nN; int wgid = L;
    { const int q = nwg / NXCD, r = nwg % NXCD, xcd = wgid % NXCD, off = wgid / NXCD; wgid = (xcd < r ? xcd * (q + 1) : r * (q + 1) + (xcd - r) * q) + off; }
    const int nig = WGM * nN, gid = wgid / nig, fm = gid * WGM, gsz = (nM - fm) < WGM ? (nM - fm) : WGM;
    pm = fm + ((wgid % nig) % gsz); pn = (wgid % nig) / gsz;
}

template <class Epi, class Sched>
__device__ __forceinline__ void gemm_phase(LAS unsigned char* lds, const Gemm g, const Sched& S, const Epi& E) {
    int tid = threadIdx.x; asm volatile("" : "+v"(tid));
    const int wid = __builtin_amdgcn_readfirstlane(tid >> 6), lane = tid & 63, wr = wid >> 2, wc = wid & 3, fr = lane & 15, fq = lane >> 4;
    int nt = g.K / BK; asm volatile("" : "+s"(nt));
    unsigned voffA[2], voffB[2];
#pragma unroll
    for (int i = 0; i < 2; ++i) { int R, C; stage_rc(tid * 16 + i * 8192, R, C); const int Rb = (R & ~31) + perm32(R & 31);
        voffA[i] = (unsigned)(R * g.lda + C) * 2u; voffB[i] = (unsigned)(Rb * g.ldb + C) * 2u; }
    const size_t kstep = (size_t)(BK * 2);
    const size_t hstepA = (size_t)HALF * g.lda * 2, hstepB = (size_t)HALF * g.ldb * 2;
    const unsigned ldsw = (unsigned)wid * 1024u;
    const int aoff = lds_byte(wr * 64 + fr, fq * 8), boff = lds_byte(wc * 32 + fr, fq * 8);
#define PG8_SA(b, h) (((b) * 2 + (h)) * HTB)
#define PG8_SB(b, h) ((4 + (b) * 2 + (h)) * HTB)
#define PG8_STAGE(bufoff, gbase, voff) do { _Pragma("unroll") for (int _i = 0; _i < 2; ++_i) \
        __builtin_amdgcn_global_load_lds((const unsigned*)((const char*)(gbase) + (voff)[_i]), (LAS unsigned*)(lds + (bufoff) + ldsw + _i * 8192), 16, 0, 0); } while (0)
#define PG8_LDA(dst, b, h) do { _Pragma("unroll") for (int m = 0; m < 4; ++m) _Pragma("unroll") for (int k = 0; k < 2; ++k) dst[m][k] = *(const LAS bf16x8*)(lds + PG8_SA(b, h) + aoff + m * 2048 + k * 1024); } while (0)
#define PG8_LDB(dst, b, h) do { _Pragma("unroll") for (int n = 0; n < 2; ++n) _Pragma("unroll") for (int k = 0; k < 2; ++k) dst[n][k] = *(const LAS bf16x8*)(lds + PG8_SB(b, h) + boff + n * 2048 + k * 1024); } while (0)
#define PG8_MMA(ai, bj, At, Bt) do { __builtin_amdgcn_s_setprio(1); _Pragma("unroll") for (int m = 0; m < 4; ++m) _Pragma("unroll") for (int n = 0; n < 2; ++n) _Pragma("unroll") for (int k = 0; k < 2; ++k) \
        acc[ai][bj][m][n] = __builtin_amdgcn_mfma_f32_16x16x32_bf16(Bt[n][k], At[m][k], acc[ai][bj][m][n], 0, 0, 0); __builtin_amdgcn_s_setprio(0); } while (0)
#define PG8_WAIT_V(n) asm volatile("s_waitcnt vmcnt(" #n ")" ::: "memory")
#define PG8_WAIT_L(n) asm volatile("s_waitcnt lgkmcnt(" #n ")" ::: "memory")
#define PG8_BAR __builtin_amdgcn_s_barrier()
#define PG8_SCHED __builtin_amdgcn_sched_barrier(0)
    Unit cur, nxt; int ui = 0;
    if (!S.next(0, cur)) return;
    f32x4 acc[2][2][4][2];
#pragma unroll
    for (int a = 0; a < 2; ++a)
#pragma unroll
        for (int b = 0; b < 2; ++b)
#pragma unroll
            for (int m = 0; m < 4; ++m)
#pragma unroll
                for (int n = 0; n < 2; ++n) acc[a][b][m][n] = (f32x4){0.f, 0.f, 0.f, 0.f};
    bf16x8 At[4][2], B0[2][2], B1[2][2];
    const char* cA = (const char*)g.A + cur.aoff; const char* cB = (const char*)g.Bt + cur.boff;
    PG8_STAGE(PG8_SB(0, 0), cB, voffB); PG8_STAGE(PG8_SB(0, 1), cB + hstepB, voffB); PG8_STAGE(PG8_SA(0, 0), cA, voffA); PG8_STAGE(PG8_SA(0, 1), cA + hstepA, voffA);
    if (wr == 1) PG8_BAR;
    PG8_WAIT_V(2); PG8_BAR;
    PG8_STAGE(PG8_SB(1, 0), cB + kstep, voffB); PG8_STAGE(PG8_SA(1, 0), cA + kstep, voffA); PG8_STAGE(PG8_SB(1, 1), cB + hstepB + kstep, voffB);
    PG8_WAIT_V(6); PG8_BAR;
    for (;;) {
        const bool has_next = S.next(ui + 1, nxt);
        const char* nA = has_next ? (const char*)g.A + nxt.aoff : cA; const char* nB = has_next ? (const char*)g.Bt + nxt.boff : cB;
        for (int t = 0; t < nt; t += 2) {
            const bool last = (t == nt - 2);
            const char* a1 = cA + (size_t)(t + 1) * kstep;
            const char* a2 = last ? nA : cA + (size_t)(t + 2) * kstep; const char* b2 = last ? nB : cB + (size_t)(t + 2) * kstep;
            const char* a3 = a2 + kstep; const char* b3 = b2 + kstep;
            PG8_LDB(B0, 0, 0); PG8_LDB(B1, 0, 1); PG8_SCHED; PG8_LDA(At, 0, 0); PG8_STAGE(PG8_SA(1, 1), a1 + hstepA, voffA);
            PG8_WAIT_V(8); PG8_WAIT_L(0); PG8_BAR; PG8_MMA(0, 0, At, B0); PG8_MMA(0, 1, At, B1); PG8_BAR; PG8_SCHED;
            PG8_LDA(At, 0, 1); PG8_STAGE(PG8_SB(0, 0), b2, voffB); PG8_STAGE(PG8_SB(0, 1), b2 + hstepB, voffB); PG8_STAGE(PG8_SA(0, 0), a2, voffA);
            PG8_WAIT_V(8); PG8_WAIT_L(0); PG8_BAR; PG8_MMA(1, 0, At, B0); PG8_MMA(1, 1, At, B1); PG8_BAR; PG8_SCHED;
            PG8_LDB(B0, 1, 0); PG8_LDB(B1, 1, 1); PG8_SCHED; PG8_LDA(At, 1, 0); PG8_STAGE(PG8_SA(0, 1), a2 + hstepA, voffA);
            PG8_WAIT_V(8); PG8_WAIT_L(0); PG8_BAR; PG8_MMA(0, 0, At, B0); PG8_MMA(0, 1, At, B1); PG8_BAR; PG8_SCHED;
            PG8_LDA(At, 1, 1); PG8_STAGE(PG8_SB(1, 0), b3, voffB); PG8_STAGE(PG8_SB(1, 1), b3 + hstepB, voffB); PG8_STAGE(PG8_SA(1, 0), a3, voffA);
            PG8_WAIT_V(8); PG8_WAIT_L(0); PG8_BAR; PG8_MMA(1, 0, At, B0); PG8_MMA(1, 1, At, B1); PG8_BAR; PG8_SCHED;
        }
        if (wr == 0) PG8_BAR;
        { int t2 = threadIdx.x; asm volatile("" : "+v"(t2)); const int fr2 = t2 & 15, fq2 = (t2 >> 4) & 3;
          E(acc, cur, wr, wc, fr2, fq2); }
        if (!has_next) break;
#pragma unroll
        for (int a = 0; a < 2; ++a)
#pragma unroll
            for (int b = 0; b < 2; ++b)
#pragma unroll
                for (int m = 0; m < 4; ++m)
#pragma unroll
                    for (int n = 0; n < 2; ++n) acc[a][b][m][n] = (f32x4){0.f, 0.f, 0.f, 0.f};
        cur = nxt; cA = nA; cB = nB; ++ui;
        if (wr == 1) PG8_BAR;
    }
    PG8_WAIT_V(0);
    PG8_BAR;
#undef PG8_SA
#undef PG8_SB
#undef PG8_STAGE
#undef PG8_LDA
#undef PG8_LDB
#undef PG8_MMA
#undef PG8_WAIT_V
#undef PG8_WAIT_L
#undef PG8_BAR
#undef PG8_SCHED
}

struct SchedStd {
    int nM, nN, G, c, lda, ldb, ldc;
    __device__ __forceinline__ bool next(int i, Unit& u) const {
        const int L = i * G + c; if (L >= nM * nN) return false;
        swz_order(L, nM, nN, u.pm, u.pn);
        u.aoff = (size_t)u.pm * BM * lda * 2; u.boff = (size_t)u.pn * BM * ldb * 2; u.coff = (size_t)u.pm * BM * ldc + (size_t)u.pn * BM; return true;
    }
};
struct SchedQKV {
    int G, c;
    __device__ __forceinline__ bool next(int i, Unit& u) const {
        const int L = i * G + c; if (L >= 1536 + 64) return false;
        if (L < 1536) swz_order(L, 64, 24, u.pm, u.pn); else { const int l2 = L - 1536; u.pm = 64 + (l2 & 3); u.pn = 8 + (l2 >> 2); }
        u.aoff = (size_t)u.pm * BM * D * 2; u.boff = (size_t)u.pn * BM * D * 2; u.coff = 0; return true;
    }
};
struct SchedInT {
    int G, c;
    __device__ __forceinline__ bool next(int i, Unit& u) const {
        const int L = i * G + c; if (L >= 512) return false;
        swz_order(L, 8, 64, u.pm, u.pn);
        u.aoff = (size_t)u.pm * BM * D * 2; u.boff = (size_t)u.pn * BM * D * 2;
        u.coff = ((size_t)((u.pn >> 4) * D + u.pm * BM)) * SEQ + (u.pn & 15) * BM; return true;
    }
};
struct SchedCols {
    int G, c, nU, ldb;
    __device__ __forceinline__ bool next(int i, Unit& u) const {
        const int L = i * G + c; if (L >= nU) return false;
        size_t z = 0; asm volatile("" : "+s"(z));
        u.pm = 0; u.pn = L; u.aoff = z; u.boff = (size_t)L * BM * ldb * 2; u.coff = 0; return true;
    }
};
struct SchedChan {
    int G, c;
    __device__ __forceinline__ bool next(int i, Unit& u) const {
        const int L = i * G + c; if (L >= 512) return false;
        u.pm = L >> 3; u.pn = L & 7;
        size_t z = 0; asm volatile("" : "+s"(z));
        u.aoff = ((size_t)u.pm * BM * 4096 + u.pn * 512) * 2; u.boff = z; u.coff = (size_t)u.pm * BM * D + u.pn * BM; return true;
    }
};

struct EpiPlain {
    bf16_t* O; int ldc;
    __device__ __forceinline__ void operator()(const f32x4 (&acc)[2][2][4][2], const Unit& u, int wr, int wc, int fr, int fq) const {
        bf16_t* base = O + u.coff + (size_t)(wr * 64 + fr) * ldc + wc * 32 + 8 * fq;
#pragma unroll
        for (int ai = 0; ai < 2; ++ai)
#pragma unroll
            for (int m = 0; m < 4; ++m) { bf16_t* rowp = base + (size_t)(ai * HALF + m * 16) * ldc;
#pragma unroll
                for (int bj = 0; bj < 2; ++bj) { const f32x4 v0 = acc[ai][bj][m][0], v1 = acc[ai][bj][m][1];
                    u32x4 w; w.x = cvt_pk_bf16(v0[0], v0[1]); w.y = cvt_pk_bf16(v0[2], v0[3]); w.z = cvt_pk_bf16(v1[0], v1[1]); w.w = cvt_pk_bf16(v1[2], v1[3]);
                    *(u32x4*)(rowp + bj * HALF) = w; } }
    }
};
struct EpiSwiGLU {
    bf16_t* O;
    __device__ __forceinline__ void operator()(const f32x4 (&acc)[2][2][4][2], const Unit& u, int wr, int wc, int fr, int fq) const {
        bf16_t* base = O + (size_t)(u.pm * BM + wr * 64 + fr) * FF + u.pn * 128 + wc * 32 + 8 * fq;
#pragma unroll
        for (int ai = 0; ai < 2; ++ai)
#pragma unroll
            for (int m = 0; m < 4; ++m) { bf16_t* rowp = base + (size_t)(ai * HALF + m * 16) * FF;
                float o[8];
#pragma unroll
                for (int n = 0; n < 2; ++n)
#pragma unroll
                    for (int j = 0; j < 4; ++j) { const float gv = acc[ai][0][m][n][j], uv = acc[ai][1][m][n][j];
                        o[n * 4 + j] = gv * uv * __builtin_amdgcn_rcpf(1.f + __builtin_amdgcn_exp2f(-1.4426950408889634f * gv)); }
                u32x4 w; w.x = cvt_pk_bf16(o[0], o[1]); w.y = cvt_pk_bf16(o[2], o[3]); w.z = cvt_pk_bf16(o[4], o[5]); w.w = cvt_pk_bf16(o[6], o[7]);
                *(u32x4*)rowp = w; }
    }
};
struct EpiFft1 {
    bf16_t* A2; const f32x2* tw;
    __device__ __forceinline__ void operator()(const f32x4 (&acc)[2][2][4][2], const Unit& u, int wr, int wc, int fr, int fq) const {
#pragma unroll
        for (int bj = 0; bj < 2; ++bj) { const int gcol = u.pn * 8 + 4 * bj + wc, b = gcol >> 11, col = gcol & 2047;
#pragma unroll
            for (int m = 0; m < 4; ++m) { const int k1 = 16 * m + fr; float re[8], im[8];
#pragma unroll
                for (int n = 0; n < 2; ++n)
#pragma unroll
                    for (int j = 0; j < 4; ++j) { const int r = 2 * (8 * fq + 4 * n + j) + wr; const f32x2 t = tw[k1 * r];
                        const float ar = acc[0][bj][m][n][j], ai = acc[1][bj][m][n][j];
                        re[n * 4 + j] = ar * t.x + ai * t.y; im[n * 4 + j] = ai * t.x - ar * t.y; }
                bf16_t* dst = A2 + (((size_t)(b * 32 + (k1 >> 1)) * D + col) * 256) + (k1 & 1) * 128 + wr * 32 + 8 * fq;
                u32x4 w; w.x = cvt_pk_bf16(re[0], re[1]); w.y = cvt_pk_bf16(re[2], re[3]); w.z = cvt_pk_bf16(re[4], re[5]); w.w = cvt_pk_bf16(re[6], re[7]);
                *(u32x4*)dst = w;
                w.x = cvt_pk_bf16(im[0], im[1]); w.y = cvt_pk_bf16(im[2], im[3]); w.z = cvt_pk_bf16(im[4], im[5]); w.w = cvt_pk_bf16(im[6], im[7]);
                *(u32x4*)(dst + 64) = w; } }
    }
};
struct EpiFft2 {
    bf16_t* X;
    __device__ __forceinline__ void operator()(const f32x4 (&acc)[2][2][4][2], const Unit& u, int wr, int wc, int fr, int fq) const {
        const int bk = u.pn >> 3, b = bk >> 5, k1p = bk & 31, gq = u.pn & 7;
#pragma unroll
        for (int ai = 0; ai < 2; ++ai)
#pragma unroll
            for (int m = 0; m < 4; ++m) { const int k2 = 16 * m + fr, tok = b * SEQ + 2 * k1p + ai + 64 * k2;
                bf16_t* rowp = X + (size_t)tok * 4096 + gq * 512 + wr * 256 + wc * 32 + 8 * fq;
#pragma unroll
                for (int bj = 0; bj < 2; ++bj) { const f32x4 v0 = acc[ai][bj][m][0], v1 = acc[ai][bj][m][1];
                    u32x4 w; w.x = cvt_pk_bf16(v0[0], v0[1]); w.y = cvt_pk_bf16(v0[2], v0[3]); w.z = cvt_pk_bf16(v1[0], v1[1]); w.w = cvt_pk_bf16(v1[2], v1[3]);
                    *(u32x4*)(rowp + bj * HALF) = w; } }
    }
};
struct EpiQKV {
    bf16_t *Q, *K, *V; const float* rope;
    __device__ __forceinline__ void operator()(const f32x4 (&acc)[2][2][4][2], const Unit& u, int wr, int wc, int fr, int fq) const {
        const int sec = u.pn >> 3, h0 = (u.pn & 7) * 2;
        const bool latent = u.pm < 64;
        const int b = latent ? (u.pm >> 4) : (u.pm - 64);
        const int tok0 = (latent ? (u.pm & 15) * 256 : SEQ) + wr * 64 + fr;
        const int cm = wc >> 1, axis = wc & 1;
#pragma unroll
        for (int ai = 0; ai < 2; ++ai)
#pragma unroll
            for (int m = 0; m < 4; ++m) {
                const int tok = tok0 + ai * HALF + m * 16;
                f32x4 c4 = {1.f, 1.f, 1.f, 1.f}, s4 = {0.f, 0.f, 0.f, 0.f};
                if (sec < 2 && latent) { const int pos = axis ? (tok & 63) : (tok >> 6); c4 = *(const f32x4*)(rope + pos * 16 + 4 * fq); s4 = *(const f32x4*)(rope + 1024 + pos * 16 + 4 * fq); }
#pragma unroll
                for (int bj = 0; bj < 2; ++bj) {
                    const int h = h0 + bj;
                    f32x4 v0 = acc[ai][bj][m][0], v1 = acc[ai][bj][m][1];
                    bf16_t* dst;
                    if (sec < 2) {
                        const f32x4 a = v0 * c4 - v1 * s4, bb = v1 * c4 + v0 * s4; v0 = a; v1 = bb;
                        if (sec == 0) { v0 = v0 * QSCALE; v1 = v1 * QSCALE; dst = Q + ((size_t)(((b * NH + h) * 2 + cm) * SEQ + tok)) * HD + axis * 32 + 8 * fq; }
                        else dst = K + ((size_t)(((b * NH + h) * 2 + cm) * SK + tok)) * HD + axis * 32 + 8 * fq;
                    } else dst = V + ((size_t)((b * NH + h) * SK + tok)) * VD + wc * 32 + 8 * fq;
                    u32x4 w; w.x = cvt_pk_bf16(v0[0], v0[1]); w.y = cvt_pk_bf16(v0[2], v0[3]); w.z = cvt_pk_bf16(v1[0], v1[1]); w.w = cvt_pk_bf16(v1[2], v1[3]);
                    *(u32x4*)dst = w;
                }
            }
    }
};
}

namespace att {
constexpr int NT = SK / 64;
constexpr int PD = 3, NS = PD + 1;
constexpr int KSL = 16384, VSL = 16384;
constexpr int KR = 0, VR = NS * KSL;
constexpr int XCH = 0, OST = 65536, SUBG = 132 * 1024, LAMO = SUBG + 512;
static_assert(VR + NS * VSL <= SUBG, "attention rings overlap the constants");
constexpr float THR = 8.f;
__device__ __forceinline__ float xmax(float v) { auto rr = __builtin_amdgcn_permlane32_swap(__float_as_uint(v), __float_as_uint(v), false, false); return fmaxf(__uint_as_float(rr[0]), __uint_as_float(rr[1])); }
__device__ __forceinline__ float xsum(float v) { auto rr = __builtin_amdgcn_permlane32_swap(__float_as_uint(v), __float_as_uint(v), false, false); return __uint_as_float(rr[0]) + __uint_as_float(rr[1]); }
#define MX3(a, b, c) __builtin_fmaxf(__builtin_fmaxf((a), (b)), (c))

__device__ __forceinline__ void attn_unit(int b, int h, int qb, const bf16_t* Q, const bf16_t* K, const bf16_t* V, bf16_t* O, LAS unsigned char* lds) {
    int tid = threadIdx.x; asm volatile("" : "+v"(tid));
    const int lane = tid & 63, r32 = lane & 31, hi = lane >> 5; const int wid = __builtin_amdgcn_readfirstlane(tid >> 6);
    const int cm = wid >> 2, wq = wid & 3;
    const bf16_t* Qp = Q + ((size_t)(((b * NH + h) * 2 + cm) * SEQ + qb * 128 + wq * 32 + r32)) * HD + hi * 8;
    const int kkey = tid >> 3;
    const bf16_t* K0g = K + ((size_t)((b * NH + h) * 2) * SK) * HD + (size_t)kkey * HD + (((tid & 7) ^ ((kkey >> 1) & 7)) * 8);
    const bf16_t* K1g = K0g + (size_t)SK * HD;
    const bf16_t* Vg0 = V + (size_t)((b * NH + h) * SK) * VD + (size_t)((((tid >> 6) & 3) * 16) + ((tid >> 2) & 15)) * VD + (tid >> 8) * 32 + (tid & 3) * 8;
    const bf16_t* Vg1 = Vg0 + 64;
    const unsigned wbase = (unsigned)wid * 1024u;
    const unsigned lds_base = (unsigned)(size_t)lds;
#define GLDS16(gsrc, ldsoff) do { unsigned keep_; const unsigned dst_ = (unsigned)__builtin_amdgcn_readfirstlane((int)(lds_base + (ldsoff))); \
        asm volatile("s_mov_b32 %0, m0\n\ts_mov_b32 m0, %2\n\ts_nop 0\n\tglobal_load_lds_dwordx4 %1, off\n\ts_mov_b32 m0, %0" : "=&s"(keep_) : "v"(gsrc), "s"(dst_) : "memory"); } while (0)
#define ATT_DMAK(t, sl) do { const size_t ko_ = (size_t)(t) * 64 * HD; \
        GLDS16(K0g + ko_, KR + (sl) * KSL + wbase); GLDS16(K1g + ko_, KR + (sl) * KSL + 8192 + wbase); } while (0)
#define ATT_DMAV(t, sl) do { const size_t vo_ = (size_t)(t) * 64 * VD; \
        GLDS16(Vg0 + vo_, VR + (sl) * VSL + wbase); GLDS16(Vg1 + vo_, VR + (sl) * VSL + 8192 + wbase); } while (0)
#define ATT_WAITBAR(N) do { asm volatile("s_waitcnt vmcnt(%0)" :: "n"(N) : "memory"); __builtin_amdgcn_s_barrier(); } while (0)
    ATT_DMAK(0, 0);
#pragma unroll
    for (int j = 0; j < PD; ++j) { ATT_DMAV(j, j); ATT_DMAK(j + 1, j + 1); }
    bf16x8 qr[4];
#pragma unroll
    for (int d0 = 0; d0 < 4; ++d0) qr[d0] = *(const bf16x8*)(Qp + d0 * 16);
    f32x16 o[4];
#pragma unroll
    for (int e = 0; e < 4; ++e) o[e] = (f32x16){};
    float mrun = -1e30f, lsum = 0.f;
    int kro4[4];
#pragma unroll
    for (int d0 = 0; d0 < 4; ++d0) kro4[d0] = cm * 8192 + r32 * 128 + (((2 * d0 + hi) ^ ((r32 >> 1) & 7)) * 16);
    const int vro = VR + ((lane >> 4) & 1) * 32 + (lane & 3) * 8 + (4 * hi + ((lane & 15) >> 2)) * 64;
#define ATT_QK(P0, P1, so) do { P0 = (f32x16){}; P1 = (f32x16){}; _Pragma("unroll") for (int d0 = 0; d0 < 4; ++d0) { \
        const bf16x8 k0_ = *(const LAS bf16x8*)(lds + (so) + kro4[d0]); const bf16x8 k1_ = *(const LAS bf16x8*)(lds + (so) + kro4[d0] + 4096); \
        P0 = __builtin_amdgcn_mfma_f32_32x32x16_bf16(k0_, qr[d0], P0, 0, 0, 0); P1 = __builtin_amdgcn_mfma_f32_32x32x16_bf16(k1_, qr[d0], P1, 0, 0, 0); } } while (0)
    f32x16 pA0, pA1, pB0, pB1;
    ATT_WAITBAR(4 * PD);
    ATT_QK(pA0, pA1, KR);
    float mxc;
    { float a_ = -1e30f;
#pragma unroll
      for (int j = 0; j < 16; ++j) a_ = MX3(a_, pA0[j], pA1[j]);
      mxc = xmax(a_); }
    ATT_WAITBAR(4 * (PD - 1));
    int sl0 = 0, sl1 = 1;
#define SBAR() __builtin_amdgcn_sched_barrier(0)
#define VTR(ks, eb, half) __builtin_bit_cast(s16x4, __builtin_amdgcn_ds_read_tr16_b64_v4i16((LAS s16x4*)(lds + sl0 * VSL + vro + (eb) * 4096 + (ks) * 1024 + (half) * 512)))
#define ATT_STEP(P0, P1, N0, N1, t) do { \
        if (__any(mxc > mrun + THR)) { const float mn_ = fmaxf(mrun, mxc), al_ = __builtin_amdgcn_exp2f(mrun - mn_); mrun = mn_; lsum *= al_; \
            _Pragma("unroll") for (int e = 0; e < 4; ++e) _Pragma("unroll") for (int i = 0; i < 16; ++i) o[e][i] *= al_; } \
        SBAR(); \
        ATT_DMAK((t) + 1 + PD, sl0); ATT_DMAV((t) + PD, (sl0 == 0 ? NS - 1 : sl0 - 1)); \
        bf16x8 kf_[8]; \
        _Pragma("unroll") for (int d0 = 0; d0 < 4; ++d0) { kf_[2 * d0] = *(const LAS bf16x8*)(lds + KR + sl1 * KSL + kro4[d0]); kf_[2 * d0 + 1] = *(const LAS bf16x8*)(lds + KR + sl1 * KSL + kro4[d0] + 4096); } \
        s16x4 vl_[4][4], vh_[4][4]; \
        _Pragma("unroll") for (int eb = 0; eb < 4; ++eb) { vl_[0][eb] = VTR(0, eb, 0); vh_[0][eb] = VTR(0, eb, 1); } \
        SBAR(); \
        N0 = (f32x16){}; N1 = (f32x16){}; \
        float ls_ = 0.f; unsigned w0_[8], w1_[8]; \
        _Pragma("unroll") for (int i = 0; i < 8; ++i) { \
            if ((i & 1) == 0) N0 = __builtin_amdgcn_mfma_f32_32x32x16_bf16(kf_[i], qr[i >> 1], N0, 0, 0, 0); \
            else              N1 = __builtin_amdgcn_mfma_f32_32x32x16_bf16(kf_[i], qr[i >> 1], N1, 0, 0, 0); \
            P0[2 * i] = __builtin_amdgcn_exp2f(P0[2 * i] - mrun); P0[2 * i + 1] = __builtin_amdgcn_exp2f(P0[2 * i + 1] - mrun); \
            P1[2 * i] = __builtin_amdgcn_exp2f(P1[2 * i] - mrun); P1[2 * i + 1] = __builtin_amdgcn_exp2f(P1[2 * i + 1] - mrun); \
            ls_ += (P0[2 * i] + P0[2 * i + 1]) + (P1[2 * i] + P1[2 * i + 1]); \
            w0_[i] = cvt_pk_bf16(P0[2 * i], P0[2 * i + 1]); w1_[i] = cvt_pk_bf16(P1[2 * i], P1[2 * i + 1]); \
            SBAR(); } \
        lsum += ls_; \
        bf16x8 pa_[4]; \
        pa_[0] = __builtin_bit_cast(bf16x8, (u32x4){w0_[0], w0_[1], w0_[2], w0_[3]}); pa_[1] = __builtin_bit_cast(bf16x8, (u32x4){w0_[4], w0_[5], w0_[6], w0_[7]}); \
        pa_[2] = __builtin_bit_cast(bf16x8, (u32x4){w1_[0], w1_[1], w1_[2], w1_[3]}); pa_[3] = __builtin_bit_cast(bf16x8, (u32x4){w1_[4], w1_[5], w1_[6], w1_[7]}); \
        float mxn_ = -1e30f; \
        _Pragma("unroll") for (int ks = 0; ks < 4; ++ks) { \
            _Pragma("unroll") for (int eb = 0; eb < 4; ++eb) { \
                const bf16x8 vf_ = (bf16x8){vl_[ks][eb][0], vl_[ks][eb][1], vl_[ks][eb][2], vl_[ks][eb][3], vh_[ks][eb][0], vh_[ks][eb][1], vh_[ks][eb][2], vh_[ks][eb][3]}; \
                o[eb] = __builtin_amdgcn_mfma_f32_32x32x16_bf16(vf_, pa_[ks], o[eb], 0, 0, 0); \
                if (ks < 3) { vl_[ks + 1][eb] = VTR(ks + 1, eb, 0); vh_[ks + 1][eb] = VTR(ks + 1, eb, 1); } \
                mxn_ = MX3(mxn_, N0[ks * 4 + eb], N1[ks * 4 + eb]); \
                SBAR(); } } \
        mxc = xmax(mxn_); \
        SBAR(); \
        asm volatile("s_waitcnt vmcnt(%0) lgkmcnt(0)" :: "n"(4 * (PD - 1)) : "memory"); __builtin_amdgcn_s_barrier(); \
        SBAR(); \
        sl0 = sl1; sl1 = (sl1 == NS - 1) ? 0 : sl1 + 1; \
    } while (0)
    for (int t = 0; t < NT; t += 2) {
        ATT_STEP(pA0, pA1, pB0, pB1, t);
        ATT_STEP(pB0, pB1, pA0, pA1, t + 1);
    }
    asm volatile("s_waitcnt vmcnt(0)" ::: "memory"); __builtin_amdgcn_s_barrier();
#undef SBAR
#undef VTR
#undef ATT_STEP
#undef ATT_QK
#undef ATT_DMAK
#undef GLDS16
#undef ATT_DMAV
#undef ATT_WAITBAR
    const float linv = 1.f / xsum(lsum);
    LAS float* xch = (LAS float*)(lds + XCH) + wq * 64 * 64 + lane;
    if (cm == 1) {
#pragma unroll
        for (int e = 0; e < 4; ++e)
#pragma unroll
            for (int i = 0; i < 16; ++i) xch[(e * 16 + i) * 64] = o[e][i] * linv;
    }
    __syncthreads();
    if (cm == 0) {
        const float lam = *(const LAS float*)(lds + LAMO);
        float ss = 0.f;
#pragma unroll
        for (int e = 0; e < 4; ++e)
#pragma unroll
            for (int i = 0; i < 16; ++i) { const float v = o[e][i] * linv - lam * xch[(e * 16 + i) * 64]; o[e][i] = v; ss += v * v; }
        ss = xsum(ss);
        const float rn = __builtin_amdgcn_rsqf(ss * (1.f / VD) + RMS_EPS);
        const LAS float* sg = (const LAS float*)(lds + SUBG);
        LAS unsigned char* stg = lds + OST + wq * (32 * 272);
#pragma unroll
        for (int e = 0; e < 4; ++e)
#pragma unroll
            for (int i4 = 0; i4 < 4; ++i4) { const int e0 = 32 * e + 8 * i4 + 4 * hi;
                const f32x4 g4 = *(const LAS f32x4*)(sg + e0);
                u32x2 w; w.x = cvt_pk_bf16(o[e][4 * i4] * rn * g4[0], o[e][4 * i4 + 1] * rn * g4[1]); w.y = cvt_pk_bf16(o[e][4 * i4 + 2] * rn * g4[2], o[e][4 * i4 + 3] * rn * g4[3]);
                *(LAS u32x2*)(stg + r32 * 272 + e0 * 2) = w; }
        asm volatile("s_waitcnt lgkmcnt(0)" ::: "memory");
        bf16_t* Ow = O + ((size_t)(b * SEQ + qb * 128 + wq * 32)) * D + h * VD;
#pragma unroll
        for (int it = 0; it < 8; ++it) { const int id = it * 64 + lane, row = id >> 4, ch = id & 15;
            const u32x4 v = *(const LAS u32x4*)(stg + row * 272 + ch * 16);
            *(u32x4*)(Ow + (size_t)row * D + ch * 8) = v; }
    }
    __syncthreads();
}
}

#define XB_TMO      128
#define XB_XCNT(j)  (256  + 64 * (j))
#define XB_XSUB(j)  (1280 + 64 * (j))
#define XB_XGEN(j)  (2304 + 64 * (j))
#define XB_TOP      3328
#define XB_TOPGEN   3392
#define XCD_BAR_WORDS 3456
#define XB_SPIN_CAP (1u << 20)
__device__ __forceinline__ unsigned xb_ld(unsigned* p)              { return __hip_atomic_load(p, __ATOMIC_RELAXED, __HIP_MEMORY_SCOPE_AGENT); }
__device__ __forceinline__ unsigned xb_add(unsigned* p, unsigned v) { return __hip_atomic_fetch_add(p, v, __ATOMIC_RELAXED, __HIP_MEMORY_SCOPE_AGENT); }
__device__ __forceinline__ unsigned xb_xcc_id() { return (unsigned)__builtin_amdgcn_s_getreg((3 << 11) | 20) & 0xFu; }
#define XB_SPIN(cond, bar) do { unsigned _sp = 0; while (cond) { __builtin_amdgcn_s_sleep(1); \
    if ((++_sp & 255u) == 0u) { if (xb_ld(&(bar)[XB_TMO])) break; if (_sp > XB_SPIN_CAP) { atomicAdd(&(bar)[XB_TMO], 1u); break; } } } } while (0)
__device__ __forceinline__ void xcd_barrier_complete(unsigned* bar, unsigned x, unsigned& nloc, unsigned& nx) {
    const unsigned G = gridDim.x;
    unsigned sum, cnt, mine, sp = 0u;
    for (;;) {
        sum = 0u; cnt = 0u; mine = 0u;
#pragma unroll
        for (unsigned j = 0; j < 16; ++j) { const unsigned c = xb_ld(&bar[XB_XCNT(j)]); sum += c; cnt += (c > 0u) ? 1u : 0u; mine = (j == x) ? c : mine; }
        if (sum == G) break;
        __builtin_amdgcn_s_sleep(1);
        if ((++sp & 255u) == 0u) { if (xb_ld(&bar[XB_TMO])) break; if (sp > XB_SPIN_CAP) { atomicAdd(&bar[XB_TMO], 1u); break; } }
    }
    nloc = mine > 0u ? mine : 1u; nx = cnt > 0u ? cnt : 1u;
}
__device__ __forceinline__ void xcd_barrier(unsigned* bar, volatile LAS unsigned* st) {
    asm volatile("s_waitcnt vmcnt(0)" ::: "memory");
    __syncthreads();
    if (threadIdx.x == 0) {
        const unsigned x = xb_xcc_id();
        __builtin_amdgcn_s_waitcnt(0);
        unsigned nloc = st[0], nx = st[1];
        if (nloc == 0u) { xcd_barrier_complete(bar, x, nloc, nx); st[0] = nloc; st[1] = nx; }
        const unsigned old = xb_add(&bar[XB_XSUB(x)], 1u);
        const unsigned gen = old / nloc;
        if (old + 1u == (gen + 1u) * nloc) {
            __builtin_amdgcn_fence(__ATOMIC_RELEASE, "agent");
            asm volatile("s_waitcnt vmcnt(0)" ::: "memory");
            const unsigned og = xb_add(&bar[XB_TOP], 1u);
            const unsigned tg = og / nx;
            if (og + 1u == (tg + 1u) * nx) xb_add(&bar[XB_TOPGEN], 1u);
            else XB_SPIN(xb_ld(&bar[XB_TOPGEN]) == tg, bar);
            __builtin_amdgcn_fence(__ATOMIC_ACQUIRE, "agent");
            xb_add(&bar[XB_XGEN(x)], 1u);
            asm volatile("s_waitcnt vmcnt(0)" ::: "memory");
        } else {
            XB_SPIN(xb_ld(&bar[XB_XGEN(x)]) == gen, bar);
            __builtin_amdgcn_fence(__ATOMIC_ACQUIRE, "agent");
            asm volatile("s_waitcnt vmcnt(0)" ::: "memory");
        }
    }
    __syncthreads();
}
constexpr int LDS_BARST = 140 * 1024;

#ifndef PH_MASK
#define PH_MASK 0xFFFFFFu
#endif
#ifndef REP_ATT
#define REP_ATT 1
#endif
#ifndef REP_GU
#define REP_GU 1
#endif
#ifndef REP_SYNC
#define REP_SYNC 0
#endif
#ifndef REP_P0
#define REP_P0 1
#endif
#define PH(k) if constexpr ((PH_MASK >> (k)) & 1u)
struct Args {
    const float *x, *c, *ctx, *c_ctx, *mod_w, *mod_b, *norm_g, *w_gu, *w_dn, *w_qkv, *w_o, *lam, *subg, *w_in, *w_out;
    float* out; unsigned char* ws;
};

__device__ __forceinline__ void transpose_item(const float* W, int K, int Nsrc, int Ndst, bf16_t* WT, int mode, LAS float* scr, int item, int lane) {
    const int nblk = Ndst / 32, kb = item / nblk, nb = item % nblk, k0 = 64 * kb, n0 = 32 * nb, i = lane & 31;
    int src;
    if (mode == 1 && n0 < 4096) src = n0 + ((i >> 2) & 1) * 16 + ((i >> 3) & 3) * 4 + (i & 3);
    else if (mode == 2) { const int tile = n0 >> 8, r0 = n0 & 255; src = (r0 < 128 ? tile * 128 + r0 : FF + tile * 128 + r0 - 128) + i; }
    else src = n0 + i;
#pragma unroll 8
    for (int q = 0; q < 32; ++q) { const int kk = 2 * q + (lane >> 5); scr[kk * 33 + i] = W[(size_t)(k0 + kk) * Nsrc + src]; }
    asm volatile("s_waitcnt lgkmcnt(0)" ::: "memory");
    const int c = lane & 7;
#pragma unroll
    for (int j = 0; j < 4; ++j) { const int n = (lane >> 3) + 8 * j; const LAS float* s = scr + (8 * c) * 33 + n;
        u32x4 o; o.x = cvt_pk_bf16(s[0 * 33], s[1 * 33]); o.y = cvt_pk_bf16(s[2 * 33], s[3 * 33]); o.z = cvt_pk_bf16(s[4 * 33], s[5 * 33]); o.w = cvt_pk_bf16(s[6 * 33], s[7 * 33]);
        *(u32x4*)(WT + (size_t)(n0 + n) * K + k0 + 8 * c) = o; }
    asm volatile("s_waitcnt lgkmcnt(0)" ::: "memory");
}

__device__ __forceinline__ void row_op(int lane, const bf16_t* y, const float* xin, const float* gate, const float* gy, float* xout,
                                       const float* gh, const float* sh, const float* sc, bf16_t* hb) {
    asm volatile("" : "+v"(lane));
    f32x4 v[8];
#pragma unroll
    for (int j = 0; j < 8; ++j) v[j] = *(const f32x4*)(xin + j * 256 + lane * 4);
    if (y) {
        u32x2 yw[8]; float ss = 0.f;
#pragma unroll
        for (int j = 0; j < 8; ++j) { yw[j] = *(const u32x2*)(y + j * 256 + lane * 4);
            const float a = bflo(yw[j].x), b = bfhi(yw[j].x), c = bflo(yw[j].y), d = bfhi(yw[j].y); ss += (a * a + b * b) + (c * c + d * d); }
        const float ry = __builtin_amdgcn_rsqf(wave_sum(ss) * (1.f / D) + RMS_EPS);
#pragma unroll
        for (int j = 0; j < 8; ++j) { const f32x4 g4 = *(const f32x4*)(gate + j * 256 + lane * 4), w4 = *(const f32x4*)(gy + j * 256 + lane * 4);
            const f32x4 yv = {bflo(yw[j].x), bfhi(yw[j].x), bflo(yw[j].y), bfhi(yw[j].y)};
            v[j] = v[j] + g4 * (yv * ry * w4); }
#pragma unroll
        for (int j = 0; j < 8; ++j) *(f32x4*)(xout + j * 256 + lane * 4) = v[j];
    }
    if (hb) {
        float ss = 0.f;
#pragma unroll
        for (int j = 0; j < 8; ++j) ss += (v[j].x * v[j].x + v[j].y * v[j].y) + (v[j].z * v[j].z + v[j].w * v[j].w);
        const float r = __builtin_amdgcn_rsqf(wave_sum(ss) * (1.f / D) + RMS_EPS);
#pragma unroll
        for (int j = 0; j < 8; ++j) { const f32x4 g4 = *(const f32x4*)(gh + j * 256 + lane * 4), s4 = *(const f32x4*)(sh + j * 256 + lane * 4), c4 = *(const f32x4*)(sc + j * 256 + lane * 4);
            const f32x4 hv = v[j] * r * g4 * (c4 + 1.f) + s4;
            u32x2 w; w.x = cvt_pk_bf16(hv.x, hv.y); w.y = cvt_pk_bf16(hv.z, hv.w);
            *(u32x2*)(hb + j * 256 + lane * 4) = w; }
    }
}

__global__ void __launch_bounds__(512, 2) fwd_megakernel(Args a) {
    extern __shared__ __attribute__((aligned(16))) unsigned char lds_raw[];
    LAS unsigned char* lds = (LAS unsigned char*)lds_raw;
    cg::grid_group grid = cg::this_grid();
    const int tid = threadIdx.x, lane = tid & 63, wave = __builtin_amdgcn_readfirstlane(tid >> 6);
    const int G = gridDim.x, bx = blockIdx.x;
    const int gw = bx * 8 + wave, NGW = G * 8;
    if (tid < 2) ((LAS unsigned*)(lds + LDS_BARST))[tid] = 0u;
    if (tid == 0) (void)xb_add(&((unsigned*)a.ws)[XB_XCNT(xb_xcc_id())], 1u);
    __syncthreads();
#define GRID_BAR() xcd_barrier((unsigned*)WSB, (volatile LAS unsigned*)(lds + LDS_BARST))
#define WSB ({ unsigned char* _w = a.ws; asm volatile("" : "+s"(_w)); _w; })
#define ADA ((float*)(WSB + WS_ADA))
#define ROPE ((float*)(WSB + WS_ROPE))
#define D1T ((bf16_t*)(WSB + WS_D1))
#define D2T ((bf16_t*)(WSB + WS_D2))
#define CS2 ((bf16_t*)(WSB + WS_CS2))
#define TWT ((f32x2*)(WSB + WS_TW))
#define Wqkv ((bf16_t*)(WSB + WS_WQKV))
#define Wo ((bf16_t*)(WSB + WS_WO))
#define Win ((bf16_t*)(WSB + WS_WIN))
#define Wout ((bf16_t*)(WSB + WS_WOUT))
#define Wgu ((bf16_t*)(WSB + WS_WGU))
#define Wdn ((bf16_t*)(WSB + WS_WDN))
#define HB ((bf16_t*)(WSB + WS_HB))
#define YB ((bf16_t*)(WSB + WS_YB))
#define Qb ((bf16_t*)(WSB + WS_Q))
#define Kb ((bf16_t*)(WSB + WS_K))
#define Vb ((bf16_t*)(WSB + WS_V))
#define Ob ((bf16_t*)(WSB + WS_O))
#define HID ((bf16_t*)(WSB + WS_HID))
#define Ub ((bf16_t*)(WSB + WS_U))
#define A2b ((bf16_t*)(WSB + WS_A2))
#define Xb ((bf16_t*)(WSB + WS_X))
#define Fb ((bf16_t*)(WSB + WS_F))

    for (int rep0 = 0; rep0 < REP_P0; ++rep0) {
        LAS float* sl = (LAS float*)(lds + 69632);
        LAS float* red = (LAS float*)lds;
        if (bx < 192) {
            for (int i = tid; i < 5 * D; i += 512) { const float cv = (i < 4 * D) ? a.c[i] : a.c_ctx[i - 4 * D]; sl[i] = silu_f(cv); }
            __syncthreads();
            for (int it = bx; it < 192; it += G) {
                const int layer = it / 96, n0 = (it % 96) * 128;
                const float* wp = a.mod_w + (size_t)layer * D * 6 * D + (size_t)(wave * 256) * 6 * D + n0 + lane * 2;
                float ac[5][2];
#pragma unroll
                for (int r = 0; r < 5; ++r) { ac[r][0] = 0.f; ac[r][1] = 0.f; }
#pragma unroll 8
                for (int k = 0; k < 256; ++k) { const f32x2 w = *(const f32x2*)(wp + (size_t)k * 6 * D);
#pragma unroll
                    for (int r = 0; r < 5; ++r) { const float s = sl[r * D + wave * 256 + k]; ac[r][0] += s * w.x; ac[r][1] += s * w.y; } }
#pragma unroll
                for (int r = 0; r < 5; ++r) { red[(wave * 5 + r) * 128 + lane * 2] = ac[r][0]; red[(wave * 5 + r) * 128 + lane * 2 + 1] = ac[r][1]; }
                __syncthreads();
                for (int i = tid; i < 5 * 128; i += 512) { const int r = i >> 7, cc = i & 127; float s = a.mod_b[layer * 6 * D + n0 + cc];
#pragma unroll
                    for (int w = 0; w < 8; ++w) s += red[(w * 5 + r) * 128 + cc];
                    ADA[(size_t)(layer * 5 + r) * 6 * D + n0 + cc] = s; }
                __syncthreads();
            }
        }
        __syncthreads();
        LAS float* scr = (LAS float*)(lds + wave * 8704);
        constexpr int I_QKV = 32 * 192, I_SQ = 32 * 64, I_GU = 32 * 352, I_DN = 88 * 64;
        constexpr int NITEMS = I_QKV + 3 * I_SQ + 2 * I_GU + 2 * I_DN;
        for (int it = gw; it < NITEMS; it += NGW) {
            int r = it;
            if (r < I_QKV) { transpose_item(a.w_qkv, D, NQKV, NQKV, Wqkv, 1, scr, r, lane); continue; } r -= I_QKV;
            if (r < I_SQ) { transpose_item(a.w_o, D, D, D, Wo, 0, scr, r, lane); continue; } r -= I_SQ;
            if (r < I_SQ) { transpose_item(a.w_in, D, D, D, Win, 0, scr, r, lane); continue; } r -= I_SQ;
            if (r < I_SQ) { transpose_item(a.w_out, D, D, D, Wout, 0, scr, r, lane); continue; } r -= I_SQ;
            if (r < 2 * I_GU) { const int l = r / I_GU; transpose_item(a.w_gu + (size_t)l * D * NGU, D, NGU, NGU, Wgu + (size_t)l * NGU * D, 2, scr, r % I_GU, lane); continue; } r -= 2 * I_GU;
            { const int l = r / I_DN; transpose_item(a.w_dn + (size_t)l * FF * D, FF, D, D, Wdn + (size_t)l * D * FF, 0, scr, r % I_DN, lane); }
        }
        const int gt = bx * 512 + tid, NGT = G * 512;
        if (gt < 1024) { const int pos = gt >> 4, f = gt & 15; const float inv = powf(10000.f, -(float)f / 16.f); const float ang = (float)pos * inv;
            ROPE[gt] = cosf(ang); ROPE[1024 + gt] = sinf(ang); }
        for (int i = gt; i < 256 * 128; i += NGT) { const int m = i >> 7, k = i & 127, part = m >> 7, rp = (m >> 6) & 1, k1 = m & 63, rp2 = k >> 6, aa = k & 63;
            float sv, cv; sincospif((float)((k1 * aa) & 63) * (1.f / 32.f), &sv, &cv); const float v = (rp == rp2) ? (part ? -sv : cv) * 0.125f : 0.f;
            D1T[i] = (bf16_t)(cvt_pk_bf16(v, v) & 0xffffu); }
        for (int i = gt; i < 256 * 256; i += NGT) { const int m = i >> 8, k = i & 255, kp = m >> 7, po = (m >> 6) & 1, k2 = m & 63, kp2 = k >> 7, part = (k >> 6) & 1, rp = (k >> 5) & 1, r = 2 * (k & 31) + rp;
            float sv, cv; sincospif((float)((k2 * r) & 63) * (1.f / 32.f), &sv, &cv);
            const float v = (kp == kp2) ? (po == 0 ? (part == 0 ? cv : sv) : (part == 0 ? -sv : cv)) * 0.125f : 0.f;
            D2T[i] = (bf16_t)(cvt_pk_bf16(v, v) & 0xffffu); }
        for (int i = gt; i < 256 * 512; i += NGT) { const int kc = i >> 9, k = i & 511, part = k >> 8, cc = k & 255;
            float sv, cv; sincospif((float)((kc * cc) & 255) * (1.f / 128.f), &sv, &cv); const float v = (part ? sv : cv) * (1.f / 16.f);
            CS2[i] = (bf16_t)(cvt_pk_bf16(v, v) & 0xffffu); }
        for (int i = gt; i < 4096; i += NGT) { float sv, cv; sincospif((float)i * (1.f / 2048.f), &sv, &cv); TWT[i] = (f32x2){cv, sv}; }
    }
    grid.sync();

    for (int rs = 0; rs < REP_SYNC; ++rs) GRID_BAR();
    for (int row = gw; row < MT; row += NGW) {
        const bool lat = row < M; const int r = lat ? (row >> 12) : 4;
        const float* xin = lat ? a.x + (size_t)row * D : a.ctx + (size_t)(row - M) * D;
        const float* ad = ADA + (size_t)r * 6 * D;
        row_op(lane, nullptr, xin, nullptr, nullptr, nullptr, a.norm_g, ad, ad + D, HB + (size_t)row * D);
    }
    GRID_BAR();

    PH(0) { pg8::Gemm g{HB, Wqkv, D, D, D}; pg8::SchedQKV S{G, bx}; pg8::EpiQKV E{Qb, Kb, Vb, ROPE};
      pg8::gemm_phase(lds, g, S, E); }
    GRID_BAR();

    {
        if (tid < 128) ((LAS float*)(lds + att::SUBG))[tid] = a.subg[tid] * 0.8f;
        if (wave == 0) { const float p01 = wave_sum(a.lam[lane] * a.lam[64 + lane]), p23 = wave_sum(a.lam[128 + lane] * a.lam[192 + lane]);
            if (lane == 0) *(LAS float*)(lds + att::LAMO) = expf(p01) - expf(p23) + 0.2f; }
        __syncthreads();
        for (int rep = 0; rep < REP_ATT; ++rep)
        if (G == 256) { for (int i = 0; i < 8; ++i) { const int bh = (bx & 7) * 8 + i, qb = bx >> 3; att::attn_unit(bh >> 4, bh & 15, qb, Qb, Kb, Vb, Ob, lds); } }
        else { for (int u = bx; u < 2048; u += G) { const int bh = u >> 5, qb = u & 31; att::attn_unit(bh >> 4, bh & 15, qb, Qb, Kb, Vb, Ob, lds); } }
    }
    GRID_BAR();

    PH(1) { pg8::Gemm g{Ob, Wo, D, D, D}; pg8::SchedStd S{64, 8, G, bx, D, D, D}; pg8::EpiPlain E{YB, D}; pg8::gemm_phase(lds, g, S, E); }
    GRID_BAR();

    for (int row = gw; row < M; row += NGW) { const float* ad = ADA + (size_t)(row >> 12) * 6 * D;
        row_op(lane, YB + (size_t)row * D, a.x + (size_t)row * D, ad + 2 * D, a.norm_g + D, a.out + (size_t)row * D, a.norm_g + 2 * D, ad + 3 * D, ad + 4 * D, HB + (size_t)row * D); }
    GRID_BAR();

    for (int repg = 0; repg < REP_GU; ++repg)
    PH(2) { pg8::Gemm g{HB, Wgu, D, D, D}; pg8::SchedStd S{64, 44, G, bx, D, D, 0}; pg8::EpiSwiGLU E{HID}; pg8::gemm_phase(lds, g, S, E); }
    GRID_BAR();
    PH(3) { pg8::Gemm g{HID, Wdn, FF, FF, FF}; pg8::SchedStd S{64, 8, G, bx, FF, FF, D}; pg8::EpiPlain E{YB, D}; pg8::gemm_phase(lds, g, S, E); }
    GRID_BAR();

    for (int row = gw; row < M; row += NGW) { const float* ad = ADA + (size_t)(row >> 12) * 6 * D; const float* ad1 = ADA + (size_t)(5 + (row >> 12)) * 6 * D;
        row_op(lane, YB + (size_t)row * D, a.out + (size_t)row * D, ad + 5 * D, a.norm_g + 3 * D, a.out + (size_t)row * D, a.norm_g + 4 * D, ad1, ad1 + D, HB + (size_t)((row & ~4095) + (row & 63) * 64 + ((row & 4095) >> 6)) * D); }
    GRID_BAR();

    PH(4) { pg8::Gemm g{Win, HB, D, D, D}; pg8::SchedInT S{G, bx}; pg8::EpiPlain E{Ub, SEQ}; pg8::gemm_phase(lds, g, S, E); }
    GRID_BAR();
    PH(5) { pg8::Gemm g{D1T, Ub, 128, 128, 128}; pg8::SchedCols S{G, bx, 1024, 128}; pg8::EpiFft1 E{A2b, TWT}; pg8::gemm_phase(lds, g, S, E); }
    GRID_BAR();
    PH(6) { pg8::Gemm g{D2T, A2b, 256, 256, 256}; pg8::SchedCols S{G, bx, 1024, 256}; pg8::EpiFft2 E{Xb}; pg8::gemm_phase(lds, g, S, E); }
    GRID_BAR();
    PH(10) { pg8::Gemm g{Xb, CS2, 4096, 512, 512}; pg8::SchedChan S{G, bx}; pg8::EpiPlain E{Fb, D}; pg8::gemm_phase(lds, g, S, E); }
    GRID_BAR();
    PH(7) { pg8::Gemm g{Fb, Wout, D, D, D}; pg8::SchedStd S{64, 8, G, bx, D, D, D}; pg8::EpiPlain E{YB, D}; pg8::gemm_phase(lds, g, S, E); }
    GRID_BAR();

    for (int row = gw; row < M; row += NGW) { const float* ad = ADA + (size_t)(5 + (row >> 12)) * 6 * D; const float* ng = a.norm_g + 4 * D;
        row_op(lane, YB + (size_t)row * D, a.out + (size_t)row * D, ad + 2 * D, ng + D, a.out + (size_t)row * D, ng + 2 * D, ad + 3 * D, ad + 4 * D, HB + (size_t)row * D); }
    GRID_BAR();

    PH(8) { pg8::Gemm g{HB, Wgu + (size_t)NGU * D, D, D, D}; pg8::SchedStd S{64, 44, G, bx, D, D, 0}; pg8::EpiSwiGLU E{HID}; pg8::gemm_phase(lds, g, S, E); }
    GRID_BAR();
    PH(9) { pg8::Gemm g{HID, Wdn + (size_t)D * FF, FF, FF, FF}; pg8::SchedStd S{64, 8, G, bx, FF, FF, D}; pg8::EpiPlain E{YB, D}; pg8::gemm_phase(lds, g, S, E); }
    GRID_BAR();

    for (int row = gw; row < M; row += NGW) { const float* ad = ADA + (size_t)(5 + (row >> 12)) * 6 * D; const float* ng = a.norm_g + 4 * D;
        row_op(lane, YB + (size_t)row * D, a.out + (size_t)row * D, ad + 5 * D, ng + 3 * D, a.out + (size_t)row * D, nullptr, nullptr, nullptr, nullptr); }
}

extern "C" void kernel_launch(void* const* d_in, const int* in_sizes, int n_in, void* d_out, int out_size, void* d_ws, size_t ws_size, hipStream_t stream) {
    static int grid = 0;
    if (grid == 0) {
        if (n_in != 15 || in_sizes[0] != M * D || out_size != M * D || ws_size < WS_END) {
            fprintf(stderr, "kernel_launch: unexpected shapes / workspace (n_in %d, in0 %d, out %d, ws %zu, need %zu)\n", n_in, n_in > 0 ? in_sizes[0] : -1, out_size, ws_size, (size_t)WS_END);
            grid = -1; return; }
        int dev = 0, cus = 0, per_cu = 0;
        hipGetDevice(&dev);
        hipDeviceGetAttribute(&cus, hipDeviceAttributeMultiprocessorCount, dev);
        if (hipFuncSetAttribute((const void*)fwd_megakernel, hipFuncAttributeMaxDynamicSharedMemorySize, LDS_BYTES) != hipSuccess) { fprintf(stderr, "kernel_launch: hipFuncSetAttribute failed\n"); grid = -1; return; }
        hipOccupancyMaxActiveBlocksPerMultiprocessor(&per_cu, (const void*)fwd_megakernel, 512, LDS_BYTES);
        if (per_cu < 1) { fprintf(stderr, "kernel_launch: occupancy query says %d blocks per CU\n", per_cu); per_cu = 1; }
        (void)hipGetLastError();
        grid = cus * 1;
    }
    if (grid < 0) return;
    if (hipMemsetAsync(d_ws, 0, 16384, stream) != hipSuccess) { fprintf(stderr, "kernel_launch: hipMemsetAsync of the barrier words failed\n"); return; }
    Args a{};
    a.x = (const float*)d_in[0]; a.c = (const float*)d_in[1]; a.ctx = (const float*)d_in[2]; a.c_ctx = (const float*)d_in[3];
    a.mod_w = (const float*)d_in[4]; a.mod_b = (const float*)d_in[5]; a.norm_g = (const float*)d_in[6]; a.w_gu = (const float*)d_in[7]; a.w_dn = (const float*)d_in[8];
    a.w_qkv = (const float*)d_in[9]; a.w_o = (const float*)d_in[10]; a.lam = (const float*)d_in[11]; a.subg = (const float*)d_in[12]; a.w_in = (const float*)d_in[13]; a.w_out = (const float*)d_in[14];
    a.out = (float*)d_out; a.ws = (unsigned char*)d_ws;
    void* args[] = {&a};
    hipError_t e = hipLaunchCooperativeKernel((const void*)fwd_megakernel, dim3(grid), dim3(512), args, LDS_BYTES, stream);
    if (e != hipSuccess) fprintf(stderr, "cooperative launch failed: %s (grid %d)\n", hipGetErrorString(e), grid);
}
```

```cpp
#include <hip/hip_runtime.h>
#include <hip/hip_cooperative_groups.h>
#include <cstdio>
#include <cstdint>
namespace cg = cooperative_groups;

#define LAS __attribute__((address_space(3)))
typedef unsigned short bf16_t;
typedef short bf16x8 __attribute__((ext_vector_type(8)));
typedef short s16x4 __attribute__((ext_vector_type(4)));
typedef float f32x4 __attribute__((ext_vector_type(4)));
typedef float f32x2 __attribute__((ext_vector_type(2)));
typedef float f32x16 __attribute__((ext_vector_type(16)));
typedef unsigned u32x4 __attribute__((ext_vector_type(4)));
typedef unsigned u32x2 __attribute__((ext_vector_type(2)));

constexpr int D = 2048, NB = 4, SEQ = 4096, M = NB * SEQ, LC = 256, MC = NB * LC, MT = M + MC;
constexpr int NH = 16, HD = 64, VD = 128, NQKV = 6144, FF = 5632, NGU = 2 * FF, SK = SEQ + LC;
constexpr float RMS_EPS = 1e-6f;
constexpr float QSCALE = 0.125f * 1.4426950408889634f;

constexpr size_t MiB = 1u << 20;
constexpr size_t WS_ADA = 1 * MiB;
constexpr size_t WS_ROPE = 1 * MiB + 768 * 1024;
constexpr size_t WS_D1 = 2 * MiB;
constexpr size_t WS_D2 = 2 * MiB + 64 * 1024;
constexpr size_t WS_CS2 = 2 * MiB + 192 * 1024;
constexpr size_t WS_TW = 2 * MiB + 448 * 1024;
constexpr size_t WS_WQKV = 3 * MiB;
constexpr size_t WS_WO = 27 * MiB;
constexpr size_t WS_WIN = 35 * MiB;
constexpr size_t WS_WOUT = 43 * MiB;
constexpr size_t WS_WGU = 51 * MiB;
constexpr size_t WS_WDN = 139 * MiB;
constexpr size_t WS_HB = 183 * MiB;
constexpr size_t WS_YB = 251 * MiB;
constexpr size_t WS_R = 315 * MiB;
constexpr size_t WS_Q = WS_R;
constexpr size_t WS_K = WS_R + 64 * MiB;
constexpr size_t WS_V = WS_R + 132 * MiB;
constexpr size_t WS_O = WS_R + 200 * MiB;
constexpr size_t WS_HID = WS_R;
constexpr size_t WS_U = WS_R + 200 * MiB;
constexpr size_t WS_A2 = WS_R;
constexpr size_t WS_X = WS_R + 128 * MiB;
constexpr size_t WS_F = WS_R;
constexpr size_t WS_END = WS_R + 264 * MiB;

constexpr int LDS_BYTES = 147456;

typedef __bf16 bf16x2_t __attribute__((ext_vector_type(2)));
__device__ __forceinline__ unsigned cvt_pk_bf16(float lo, float hi) { const f32x2 v = {lo, hi}; const bf16x2_t b = __builtin_convertvector(v, bf16x2_t); return __builtin_bit_cast(unsigned, b); }
__device__ __forceinline__ float bf2f(unsigned short b) { return __uint_as_float(((unsigned)b) << 16); }
__device__ __forceinline__ float bflo(unsigned w) { return __uint_as_float(w << 16); }
__device__ __forceinline__ float bfhi(unsigned w) { return __uint_as_float(w & 0xffff0000u); }
__device__ __forceinline__ float wave_sum(float v) {
#pragma unroll
    for (int o = 1; o < 64; o <<= 1) v += __shfl_xor(v, o);
    return v;
}
__device__ __forceinline__ float silu_f(float v) { return v / (1.f + __expf(-v)); }

namespace pg8 {
constexpr int BM = 256, BK = 64, HALF = 128, HTB = HALF * BK * 2, NXCD = 8, WGM = 8;
__host__ __device__ __forceinline__ int lds_byte(int r, int c) { const int st = (r >> 4) * 2 + (c >> 5), rr = r & 15, cc = c & 31, ob = rr * 64 + cc * 2; return st * 1024 + (ob ^ (((ob >> 9) & 1) << 5)); }
__host__ __device__ __forceinline__ void stage_rc(int b, int& R, int& C) { const int st = b / 1024, sb = b % 1024, swz = sb ^ (((sb >> 9) & 1) << 5); R = (st >> 1) * 16 + swz / 64; C = (st & 1) * 32 + (swz % 64) / 2; }
__host__ __device__ __forceinline__ int perm32(int rho) { const int n = rho >> 4, i = rho & 15; return 8 * (i >> 2) + 4 * n + (i & 3); }

struct Unit { int pm, pn; size_t aoff, boff, coff; };
struct Gemm { const bf16_t* A; const bf16_t* Bt; int lda, ldb, K; };

__device__ __forceinline__ void swz_order(int L, int nM, int nN, int& pm, int& pn) {
    const int nwg = nM * nN; int wgid = L;
    { const int q = nwg / NXCD, r = nwg % NXCD, xcd = wgid % NXCD, off = wgid / NXCD; wgid = (xcd < r ? xcd * (q + 1) : r * (q + 1) + (xcd - r) * q) + off; }
    const int nig = WGM * nN, gid = wgid / nig, fm = gid * WGM, gsz = (nM - fm) < WGM ? (nM - fm) : WGM;
    pm = fm + ((wgid % nig) % gsz); pn = (wgid % nig) / gsz;
}

template <class Epi, class Sched>
__device__ __forceinline__ void gemm_phase(LAS unsigned char* lds, const Gemm g, const Sched& S, const Epi& E) {
    int tid = threadIdx.x; asm volatile("" : "+v"(tid));
    const int wid = __builtin_amdgcn_readfirstlane(tid >> 6), lane = tid & 63, wr = wid >> 2, wc = wid & 3, fr = lane & 15, fq = lane >> 4;
    int nt = g.K / BK; asm volatile("" : "+s"(nt));
    unsigned voffA[2], voffB[2];
#pragma unroll
    for (int i = 0; i < 2; ++i) { int R, C; stage_rc(tid * 16 + i * 8192, R, C); const int Rb = (R & ~31) + perm32(R & 31);
        voffA[i] = (unsigned)(R * g.lda + C) * 2u; voffB[i] = (unsigned)(Rb * g.ldb + C) * 2u; }
    const size_t kstep = (size_t)(BK * 2);
    const size_t hstepA = (size_t)HALF * g.lda * 2, hstepB = (size_t)HALF * g.ldb * 2;
    const unsigned ldsw = (unsigned)wid * 1024u;
    const int aoff = lds_byte(wr * 64 + fr, fq * 8), boff = lds_byte(wc * 32 + fr, fq * 8);
#define PG8_SA(b, h) (((b) * 2 + (h)) * HTB)
#define PG8_SB(b, h) ((4 + (b) * 2 + (h)) * HTB)
#define PG8_STAGE(bufoff, gbase, voff) do { _Pragma("unroll") for (int _i = 0; _i < 2; ++_i) \
        __builtin_amdgcn_global_load_lds((const unsigned*)((const char*)(gbase) + (voff)[_i]), (LAS unsigned*)(lds + (bufoff) + ldsw + _i * 8192), 16, 0, 0); } while (0)
#define PG8_LDA(dst, b, h) do { _Pragma("unroll") for (int m = 0; m < 4; ++m) _Pragma("unroll") for (int k = 0; k < 2; ++k) dst[m][k] = *(const LAS bf16x8*)(lds + PG8_SA(b, h) + aoff + m * 2048 + k * 1024); } while (0)
#define PG8_LDB(dst, b, h) do { _Pragma("unroll") for (int n = 0; n < 2; ++n) _Pragma("unroll") for (int k = 0; k < 2; ++k) dst[n][k] = *(const LAS bf16x8*)(lds + PG8_SB(b, h) + boff + n * 2048 + k * 1024); } while (0)
#define PG8_MMA(ai, bj, At, Bt) do { __builtin_amdgcn_s_setprio(1); _Pragma("unroll") for (int m = 0; m < 4; ++m) _Pragma("unroll") for (int n = 0; n < 2; ++n) _Pragma("unroll") for (int k = 0; k < 2; ++k) \
        acc[ai][bj][m][n] = __builtin_amdgcn_mfma_f32_16x16x32_bf16(Bt[n][k], At[m][k], acc[ai][bj][m][n], 0, 0, 0); __builtin_amdgcn_s_setprio(0); } while (0)
#define PG8_WAIT_V(n) asm volatile("s_waitcnt vmcnt(" #n ")" ::: "memory")
#define PG8_WAIT_L(n) asm volatile("s_waitcnt lgkmcnt(" #n ")" ::: "memory")
#define PG8_BAR __builtin_amdgcn_s_barrier()
#define PG8_SCHED __builtin_amdgcn_sched_barrier(0)
    Unit cur, nxt; int ui = 0;
    if (!S.next(0, cur)) return;
    f32x4 acc[2][2][4][2];
#pragma unroll
    for (int a = 0; a < 2; ++a)
#pragma unroll
        for (int b = 0; b < 2; ++b)
#pragma unroll
            for (int m = 0; m < 4; ++m)
#pragma unroll
                for (int n = 0; n < 2; ++n) acc[a][b][m][n] = (f32x4){0.f, 0.f, 0.f, 0.f};
    bf16x8 At[4][2], B0[2][2], B1[2][2];
    const char* cA = (const char*)g.A + cur.aoff; const char* cB = (const char*)g.Bt + cur.boff;
    PG8_STAGE(PG8_SB(0, 0), cB, voffB); PG8_STAGE(PG8_SB(0, 1), cB + hstepB, voffB); PG8_STAGE(PG8_SA(0, 0), cA, voffA); PG8_STAGE(PG8_SA(0, 1), cA + hstepA, voffA);
    if (wr == 1) PG8_BAR;
    PG8_WAIT_V(2); PG8_BAR;
    PG8_STAGE(PG8_SB(1, 0), cB + kstep, voffB); PG8_STAGE(PG8_SA(1, 0), cA + kstep, voffA); PG8_STAGE(PG8_SB(1, 1), cB + hstepB + kstep, voffB);
    PG8_WAIT_V(6); PG8_BAR;
    for (;;) {
        const bool has_next = S.next(ui + 1, nxt);
        const char* nA = has_next ? (const char*)g.A + nxt.aoff : cA; const char* nB = has_next ? (const char*)g.Bt + nxt.boff : cB;
        for (int t = 0; t < nt; t += 2) {
            const bool last = (t == nt - 2);
            const char* a1 = cA + (size_t)(t + 1) * kstep;
            const char* a2 = last ? nA : cA + (size_t)(t + 2) * kstep; const char* b2 = last ? nB : cB + (size_t)(t + 2) * kstep;
            const char* a3 = a2 + kstep; const char* b3 = b2 + kstep;
            PG8_LDB(B0, 0, 0); PG8_LDB(B1, 0, 1); PG8_SCHED; PG8_LDA(At, 0, 0); PG8_STAGE(PG8_SA(1, 1), a1 + hstepA, voffA);
            PG8_WAIT_V(8); PG8_WAIT_L(0); PG8_BAR; PG8_MMA(0, 0, At, B0); PG8_MMA(0, 1, At, B1); PG8_BAR; PG8_SCHED;
            PG8_LDA(At, 0, 1); PG8_STAGE(PG8_SB(0, 0), b2, voffB); PG8_STAGE(PG8_SB(0, 1), b2 + hstepB, voffB); PG8_STAGE(PG8_SA(0, 0), a2, voffA);
            PG8_WAIT_V(8); PG8_WAIT_L(0); PG8_BAR; PG8_MMA(1, 0, At, B0); PG8_MMA(1, 1, At, B1); PG8_BAR; PG8_SCHED;
            PG8_LDB(B0, 1, 0); PG8_LDB(B1, 1, 1); PG8_SCHED; PG8_LDA(At, 1, 0); PG8_STAGE(PG8_SA(0, 1), a2 + hstepA, voffA);
            PG8_WAIT_V(8); PG8_WAIT_L(0); PG8_BAR; PG8_MMA(0, 0, At, B0); PG8_MMA(0, 1, At, B1); PG8_BAR; PG8_SCHED;
            PG8_LDA(At, 1, 1); PG8_STAGE(PG8_SB(1, 0), b3, voffB); PG8_STAGE(PG8_SB(1, 1), b3 + hstepB, voffB); PG8_STAGE(PG8_SA(1, 0), a3, voffA);
            PG8_WAIT_V(8); PG8_WAIT_L(0); PG8_BAR; PG8_MMA(1, 0, At, B0); PG8_MMA(1, 1, At, B1); PG8_BAR; PG8_SCHED;
        }
        if (wr == 0) PG8_BAR;
        { int t2 = threadIdx.x; asm volatile("" : "+v"(t2)); const int fr2 = t2 & 15, fq2 = (t2 >> 4) & 3;
          E(acc, cur, wr, wc, fr2, fq2); }
        if (!has_next) break;
#pragma unroll
        for (int a = 0; a < 2; ++a)
#pragma unroll
            for (int b = 0; b < 2; ++b)
#pragma unroll
                for (int m = 0; m < 4; ++m)
#pragma unroll
                    for (int n = 0; n < 2; ++n) acc[a][b][m][n] = (f32x4){0.f, 0.f, 0.f, 0.f};
        cur = nxt; cA = nA; cB = nB; ++ui;
        if (wr == 1) PG8_BAR;
    }
    PG8_WAIT_V(0);
    PG8_BAR;
#undef PG8_SA
#undef PG8_SB
#undef PG8_STAGE
#undef PG8_LDA
#undef PG8_LDB
#undef PG8_MMA
#undef PG8_WAIT_V
#undef PG8_WAIT_L
#undef PG8_BAR
#undef PG8_SCHED
}

struct SchedStd {
    int nM, nN, G, c, lda, ldb, ldc;
    __device__ __forceinline__ bool next(int i, Unit& u) const {
        const int L = i * G + c; if (L >= nM * nN) return false;
        swz_order(L, nM, nN, u.pm, u.pn);
        u.aoff = (size_t)u.pm * BM * lda * 2; u.boff = (size_t)u.pn * BM * ldb * 2; u.coff = (size_t)u.pm * BM * ldc + (size_t)u.pn * BM; return true;
    }
};
struct SchedQKV {
    int G, c;
    __device__ __forceinline__ bool next(int i, Unit& u) const {
        const int L = i * G + c; if (L >= 1536 + 64) return false;
        if (L < 1536) swz_order(L, 64, 24, u.pm, u.pn); else { const int l2 = L - 1536; u.pm = 64 + (l2 & 3); u.pn = 8 + (l2 >> 2); }
        u.aoff = (size_t)u.pm * BM * D * 2; u.boff = (size_t)u.pn * BM * D * 2; u.coff = 0; return true;
    }
};
struct SchedInT {
    int G, c;
    __device__ __forceinline__ bool next(int i, Unit& u) const {
        const int L = i * G + c; if (L >= 512) return false;
        swz_order(L, 8, 64, u.pm, u.pn);
        u.aoff = (size_t)u.pm * BM * D * 2; u.boff = (size_t)u.pn * BM * D * 2;
        u.coff = ((size_t)((u.pn >> 4) * D + u.pm * BM)) * SEQ + (u.pn & 15) * BM; return true;
    }
};
struct SchedCols {
    int G, c, nU, ldb;
    __device__ __forceinline__ bool next(int i, Unit& u) const {
        const int L = i * G + c; if (L >= nU) return false;
        size_t z = 0; asm volatile("" : "+s"(z));
        u.pm = 0; u.pn = L; u.aoff = z; u.boff = (size_t)L * BM * ldb * 2; u.coff = 0; return true;
    }
};
struct SchedChan {
    int G, c;
    __device__ __forceinline__ bool next(int i, Unit& u) const {
        const int L = i * G + c; if (L >= 512) return false;
        u.pm = L >> 3; u.pn = L & 7;
        size_t z = 0; asm volatile("" : "+s"(z));
        u.aoff = ((size_t)u.pm * BM * 4096 + u.pn * 512) * 2; u.boff = z; u.coff = (size_t)u.pm * BM * D + u.pn * BM; return true;
    }
};

struct EpiPlain {
    bf16_t* O; int ldc;
    __device__ __forceinline__ void operator()(const f32x4 (&acc)[2][2][4][2], const Unit& u, int wr, int wc, int fr, int fq) const {
        bf16_t* base = O + u.coff + (size_t)(wr * 64 + fr) * ldc + wc * 32 + 8 * fq;
#pragma unroll
        for (int ai = 0; ai < 2; ++ai)
#pragma unroll
            for (int m = 0; m < 4; ++m) { bf16_t* rowp = base + (size_t)(ai * HALF + m * 16) * ldc;
#pragma unroll
                for (int bj = 0; bj < 2; ++bj) { const f32x4 v0 = acc[ai][bj][m][0], v1 = acc[ai][bj][m][1];
                    u32x4 w; w.x = cvt_pk_bf16(v0[0], v0[1]); w.y = cvt_pk_bf16(v0[2], v0[3]); w.z = cvt_pk_bf16(v1[0], v1[1]); w.w = cvt_pk_bf16(v1[2], v1[3]);
                    *(u32x4*)(rowp + bj * HALF) = w; } }
    }
};
struct EpiSwiGLU {
    bf16_t* O;
    __device__ __forceinline__ void operator()(const f32x4 (&acc)[2][2][4][2], const Unit& u, int wr, int wc, int fr, int fq) const {
        bf16_t* base = O + (size_t)(u.pm * BM + wr * 64 + fr) * FF + u.pn * 128 + wc * 32 + 8 * fq;
#pragma unroll
        for (int ai = 0; ai < 2; ++ai)
#pragma unroll
            for (int m = 0; m < 4; ++m) { bf16_t* rowp = base + (size_t)(ai * HALF + m * 16) * FF;
                float o[8];
#pragma unroll
                for (int n = 0; n < 2; ++n)
#pragma unroll
                    for (int j = 0; j < 4; ++j) { const float gv = acc[ai][0][m][n][j], uv = acc[ai][1][m][n][j];
                        o[n * 4 + j] = gv * uv * __builtin_amdgcn_rcpf(1.f + __builtin_amdgcn_exp2f(-1.4426950408889634f * gv)); }
                u32x4 w; w.x = cvt_pk_bf16(o[0], o[1]); w.y = cvt_pk_bf16(o[2], o[3]); w.z = cvt_pk_bf16(o[4], o[5]); w.w = cvt_pk_bf16(o[6], o[7]);
                *(u32x4*)rowp = w; }
    }
};
struct EpiFft1 {
    bf16_t* A2; const f32x2* tw;
    __device__ __forceinline__ void operator()(const f32x4 (&acc)[2][2][4][2], const Unit& u, int wr, int wc, int fr, int fq) const {
#pragma unroll
        for (int bj = 0; bj < 2; ++bj) { const int gcol = u.pn * 8 + 4 * bj + wc, b = gcol >> 11, col = gcol & 2047;
#pragma unroll
            for (int m = 0; m < 4; ++m) { const int k1 = 16 * m + fr; float re[8], im[8];
#pragma unroll
                for (int n = 0; n < 2; ++n)
#pragma unroll
                    for (int j = 0; j < 4; ++j) { const int r = 2 * (8 * fq + 4 * n + j) + wr; const f32x2 t = tw[k1 * r];
                        const float ar = acc[0][bj][m][n][j], ai = acc[1][bj][m][n][j];
                        re[n * 4 + j] = ar * t.x + ai * t.y; im[n * 4 + j] = ai * t.x - ar * t.y; }
                bf16_t* dst = A2 + (((size_t)(b * 32 + (k1 >> 1)) * D + col) * 256) + (k1 & 1) * 128 + wr * 32 + 8 * fq;
                u32x4 w; w.x = cvt_pk_bf16(re[0], re[1]); w.y = cvt_pk_bf16(re[2], re[3]); w.z = cvt_pk_bf16(re[4], re[5]); w.w = cvt_pk_bf16(re[6], re[7]);
                *(u32x4*)dst = w;
                w.x = cvt_pk_bf16(im[0], im[1]); w.y = cvt_pk_bf16(im[2], im[3]); w.z = cvt_pk_bf16(im[4], im[5]); w.w = cvt_pk_bf16(im[6], im[7]);
                *(u32x4*)(dst + 64) = w; } }
    }
};
struct EpiFft2 {
    bf16_t* X;
    __device__ __forceinline__ void operator()(const f32x4 (&acc)[2][2][4][2], const Unit& u, int wr, int wc, int fr, int fq) const {
        const int bk = u.pn >> 3, b = bk >> 5, k1p = bk & 31, gq = u.pn & 7;
#pragma unroll
        for (int ai = 0; ai < 2; ++ai)
#pragma unroll
            for (int m = 0; m < 4; ++m) { const int k2 = 16 * m + fr, tok = b * SEQ + 2 * k1p + ai + 64 * k2;
                bf16_t* rowp = X + (size_t)tok * 4096 + gq * 512 + wr * 256 + wc * 32 + 8 * fq;
#pragma unroll
                for (int bj = 0; bj < 2; ++bj) { const f32x4 v0 = acc[ai][bj][m][0], v1 = acc[ai][bj][m][1];
                    u32x4 w; w.x = cvt_pk_bf16(v0[0], v0[1]); w.y = cvt_pk_bf16(v0[2], v0[3]); w.z = cvt_pk_bf16(v1[0], v1[1]); w.w = cvt_pk_bf16(v1[2], v1[3]);
                    *(u32x4*)(rowp + bj * HALF) = w; } }
    }
};
struct EpiQKV {
    bf16_t *Q, *K, *V; const float* rope;
    __device__ __forceinline__ void operator()(const f32x4 (&acc)[2][2][4][2], const Unit& u, int wr, int wc, int fr, int fq) const {
        const int sec = u.pn >> 3, h0 = (u.pn & 7) * 2;
        const bool latent = u.pm < 64;
        const int b = latent ? (u.pm >> 4) : (u.pm - 64);
        const int tok0 = (latent ? (u.pm & 15) * 256 : SEQ) + wr * 64 + fr;
        const int cm = wc >> 1, axis = wc & 1;
#pragma unroll
        for (int ai = 0; ai < 2; ++ai)
#pragma unroll
            for (int m = 0; m < 4; ++m) {
                const int tok = tok0 + ai * HALF + m * 16;
                f32x4 c4 = {1.f, 1.f, 1.f, 1.f}, s4 = {0.f, 0.f, 0.f, 0.f};
                if (sec < 2 && latent) { const int pos = axis ? (tok & 63) : (tok >> 6); c4 = *(const f32x4*)(rope + pos * 16 + 4 * fq); s4 = *(const f32x4*)(rope + 1024 + pos * 16 + 4 * fq); }
#pragma unroll
                for (int bj = 0; bj < 2; ++bj) {
                    const int h = h0 + bj;
                    f32x4 v0 = acc[ai][bj][m][0], v1 = acc[ai][bj][m][1];
                    bf16_t* dst;
                    if (sec < 2) {
                        const f32x4 a = v0 * c4 - v1 * s4, bb = v1 * c4 + v0 * s4; v0 = a; v1 = bb;
                        if (sec == 0) { v0 = v0 * QSCALE; v1 = v1 * QSCALE; dst = Q + ((size_t)(((b * NH + h) * 2 + cm) * SEQ + tok)) * HD + axis * 32 + 8 * fq; }
                        else dst = K + ((size_t)(((b * NH + h) * 2 + cm) * SK + tok)) * HD + axis * 32 + 8 * fq;
                    } else dst = V + ((size_t)((b * NH + h) * SK + tok)) * VD + wc * 32 + 8 * fq;
                    u32x4 w; w.x = cvt_pk_bf16(v0[0], v0[1]); w.y = cvt_pk_bf16(v0[2], v0[3]); w.z = cvt_pk_bf16(v1[0], v1[1]); w.w = cvt_pk_bf16(v1[2], v1[3]);
                    *(u32x4*)dst = w;
                }
            }
    }
};
}

namespace att {
constexpr int NT = SK / 64;
constexpr int PD = 3, NS = PD + 1;
constexpr int KSL = 16384, VSL = 16384;
constexpr int KR = 0, VR = NS * KSL;
constexpr int XCH = 0, OST = 65536, SUBG = 132 * 1024, LAMO = SUBG + 512;
static_assert(VR + NS * VSL <= SUBG, "attention rings overlap the constants");
constexpr float THR = 8.f;
__device__ __forceinline__ float xmax(float v) { auto rr = __builtin_amdgcn_permlane32_swap(__float_as_uint(v), __float_as_uint(v), false, false); return fmaxf(__uint_as_float(rr[0]), __uint_as_float(rr[1])); }
__device__ __forceinline__ float xsum(float v) { auto rr = __builtin_amdgcn_permlane32_swap(__float_as_uint(v), __float_as_uint(v), false, false); return __uint_as_float(rr[0]) + __uint_as_float(rr[1]); }
#define MX3(a, b, c) __builtin_fmaxf(__builtin_fmaxf((a), (b)), (c))

__device__ __forceinline__ void attn_unit(int b, int h, int qb, const bf16_t* Q, const bf16_t* K, const bf16_t* V, bf16_t* O, LAS unsigned char* lds) {
    int tid = threadIdx.x; asm volatile("" : "+v"(tid));
    const int lane = tid & 63, r32 = lane & 31, hi = lane >> 5; const int wid = __builtin_amdgcn_readfirstlane(tid >> 6);
    const int cm = wid >> 2, wq = wid & 3;
    const bf16_t* Qp = Q + ((size_t)(((b * NH + h) * 2 + cm) * SEQ + qb * 128 + wq * 32 + r32)) * HD + hi * 8;
    const int kkey = tid >> 3;
    const bf16_t* K0g = K + ((size_t)((b * NH + h) * 2) * SK) * HD + (size_t)kkey * HD + (((tid & 7) ^ ((kkey >> 1) & 7)) * 8);
    const bf16_t* K1g = K0g + (size_t)SK * HD;
    const bf16_t* Vg0 = V + (size_t)((b * NH + h) * SK) * VD + (size_t)((((tid >> 6) & 3) * 16) + ((tid >> 2) & 15)) * VD + (tid >> 8) * 32 + (tid & 3) * 8;
    const bf16_t* Vg1 = Vg0 + 64;
    const unsigned wbase = (unsigned)wid * 1024u;
    const unsigned lds_base = (unsigned)(size_t)lds;
    const int toff = (qb * 17) % NT;
#define GLDS16(gsrc, ldsoff) do { unsigned keep_; const unsigned dst_ = (unsigned)__builtin_amdgcn_readfirstlane((int)(lds_base + (ldsoff))); \
        asm volatile("s_mov_b32 %0, m0\n\ts_mov_b32 m0, %2\n\ts_nop 0\n\tglobal_load_lds_dwordx4 %1, off\n\ts_mov_b32 m0, %0" : "=&s"(keep_) : "v"(gsrc), "s"(dst_) : "memory"); } while (0)
#define ATT_TILE(t) ({ int tt_ = (t) + toff; if (tt_ >= NT) tt_ -= NT; if (tt_ >= NT) tt_ -= NT; tt_; })
#define ATT_DMAK(t, sl) do { const size_t ko_ = (size_t)ATT_TILE(t) * 64 * HD; \
        GLDS16(K0g + ko_, KR + (sl) * KSL + wbase); GLDS16(K1g + ko_, KR + (sl) * KSL + 8192 + wbase); } while (0)
#define ATT_DMAV(t, sl) do { const size_t vo_ = (size_t)ATT_TILE(t) * 64 * VD; \
        GLDS16(Vg0 + vo_, VR + (sl) * VSL + wbase); GLDS16(Vg1 + vo_, VR + (sl) * VSL + 8192 + wbase); } while (0)
#define ATT_WAITBAR(N) do { asm volatile("s_waitcnt vmcnt(%0)" :: "n"(N) : "memory"); __builtin_amdgcn_s_barrier(); } while (0)
    static_assert(PD == 3, "the DMA schedule below is written for PD = 3 (4-slot rings)");
    ATT_DMAK(0, 0); ATT_DMAK(1, 1); ATT_DMAV(0, 0); ATT_DMAK(2, 2); ATT_DMAV(1, 1); ATT_DMAK(3, 3); ATT_DMAV(2, 2);
    bf16x8 qr[4];
#pragma unroll
    for (int d0 = 0; d0 < 4; ++d0) qr[d0] = *(const bf16x8*)(Qp + d0 * 16);
    f32x16 o[4];
#pragma unroll
    for (int e = 0; e < 4; ++e) o[e] = (f32x16){};
    float mrun, lsum = 0.f;
    int kro4[4];
#pragma unroll
    for (int d0 = 0; d0 < 4; ++d0) kro4[d0] = cm * 8192 + r32 * 128 + (((2 * d0 + hi) ^ ((r32 >> 1) & 7)) * 16);
    const int vro = VR + ((lane >> 4) & 1) * 32 + (lane & 3) * 8 + (4 * hi + ((lane & 15) >> 2)) * 64;
#define ATT_QK(P0, P1, so) do { P0 = (f32x16){}; P1 = (f32x16){}; _Pragma("unroll") for (int d0 = 0; d0 < 4; ++d0) { \
        const bf16x8 k0_ = *(const LAS bf16x8*)(lds + (so) + kro4[d0]); const bf16x8 k1_ = *(const LAS bf16x8*)(lds + (so) + kro4[d0] + 4096); \
        P0 = __builtin_amdgcn_mfma_f32_32x32x16_bf16(k0_, qr[d0], P0, 0, 0, 0); P1 = __builtin_amdgcn_mfma_f32_32x32x16_bf16(k1_, qr[d0], P1, 0, 0, 0); } } while (0)
    f32x16 pA0, pA1, pB0, pB1;
    ATT_WAITBAR(12);
    ATT_QK(pA0, pA1, KR);
    { float a_ = -1e30f;
#pragma unroll
      for (int j = 0; j < 16; ++j) a_ = MX3(a_, pA0[j], pA1[j]);
      mrun = xmax(a_);
#pragma unroll
      for (int j = 0; j < 16; ++j) { pA0[j] = __builtin_amdgcn_exp2f(pA0[j] - mrun); pA1[j] = __builtin_amdgcn_exp2f(pA1[j] - mrun); } }
    asm volatile("s_waitcnt lgkmcnt(0)" ::: "memory"); __builtin_amdgcn_s_barrier();
    ATT_DMAK(4, 0);
    ATT_WAITBAR(8);
    bf16x8 kf[8];
#pragma unroll
    for (int d0 = 0; d0 < 4; ++d0) { kf[2 * d0] = *(const LAS bf16x8*)(lds + KR + 1 * KSL + kro4[d0]); kf[2 * d0 + 1] = *(const LAS bf16x8*)(lds + KR + 1 * KSL + kro4[d0] + 4096); }
    asm volatile("s_waitcnt lgkmcnt(0)" ::: "memory"); __builtin_amdgcn_s_barrier();
    int sl0 = 0, sl1 = 1;
#define SBAR() __builtin_amdgcn_sched_barrier(0)
#define VTR(ks, eb, half) __builtin_bit_cast(s16x4, __builtin_amdgcn_ds_read_tr16_b64_v4i16((LAS s16x4*)(lds + sl0 * VSL + vro + (eb) * 4096 + (ks) * 1024 + (half) * 512)))
#define ATT_STEP(P0, P1, N0, N1, t) do { \
        ATT_DMAK((t) + 5, sl1); ATT_DMAV((t) + 3, (sl0 == 0 ? NS - 1 : sl0 - 1)); \
        const int sl2_ = (sl1 == NS - 1) ? 0 : sl1 + 1; \
        s16x4 vl_[4][4], vh_[4][4]; \
        _Pragma("unroll") for (int eb = 0; eb < 4; ++eb) { vl_[0][eb] = VTR(0, eb, 0); vh_[0][eb] = VTR(0, eb, 1); } \
        SBAR(); \
        N0 = (f32x16){}; N1 = (f32x16){}; \
        float ls_ = 0.f; unsigned w0_[8], w1_[8]; \
        _Pragma("unroll") for (int i = 0; i < 8; ++i) { \
            if ((i & 1) == 0) N0 = __builtin_amdgcn_mfma_f32_32x32x16_bf16(kf[i], qr[i >> 1], N0, 0, 0, 0); \
            else              N1 = __builtin_amdgcn_mfma_f32_32x32x16_bf16(kf[i], qr[i >> 1], N1, 0, 0, 0); \
            ls_ += (P0[2 * i] + P0[2 * i + 1]) + (P1[2 * i] + P1[2 * i + 1]); \
            w0_[i] = cvt_pk_bf16(P0[2 * i], P0[2 * i + 1]); w1_[i] = cvt_pk_bf16(P1[2 * i], P1[2 * i + 1]); \
            SBAR(); } \
        lsum += ls_; \
        bf16x8 pa_[4]; \
        pa_[0] = __builtin_bit_cast(bf16x8, (u32x4){w0_[0], w0_[1], w0_[2], w0_[3]}); pa_[1] = __builtin_bit_cast(bf16x8, (u32x4){w0_[4], w0_[5], w0_[6], w0_[7]}); \
        pa_[2] = __builtin_bit_cast(bf16x8, (u32x4){w1_[0], w1_[1], w1_[2], w1_[3]}); pa_[3] = __builtin_bit_cast(bf16x8, (u32x4){w1_[4], w1_[5], w1_[6], w1_[7]}); \
        float al_ = 1.f; bool resc_ = false; float mxn_ = -1e30f; \
        _Pragma("unroll") for (int ks = 0; ks < 4; ++ks) { \
            _Pragma("unroll") for (int eb = 0; eb < 4; ++eb) { \
                const bf16x8 vf_ = (bf16x8){vl_[ks][eb][0], vl_[ks][eb][1], vl_[ks][eb][2], vl_[ks][eb][3], vh_[ks][eb][0], vh_[ks][eb][1], vh_[ks][eb][2], vh_[ks][eb][3]}; \
                o[eb] = __builtin_amdgcn_mfma_f32_32x32x16_bf16(vf_, pa_[ks], o[eb], 0, 0, 0); \
                if (ks < 3) { vl_[ks + 1][eb] = VTR(ks + 1, eb, 0); vh_[ks + 1][eb] = VTR(ks + 1, eb, 1); } \
                if (ks == 0) { _Pragma("unroll") for (int j = 0; j < 4; ++j) mxn_ = MX3(mxn_, N0[eb * 4 + j], N1[eb * 4 + j]); } \
                if (ks == 1 || ks == 3) { const int i_ = (ks >> 1) * 4 + eb; \
                    N0[2 * i_] = __builtin_amdgcn_exp2f(N0[2 * i_] - mrun); N0[2 * i_ + 1] = __builtin_amdgcn_exp2f(N0[2 * i_ + 1] - mrun); \
                    N1[2 * i_] = __builtin_amdgcn_exp2f(N1[2 * i_] - mrun); N1[2 * i_ + 1] = __builtin_amdgcn_exp2f(N1[2 * i_ + 1] - mrun); } \
                if (ks == 2) { kf[2 * eb] = *(const LAS bf16x8*)(lds + KR + sl2_ * KSL + kro4[eb]); kf[2 * eb + 1] = *(const LAS bf16x8*)(lds + KR + sl2_ * KSL + kro4[eb] + 4096); } \
                SBAR(); } \
            if (ks == 0) { mxn_ = xmax(mxn_); \
                if ((t) + 1 < NT && __any(mxn_ > mrun + THR)) { const float mn_ = fmaxf(mrun, mxn_); al_ = __builtin_amdgcn_exp2f(mrun - mn_); mrun = mn_; lsum *= al_; resc_ = true; } \
                SBAR(); } } \
        if (resc_) { _Pragma("unroll") for (int e = 0; e < 4; ++e) _Pragma("unroll") for (int i = 0; i < 16; ++i) o[e][i] *= al_; } \
        SBAR(); \
        asm volatile("s_waitcnt vmcnt(8) lgkmcnt(0)" ::: "memory"); __builtin_amdgcn_s_barrier(); \
        SBAR(); \
        sl0 = sl1; sl1 = sl2_; \
    } while (0)
    for (int t = 0; t < NT; t += 2) {
        ATT_STEP(pA0, pA1, pB0, pB1, t);
        ATT_STEP(pB0, pB1, pA0, pA1, t + 1);
    }
    asm volatile("s_waitcnt vmcnt(0)" ::: "memory"); __builtin_amdgcn_s_barrier();
#undef SBAR
#undef VTR
#undef ATT_STEP
#undef ATT_QK
#undef ATT_DMAK
#undef ATT_TILE
#undef GLDS16
#undef ATT_DMAV
#undef ATT_WAITBAR
    const float linv = 1.f / xsum(lsum);
    LAS float* xch = (LAS float*)(lds + XCH) + wq * 64 * 64 + lane;
    if (cm == 1) {
#pragma unroll
        for (int e = 0; e < 4; ++e)
#pragma unroll
            for (int i = 0; i < 16; ++i) xch[(e * 16 + i) * 64] = o[e][i] * linv;
    }
    __syncthreads();
    if (cm == 0) {
        const float lam = *(const LAS float*)(lds + LAMO);
        float ss = 0.f;
#pragma unroll
        for (int e = 0; e < 4; ++e)
#pragma unroll
            for (int i = 0; i < 16; ++i) { const float v = o[e][i] * linv - lam * xch[(e * 16 + i) * 64]; o[e][i] = v; ss += v * v; }
        ss = xsum(ss);
        const float rn = __builtin_amdgcn_rsqf(ss * (1.f / VD) + RMS_EPS);
        const LAS float* sg = (const LAS float*)(lds + SUBG);
        LAS unsigned char* stg = lds + OST + wq * (32 * 272);
#pragma unroll
        for (int e = 0; e < 4; ++e)
#pragma unroll
            for (int i4 = 0; i4 < 4; ++i4) { const int e0 = 32 * e + 8 * i4 + 4 * hi;
                const f32x4 g4 = *(const LAS f32x4*)(sg + e0);
                u32x2 w; w.x = cvt_pk_bf16(o[e][4 * i4] * rn * g4[0], o[e][4 * i4 + 1] * rn * g4[1]); w.y = cvt_pk_bf16(o[e][4 * i4 + 2] * rn * g4[2], o[e][4 * i4 + 3] * rn * g4[3]);
                *(LAS u32x2*)(stg + r32 * 272 + e0 * 2) = w; }
        asm volatile("s_waitcnt lgkmcnt(0)" ::: "memory");
        bf16_t* Ow = O + ((size_t)(b * SEQ + qb * 128 + wq * 32)) * D + h * VD;
#pragma unroll
        for (int it = 0; it < 8; ++it) { const int id = it * 64 + lane, row = id >> 4, ch = id & 15;
            const u32x4 v = *(const LAS u32x4*)(stg + row * 272 + ch * 16);
            *(u32x4*)(Ow + (size_t)row * D + ch * 8) = v; }
    }
    __syncthreads();
}
}

#define XB_TMO      128
#define XB_XCNT(j)  (256  + 64 * (j))
#define XB_XSUB(j)  (1280 + 64 * (j))
#define XB_XGEN(j)  (2304 + 64 * (j))
#define XB_TOP      3328
#define XB_TOPGEN   3392
#define XCD_BAR_WORDS 3456
#define XB_SPIN_CAP (1u << 20)
__device__ __forceinline__ unsigned xb_ld(unsigned* p)              { return __hip_atomic_load(p, __ATOMIC_RELAXED, __HIP_MEMORY_SCOPE_AGENT); }
__device__ __forceinline__ unsigned xb_add(unsigned* p, unsigned v) { return __hip_atomic_fetch_add(p, v, __ATOMIC_RELAXED, __HIP_MEMORY_SCOPE_AGENT); }
__device__ __forceinline__ unsigned xb_xcc_id() { return (unsigned)__builtin_amdgcn_s_getreg((3 << 11) | 20) & 0xFu; }
#define XB_SPIN(cond, bar) do { unsigned _sp = 0; while (cond) { __builtin_amdgcn_s_sleep(1); \
    if ((++_sp & 255u) == 0u) { if (xb_ld(&(bar)[XB_TMO])) break; if (_sp > XB_SPIN_CAP) { atomicAdd(&(bar)[XB_TMO], 1u); break; } } } } while (0)
__device__ __forceinline__ void xcd_barrier_complete(unsigned* bar, unsigned x, unsigned& nloc, unsigned& nx) {
    const unsigned G = gridDim.x;
    unsigned sum, cnt, mine, sp = 0u;
    for (;;) {
        sum = 0u; cnt = 0u; mine = 0u;
#pragma unroll
        for (unsigned j = 0; j < 16; ++j) { const unsigned c = xb_ld(&bar[XB_XCNT(j)]); sum += c; cnt += (c > 0u) ? 1u : 0u; mine = (j == x) ? c : mine; }
        if (sum == G) break;
        __builtin_amdgcn_s_sleep(1);
        if ((++sp & 255u) == 0u) { if (xb_ld(&bar[XB_TMO])) break; if (sp > XB_SPIN_CAP) { atomicAdd(&bar[XB_TMO], 1u); break; } }
    }
    nloc = mine > 0u ? mine : 1u; nx = cnt > 0u ? cnt : 1u;
}
__device__ __forceinline__ void xcd_barrier(unsigned* bar, volatile LAS unsigned* st) {
    asm volatile("s_waitcnt vmcnt(0)" ::: "memory");
    __syncthreads();
    if (threadIdx.x == 0) {
        const unsigned x = xb_xcc_id();
        __builtin_amdgcn_s_waitcnt(0);
        unsigned nloc = st[0], nx = st[1];
        if (nloc == 0u) { xcd_barrier_complete(bar, x, nloc, nx); st[0] = nloc; st[1] = nx; }
        const unsigned old = xb_add(&bar[XB_XSUB(x)], 1u);
        const unsigned gen = old / nloc;
        if (old + 1u == (gen + 1u) * nloc) {
            __builtin_amdgcn_fence(__ATOMIC_RELEASE, "agent");
            asm volatile("s_waitcnt vmcnt(0)" ::: "memory");
            const unsigned og = xb_add(&bar[XB_TOP], 1u);
            const unsigned tg = og / nx;
            if (og + 1u == (tg + 1u) * nx) xb_add(&bar[XB_TOPGEN], 1u);
            else XB_SPIN(xb_ld(&bar[XB_TOPGEN]) == tg, bar);
            __builtin_amdgcn_fence(__ATOMIC_ACQUIRE, "agent");
            xb_add(&bar[XB_XGEN(x)], 1u);
            asm volatile("s_waitcnt vmcnt(0)" ::: "memory");
        } else {
            XB_SPIN(xb_ld(&bar[XB_XGEN(x)]) == gen, bar);
            __builtin_amdgcn_fence(__ATOMIC_ACQUIRE, "agent");
            asm volatile("s_waitcnt vmcnt(0)" ::: "memory");
        }
    }
    __syncthreads();
}
constexpr int LDS_BARST = 140 * 1024;

#ifndef PH_MASK
#define PH_MASK 0xFFFFFFu
#endif
#ifndef REP_ATT
#define REP_ATT 1
#endif
#ifndef REP_GU
#define REP_GU 1
#endif
#ifndef REP_SYNC
#define REP_SYNC 0
#endif
#ifndef REP_ROW
#define REP_ROW 1
#endif
#ifndef REP_P0
#define REP_P0 1
#endif
#define PH(k) if constexpr ((PH_MASK >> (k)) & 1u)
struct Args {
    const float *x, *c, *ctx, *c_ctx, *mod_w, *mod_b, *norm_g, *w_gu, *w_dn, *w_qkv, *w_o, *lam, *subg, *w_in, *w_out;
    float* out; unsigned char* ws;
};

__device__ __forceinline__ void transpose_item(const float* W, int K, int Nsrc, int Ndst, bf16_t* WT, int mode, LAS float* scr, int item, int lane) {
    const int nblk = Ndst / 32, kb = item / nblk, nb = item % nblk, k0 = 64 * kb, n0 = 32 * nb, i = lane & 31;
    int src;
    if (mode == 1 && n0 < 4096) src = n0 + ((i >> 2) & 1) * 16 + ((i >> 3) & 3) * 4 + (i & 3);
    else if (mode == 2) { const int tile = n0 >> 8, r0 = n0 & 255; src = (r0 < 128 ? tile * 128 + r0 : FF + tile * 128 + r0 - 128) + i; }
    else src = n0 + i;
#pragma unroll 8
    for (int q = 0; q < 32; ++q) { const int kk = 2 * q + (lane >> 5); scr[kk * 33 + i] = W[(size_t)(k0 + kk) * Nsrc + src]; }
    asm volatile("s_waitcnt lgkmcnt(0)" ::: "memory");
    const int c = lane & 7;
#pragma unroll
    for (int j = 0; j < 4; ++j) { const int n = (lane >> 3) + 8 * j; const LAS float* s = scr + (8 * c) * 33 + n;
        u32x4 o; o.x = cvt_pk_bf16(s[0 * 33], s[1 * 33]); o.y = cvt_pk_bf16(s[2 * 33], s[3 * 33]); o.z = cvt_pk_bf16(s[4 * 33], s[5 * 33]); o.w = cvt_pk_bf16(s[6 * 33], s[7 * 33]);
        *(u32x4*)(WT + (size_t)(n0 + n) * K + k0 + 8 * c) = o; }
    asm volatile("s_waitcnt lgkmcnt(0)" ::: "memory");
}

__device__ __forceinline__ void row_op(int lane, const bf16_t* y, const float* xin, const float* gate, const float* gy, float* xout,
                                       const float* gh, const float* sh, const float* sc, bf16_t* hb) {
    asm volatile("" : "+v"(lane));
    f32x4 v[8];
#pragma unroll
    for (int j = 0; j < 8; ++j) v[j] = *(const f32x4*)(xin + j * 256 + lane * 4);
    if (y) {
        u32x2 yw[8]; float ss = 0.f;
#pragma unroll
        for (int j = 0; j < 8; ++j) { yw[j] = *(const u32x2*)(y + j * 256 + lane * 4);
            const float a = bflo(yw[j].x), b = bfhi(yw[j].x), c = bflo(yw[j].y), d = bfhi(yw[j].y); ss += (a * a + b * b) + (c * c + d * d); }
        const float ry = __builtin_amdgcn_rsqf(wave_sum(ss) * (1.f / D) + RMS_EPS);
#pragma unroll
        for (int j = 0; j < 8; ++j) { const f32x4 g4 = *(const f32x4*)(gate + j * 256 + lane * 4), w4 = *(const f32x4*)(gy + j * 256 + lane * 4);
            const f32x4 yv = {bflo(yw[j].x), bfhi(yw[j].x), bflo(yw[j].y), bfhi(yw[j].y)};
            v[j] = v[j] + g4 * (yv * ry * w4); }
#pragma unroll
        for (int j = 0; j < 8; ++j) *(f32x4*)(xout + j * 256 + lane * 4) = v[j];
    }
    if (hb) {
        float ss = 0.f;
#pragma unroll
        for (int j = 0; j < 8; ++j) ss += (v[j].x * v[j].x + v[j].y * v[j].y) + (v[j].z * v[j].z + v[j].w * v[j].w);
        const float r = __builtin_amdgcn_rsqf(wave_sum(ss) * (1.f / D) + RMS_EPS);
#pragma unroll
        for (int j = 0; j < 8; ++j) { const f32x4 g4 = *(const f32x4*)(gh + j * 256 + lane * 4), s4 = *(const f32x4*)(sh + j * 256 + lane * 4), c4 = *(const f32x4*)(sc + j * 256 + lane * 4);
            const f32x4 hv = v[j] * r * g4 * (c4 + 1.f) + s4;
            u32x2 w; w.x = cvt_pk_bf16(hv.x, hv.y); w.y = cvt_pk_bf16(hv.z, hv.w);
            *(u32x2*)(hb + j * 256 + lane * 4) = w; }
    }
}

template <bool HAS_Y, bool HAS_H>
__device__ __forceinline__ void row_phase(int lane, int gw, int NGW, const bf16_t* Y, const float* Xin, float* Xout, const float* ada_layer, int cg, const float* gy,
                                          const float* gh, int csh, int csc, bf16_t* Hout, bool perm) {
    asm volatile("" : "+v"(lane));
    const int b = gw & 3;
    const float* ad = ada_layer + (size_t)b * 6 * D;
    f32x4 pa[8], pb[8], pc[8];
#pragma unroll
    for (int j = 0; j < 8; ++j) { const int c = j * 256 + lane * 4;
        if (HAS_Y) pa[j] = *(const f32x4*)(ad + cg * D + c) * *(const f32x4*)(gy + c);
        if (HAS_H) { pb[j] = *(const f32x4*)(gh + c) * (*(const f32x4*)(ad + csc * D + c) + 1.f); pc[j] = *(const f32x4*)(ad + csh * D + c); } }
    for (int idx = gw; idx < M; idx += NGW) {
        const int t = idx >> 2; const size_t row = (size_t)b * SEQ + t;
        f32x4 v[8];
#pragma unroll
        for (int j = 0; j < 8; ++j) v[j] = *(const f32x4*)(Xin + row * D + j * 256 + lane * 4);
        if (HAS_Y) {
            u32x2 yw[8]; float ss = 0.f;
#pragma unroll
            for (int j = 0; j < 8; ++j) { yw[j] = *(const u32x2*)(Y + row * D + j * 256 + lane * 4);
                const float a0 = bflo(yw[j].x), a1 = bfhi(yw[j].x), a2 = bflo(yw[j].y), a3 = bfhi(yw[j].y); ss += (a0 * a0 + a1 * a1) + (a2 * a2 + a3 * a3); }
            const float ry = __builtin_amdgcn_rsqf(wave_sum(ss) * (1.f / D) + RMS_EPS);
#pragma unroll
            for (int j = 0; j < 8; ++j) { const f32x4 yv = {bflo(yw[j].x), bfhi(yw[j].x), bflo(yw[j].y), bfhi(yw[j].y)};
                v[j] = v[j] + pa[j] * (yv * ry);
                *(f32x4*)(Xout + row * D + j * 256 + lane * 4) = v[j]; }
        }
        if (HAS_H) {
            float ss = 0.f;
#pragma unroll
            for (int j = 0; j < 8; ++j) ss += (v[j].x * v[j].x + v[j].y * v[j].y) + (v[j].z * v[j].z + v[j].w * v[j].w);
            const float r = __builtin_amdgcn_rsqf(wave_sum(ss) * (1.f / D) + RMS_EPS);
            const size_t hrow = perm ? (size_t)b * SEQ + (t & 63) * 64 + (t >> 6) : row;
#pragma unroll
            for (int j = 0; j < 8; ++j) { const f32x4 hv = v[j] * r * pb[j] + pc[j];
                u32x2 w; w.x = cvt_pk_bf16(hv.x, hv.y); w.y = cvt_pk_bf16(hv.z, hv.w);
                *(u32x2*)(Hout + hrow * D + j * 256 + lane * 4) = w; }
        }
    }
}

__global__ void __launch_bounds__(512, 2) fwd_megakernel(Args a) {
    extern __shared__ __attribute__((aligned(16))) unsigned char lds_raw[];
    LAS unsigned char* lds = (LAS unsigned char*)lds_raw;
    cg::grid_group grid = cg::this_grid();
    const int tid = threadIdx.x, lane = tid & 63, wave = __builtin_amdgcn_readfirstlane(tid >> 6);
    const int G = gridDim.x, bx = blockIdx.x;
    const int gw = bx * 8 + wave, NGW = G * 8;
    if (tid < 2) ((LAS unsigned*)(lds + LDS_BARST))[tid] = 0u;
    if (tid == 0) (void)xb_add(&((unsigned*)a.ws)[XB_XCNT(xb_xcc_id())], 1u);
    __syncthreads();
#define GRID_BAR() xcd_barrier((unsigned*)WSB, (volatile LAS unsigned*)(lds + LDS_BARST))
#define WSB ({ unsigned char* _w = a.ws; asm volatile("" : "+s"(_w)); _w; })
#define ADA ((float*)(WSB + WS_ADA))
#define ROPE ((float*)(WSB + WS_ROPE))
#define D1T ((bf16_t*)(WSB + WS_D1))
#define D2T ((bf16_t*)(WSB + WS_D2))
#define CS2 ((bf16_t*)(WSB + WS_CS2))
#define TWT ((f32x2*)(WSB + WS_TW))
#define Wqkv ((bf16_t*)(WSB + WS_WQKV))
#define Wo ((bf16_t*)(WSB + WS_WO))
#define Win ((bf16_t*)(WSB + WS_WIN))
#define Wout ((bf16_t*)(WSB + WS_WOUT))
#define Wgu ((bf16_t*)(WSB + WS_WGU))
#define Wdn ((bf16_t*)(WSB + WS_WDN))
#define HB ((bf16_t*)(WSB + WS_HB))
#define YB ((bf16_t*)(WSB + WS_YB))
#define Qb ((bf16_t*)(WSB + WS_Q))
#define Kb ((bf16_t*)(WSB + WS_K))
#define Vb ((bf16_t*)(WSB + WS_V))
#define Ob ((bf16_t*)(WSB + WS_O))
#define HID ((bf16_t*)(WSB + WS_HID))
#define Ub ((bf16_t*)(WSB + WS_U))
#define A2b ((bf16_t*)(WSB + WS_A2))
#define Xb ((bf16_t*)(WSB + WS_X))
#define Fb ((bf16_t*)(WSB + WS_F))

    for (int rep0 = 0; rep0 < REP_P0; ++rep0) {
        LAS float* sl = (LAS float*)(lds + 69632);
        LAS float* red = (LAS float*)lds;
        if (bx < 192) {
            for (int i = tid; i < 5 * D; i += 512) { const float cv = (i < 4 * D) ? a.c[i] : a.c_ctx[i - 4 * D]; sl[i] = silu_f(cv); }
            __syncthreads();
            for (int it = bx; it < 192; it += G) {
                const int layer = it / 96, n0 = (it % 96) * 128;
                const float* wp = a.mod_w + (size_t)layer * D * 6 * D + (size_t)(wave * 256) * 6 * D + n0 + lane * 2;
                float ac[5][2];
#pragma unroll
                for (int r = 0; r < 5; ++r) { ac[r][0] = 0.f; ac[r][1] = 0.f; }
#pragma unroll 8
                for (int k = 0; k < 256; ++k) { const f32x2 w = *(const f32x2*)(wp + (size_t)k * 6 * D);
#pragma unroll
                    for (int r = 0; r < 5; ++r) { const float s = sl[r * D + wave * 256 + k]; ac[r][0] += s * w.x; ac[r][1] += s * w.y; } }
#pragma unroll
                for (int r = 0; r < 5; ++r) { red[(wave * 5 + r) * 128 + lane * 2] = ac[r][0]; red[(wave * 5 + r) * 128 + lane * 2 + 1] = ac[r][1]; }
                __syncthreads();
                for (int i = tid; i < 5 * 128; i += 512) { const int r = i >> 7, cc = i & 127; float s = a.mod_b[layer * 6 * D + n0 + cc];
#pragma unroll
                    for (int w = 0; w < 8; ++w) s += red[(w * 5 + r) * 128 + cc];
                    ADA[(size_t)(layer * 5 + r) * 6 * D + n0 + cc] = s; }
                __syncthreads();
            }
        }
        __syncthreads();
        LAS float* scr = (LAS float*)(lds + wave * 8704);
        constexpr int I_QKV = 32 * 192, I_SQ = 32 * 64, I_GU = 32 * 352, I_DN = 88 * 64;
        constexpr int NITEMS = I_QKV + 3 * I_SQ + 2 * I_GU + 2 * I_DN;
        for (int it = gw; it < NITEMS; it += NGW) {
            int r = it;
            if (r < I_QKV) { transpose_item(a.w_qkv, D, NQKV, NQKV, Wqkv, 1, scr, r, lane); continue; } r -= I_QKV;
            if (r < I_SQ) { transpose_item(a.w_o, D, D, D, Wo, 0, scr, r, lane); continue; } r -= I_SQ;
            if (r < I_SQ) { transpose_item(a.w_in, D, D, D, Win, 0, scr, r, lane); continue; } r -= I_SQ;
            if (r < I_SQ) { transpose_item(a.w_out, D, D, D, Wout, 0, scr, r, lane); continue; } r -= I_SQ;
            if (r < 2 * I_GU) { const int l = r / I_GU; transpose_item(a.w_gu + (size_t)l * D * NGU, D, NGU, NGU, Wgu + (size_t)l * NGU * D, 2, scr, r % I_GU, lane); continue; } r -= 2 * I_GU;
            { const int l = r / I_DN; transpose_item(a.w_dn + (size_t)l * FF * D, FF, D, D, Wdn + (size_t)l * D * FF, 0, scr, r % I_DN, lane); }
        }
        const int gt = bx * 512 + tid, NGT = G * 512;
        if (gt < 1024) { const int pos = gt >> 4, f = gt & 15; const float inv = powf(10000.f, -(float)f / 16.f); const float ang = (float)pos * inv;
            ROPE[gt] = cosf(ang); ROPE[1024 + gt] = sinf(ang); }
        for (int i = gt; i < 256 * 128; i += NGT) { const int m = i >> 7, k = i & 127, part = m >> 7, rp = (m >> 6) & 1, k1 = m & 63, rp2 = k >> 6, aa = k & 63;
            float sv, cv; sincospif((float)((k1 * aa) & 63) * (1.f / 32.f), &sv, &cv); const float v = (rp == rp2) ? (part ? -sv : cv) * 0.125f : 0.f;
            D1T[i] = (bf16_t)(cvt_pk_bf16(v, v) & 0xffffu); }
        for (int i = gt; i < 256 * 256; i += NGT) { const int m = i >> 8, k = i & 255, kp = m >> 7, po = (m >> 6) & 1, k2 = m & 63, kp2 = k >> 7, part = (k >> 6) & 1, rp = (k >> 5) & 1, r = 2 * (k & 31) + rp;
            float sv, cv; sincospif((float)((k2 * r) & 63) * (1.f / 32.f), &sv, &cv);
            const float v = (kp == kp2) ? (po == 0 ? (part == 0 ? cv : sv) : (part == 0 ? -sv : cv)) * 0.125f : 0.f;
            D2T[i] = (bf16_t)(cvt_pk_bf16(v, v) & 0xffffu); }
        for (int i = gt; i < 256 * 512; i += NGT) { const int kc = i >> 9, k = i & 511, part = k >> 8, cc = k & 255;
            float sv, cv; sincospif((float)((kc * cc) & 255) * (1.f / 128.f), &sv, &cv); const float v = (part ? sv : cv) * (1.f / 16.f);
            CS2[i] = (bf16_t)(cvt_pk_bf16(v, v) & 0xffffu); }
        for (int i = gt; i < 4096; i += NGT) { float sv, cv; sincospif((float)i * (1.f / 2048.f), &sv, &cv); TWT[i] = (f32x2){cv, sv}; }
    }
    grid.sync();

    for (int rs = 0; rs < REP_SYNC; ++rs) GRID_BAR();
    row_phase<false, true>(lane, gw, NGW, nullptr, a.x, nullptr, ADA, 0, nullptr, a.norm_g, 0, 1, HB, false);
    for (int row = M + gw; row < MT; row += NGW) { const float* ad = ADA + (size_t)4 * 6 * D;
        row_op(lane, nullptr, a.ctx + (size_t)(row - M) * D, nullptr, nullptr, nullptr, a.norm_g, ad, ad + D, HB + (size_t)row * D); }
    GRID_BAR();

    PH(0) { pg8::Gemm g{HB, Wqkv, D, D, D}; pg8::SchedQKV S{G, bx}; pg8::EpiQKV E{Qb, Kb, Vb, ROPE};
      pg8::gemm_phase(lds, g, S, E); }
    GRID_BAR();

    {
        if (tid < 128) ((LAS float*)(lds + att::SUBG))[tid] = a.subg[tid] * 0.8f;
        if (wave == 0) { const float p01 = wave_sum(a.lam[lane] * a.lam[64 + lane]), p23 = wave_sum(a.lam[128 + lane] * a.lam[192 + lane]);
            if (lane == 0) *(LAS float*)(lds + att::LAMO) = expf(p01) - expf(p23) + 0.2f; }
        __syncthreads();
        for (int rep = 0; rep < REP_ATT; ++rep)
        if (G == 256) { for (int i = 0; i < 8; ++i) { const int bh = (bx & 7) * 8 + i, qb = bx >> 3; att::attn_unit(bh >> 4, bh & 15, qb, Qb, Kb, Vb, Ob, lds); } }
        else { for (int u = bx; u < 2048; u += G) { const int bh = u >> 5, qb = u & 31; att::attn_unit(bh >> 4, bh & 15, qb, Qb, Kb, Vb, Ob, lds); } }
    }
    GRID_BAR();

    PH(1) { pg8::Gemm g{Ob, Wo, D, D, D}; pg8::SchedStd S{64, 8, G, bx, D, D, D}; pg8::EpiPlain E{YB, D}; pg8::gemm_phase(lds, g, S, E); }
    GRID_BAR();

    row_phase<true, true>(lane, gw, NGW, YB, a.x, a.out, ADA, 2, a.norm_g + D, a.norm_g + 2 * D, 3, 4, HB, false);
    GRID_BAR();

    for (int repg = 0; repg < REP_GU; ++repg)
    PH(2) { pg8::Gemm g{HB, Wgu, D, D, D}; pg8::SchedStd S{64, 44, G, bx, D, D, 0}; pg8::EpiSwiGLU E{HID}; pg8::gemm_phase(lds, g, S, E); }
    GRID_BAR();
    PH(3) { pg8::Gemm g{HID, Wdn, FF, FF, FF}; pg8::SchedStd S{64, 8, G, bx, FF, FF, D}; pg8::EpiPlain E{YB, D}; pg8::gemm_phase(lds, g, S, E); }
    GRID_BAR();

    {
        const int b = gw & 3; int ln = lane; asm volatile("" : "+v"(ln));
        const float* ad0 = ADA + (size_t)b * 6 * D; const float* ad1 = ADA + (size_t)(5 + b) * 6 * D;
        f32x4 pa[8], pb[8], pc[8];
#pragma unroll
        for (int j = 0; j < 8; ++j) { const int c = j * 256 + ln * 4;
            pa[j] = *(const f32x4*)(ad0 + 5 * D + c) * *(const f32x4*)(a.norm_g + 3 * D + c);
            pb[j] = *(const f32x4*)(a.norm_g + 4 * D + c) * (*(const f32x4*)(ad1 + D + c) + 1.f); pc[j] = *(const f32x4*)(ad1 + c); }
        const bf16_t* Yp = YB; bf16_t* Hp = HB;
        for (int idx = gw; idx < M; idx += NGW) {
            const int t = idx >> 2; const size_t row = (size_t)b * SEQ + t;
            f32x4 v[8]; u32x2 yw[8]; float ss = 0.f;
#pragma unroll
            for (int j = 0; j < 8; ++j) v[j] = *(const f32x4*)(a.out + row * D + j * 256 + ln * 4);
#pragma unroll
            for (int j = 0; j < 8; ++j) { yw[j] = *(const u32x2*)(Yp + row * D + j * 256 + ln * 4);
                const float a0 = bflo(yw[j].x), a1 = bfhi(yw[j].x), a2 = bflo(yw[j].y), a3 = bfhi(yw[j].y); ss += (a0 * a0 + a1 * a1) + (a2 * a2 + a3 * a3); }
            const float ry = __builtin_amdgcn_rsqf(wave_sum(ss) * (1.f / D) + RMS_EPS);
            float s2 = 0.f;
#pragma unroll
            for (int j = 0; j < 8; ++j) { const f32x4 yv = {bflo(yw[j].x), bfhi(yw[j].x), bflo(yw[j].y), bfhi(yw[j].y)};
                v[j] = v[j] + pa[j] * (yv * ry);
                *(f32x4*)(a.out + row * D + j * 256 + ln * 4) = v[j];
                s2 += (v[j].x * v[j].x + v[j].y * v[j].y) + (v[j].z * v[j].z + v[j].w * v[j].w); }
            const float r = __builtin_amdgcn_rsqf(wave_sum(s2) * (1.f / D) + RMS_EPS);
            const size_t hrow = (size_t)b * SEQ + (t & 63) * 64 + (t >> 6);
#pragma unroll
            for (int j = 0; j < 8; ++j) { const f32x4 hv = v[j] * r * pb[j] + pc[j];
                u32x2 w; w.x = cvt_pk_bf16(hv.x, hv.y); w.y = cvt_pk_bf16(hv.z, hv.w);
                *(u32x2*)(Hp + hrow * D + j * 256 + ln * 4) = w; }
        }
    }
    GRID_BAR();

    PH(4) { pg8::Gemm g{Win, HB, D, D, D}; pg8::SchedInT S{G, bx}; pg8::EpiPlain E{Ub, SEQ}; pg8::gemm_phase(lds, g, S, E); }
    GRID_BAR();
    PH(5) { pg8::Gemm g{D1T, Ub, 128, 128, 128}; pg8::SchedCols S{G, bx, 1024, 128}; pg8::EpiFft1 E{A2b, TWT}; pg8::gemm_phase(lds, g, S, E); }
    GRID_BAR();
    PH(6) { pg8::Gemm g{D2T, A2b, 256, 256, 256}; pg8::SchedCols S{G, bx, 1024, 256}; pg8::EpiFft2 E{Xb}; pg8::gemm_phase(lds, g, S, E); }
    GRID_BAR();
    PH(10) { pg8::Gemm g{Xb, CS2, 4096, 512, 512}; pg8::SchedChan S{G, bx}; pg8::EpiPlain E{Fb, D}; pg8::gemm_phase(lds, g, S, E); }
    GRID_BAR();
    PH(7) { pg8::Gemm g{Fb, Wout, D, D, D}; pg8::SchedStd S{64, 8, G, bx, D, D, D}; pg8::EpiPlain E{YB, D}; pg8::gemm_phase(lds, g, S, E); }
    GRID_BAR();

    row_phase<true, true>(lane, gw, NGW, YB, a.out, a.out, ADA + (size_t)5 * 6 * D, 2, a.norm_g + 5 * D, a.norm_g + 6 * D, 3, 4, HB, false);
    GRID_BAR();

    PH(8) { pg8::Gemm g{HB, Wgu + (size_t)NGU * D, D, D, D}; pg8::SchedStd S{64, 44, G, bx, D, D, 0}; pg8::EpiSwiGLU E{HID}; pg8::gemm_phase(lds, g, S, E); }
    GRID_BAR();
    PH(9) { pg8::Gemm g{HID, Wdn + (size_t)D * FF, FF, FF, FF}; pg8::SchedStd S{64, 8, G, bx, FF, FF, D}; pg8::EpiPlain E{YB, D}; pg8::gemm_phase(lds, g, S, E); }
    GRID_BAR();

    row_phase<true, false>(lane, gw, NGW, YB, a.out, a.out, ADA + (size_t)5 * 6 * D, 5, a.norm_g + 7 * D, nullptr, 0, 0, nullptr, false);
}

extern "C" void kernel_launch(void* const* d_in, const int* in_sizes, int n_in, void* d_out, int out_size, void* d_ws, size_t ws_size, hipStream_t stream) {
    static int grid = 0;
    if (grid == 0) {
        if (n_in != 15 || in_sizes[0] != M * D || out_size != M * D || ws_size < WS_END) {
            fprintf(stderr, "kernel_launch: unexpected shapes / workspace (n_in %d, in0 %d, out %d, ws %zu, need %zu)\n", n_in, n_in > 0 ? in_sizes[0] : -1, out_size, ws_size, (size_t)WS_END);
            grid = -1; return; }
        int dev = 0, cus = 0, per_cu = 0;
        hipGetDevice(&dev);
        hipDeviceGetAttribute(&cus, hipDeviceAttributeMultiprocessorCount, dev);
        if (hipFuncSetAttribute((const void*)fwd_megakernel, hipFuncAttributeMaxDynamicSharedMemorySize, LDS_BYTES) != hipSuccess) { fprintf(stderr, "kernel_launch: hipFuncSetAttribute failed\n"); grid = -1; return; }
        hipOccupancyMaxActiveBlocksPerMultiprocessor(&per_cu, (const void*)fwd_megakernel, 512, LDS_BYTES);
        if (per_cu < 1) { fprintf(stderr, "kernel_launch: occupancy query says %d blocks per CU\n", per_cu); per_cu = 1; }
        (void)hipGetLastError();
        grid = cus * 1;
    }
    if (grid < 0) return;
    if (hipMemsetAsync(d_ws, 0, 16384, stream) != hipSuccess) { fprintf(stderr, "kernel_launch: hipMemsetAsync of the barrier words failed\n"); return; }
    Args a{};
    a.x = (const float*)d_in[0]; a.c = (const float*)d_in[1]; a.ctx = (const float*)d_in[2]; a.c_ctx = (const float*)d_in[3];
    a.mod_w = (const float*)d_in[4]; a.mod_b = (const float*)d_in[5]; a.norm_g = (const float*)d_in[6]; a.w_gu = (const float*)d_in[7]; a.w_dn = (const float*)d_in[8];
    a.w_qkv = (const float*)d_in[9]; a.w_o = (const float*)d_in[10]; a.lam = (const float*)d_in[11]; a.subg = (const float*)d_in[12]; a.w_in = (const float*)d_in[13]; a.w_out = (const float*)d_in[14];
    a.out = (float*)d_out; a.ws = (unsigned char*)d_ws;
    void* args[] = {&a};
    hipError_t e = hipLaunchCooperativeKernel((const void*)fwd_megakernel, dim3(grid), dim3(512), args, LDS_BYTES, stream);
    if (e != hipSuccess) fprintf(stderr, "cooperative launch failed: %s (grid %d)\n", hipGetErrorString(e), grid);
}
```

```cpp
#include <hip/hip_runtime.h>
#include <hip/hip_cooperative_groups.h>
#include <cstdio>
#include <cstdint>
namespace cg = cooperative_groups;

#define LAS __attribute__((address_space(3)))
typedef unsigned short bf16_t;
typedef short bf16x8 __attribute__((ext_vector_type(8)));
typedef short s16x4 __attribute__((ext_vector_type(4)));
typedef float f32x4 __attribute__((ext_vector_type(4)));
typedef float f32x2 __attribute__((ext_vector_type(2)));
typedef float f32x16 __attribute__((ext_vector_type(16)));
typedef unsigned u32x4 __attribute__((ext_vector_type(4)));
typedef unsigned u32x2 __attribute__((ext_vector_type(2)));

constexpr int D = 2048, NB = 4, SEQ = 4096, M = NB * SEQ, LC = 256, MC = NB * LC, MT = M + MC;
constexpr int NH = 16, HD = 64, VD = 128, NQKV = 6144, FF = 5632, NGU = 2 * FF, SK = SEQ + LC;
constexpr float RMS_EPS = 1e-6f;
constexpr float QSCALE = 0.125f * 1.4426950408889634f;

constexpr size_t MiB = 1u << 20;
constexpr size_t WS_ADA = 1 * MiB;
constexpr size_t WS_ROPE = 1 * MiB + 768 * 1024;
constexpr size_t WS_D1 = 2 * MiB;
constexpr size_t WS_D2 = 2 * MiB + 64 * 1024;
constexpr size_t WS_CS2 = 2 * MiB + 192 * 1024;
constexpr size_t WS_TW = 2 * MiB + 448 * 1024;
constexpr size_t WS_WQKV = 3 * MiB;
constexpr size_t WS_WO = 27 * MiB;
constexpr size_t WS_WIN = 35 * MiB;
constexpr size_t WS_WOUT = 43 * MiB;
constexpr size_t WS_WGU = 51 * MiB;
constexpr size_t WS_WDN = 139 * MiB;
constexpr size_t WS_HB = 183 * MiB;
constexpr size_t WS_YB = 251 * MiB;
constexpr size_t WS_R = 315 * MiB;
constexpr size_t WS_Q = WS_R;
constexpr size_t WS_K = WS_R + 64 * MiB;
constexpr size_t WS_V = WS_R + 132 * MiB;
constexpr size_t WS_O = WS_R + 200 * MiB;
constexpr size_t WS_HID = WS_R;
constexpr size_t WS_U = WS_R + 200 * MiB;
constexpr size_t WS_A2 = WS_R;
constexpr size_t WS_X = WS_R + 128 * MiB;
constexpr size_t WS_F = WS_R;
constexpr size_t WS_XR = WS_R + 264 * MiB;
constexpr size_t WS_END = WS_R + 328 * MiB;

constexpr int LDS_BYTES = 147456;

typedef __bf16 bf16x2_t __attribute__((ext_vector_type(2)));
__device__ __forceinline__ unsigned cvt_pk_bf16(float lo, float hi) { const f32x2 v = {lo, hi}; const bf16x2_t b = __builtin_convertvector(v, bf16x2_t); return __builtin_bit_cast(unsigned, b); }
__device__ __forceinline__ float bf2f(unsigned short b) { return __uint_as_float(((unsigned)b) << 16); }
__device__ __forceinline__ float bflo(unsigned w) { return __uint_as_float(w << 16); }
__device__ __forceinline__ float bfhi(unsigned w) { return __uint_as_float(w & 0xffff0000u); }
__device__ __forceinline__ float wave_sum(float v) {
#pragma unroll
    for (int o = 1; o < 64; o <<= 1) v += __shfl_xor(v, o);
    return v;
}
__device__ __forceinline__ float silu_f(float v) { return v / (1.f + __expf(-v)); }

namespace pg8 {
constexpr int BM = 256, BK = 64, HALF = 128, HTB = HALF * BK * 2, NXCD = 8, WGM = 8;
__host__ __device__ __forceinline__ int lds_byte(int r, int c) { const int st = (r >> 4) * 2 + (c >> 5), rr = r & 15, cc = c & 31, ob = rr * 64 + cc * 2; return st * 1024 + (ob ^ (((ob >> 9) & 1) << 5)); }
__host__ __device__ __forceinline__ void stage_rc(int b, int& R, int& C) { const int st = b / 1024, sb = b % 1024, swz = sb ^ (((sb >> 9) & 1) << 5); R = (st >> 1) * 16 + swz / 64; C = (st & 1) * 32 + (swz % 64) / 2; }
__host__ __device__ __forceinline__ int perm32(int rho) { const int n = rho >> 4, i = rho & 15; return 8 * (i >> 2) + 4 * n + (i & 3); }

struct Unit { int pm, pn; size_t aoff, boff, coff; };
struct Gemm { const bf16_t* A; const bf16_t* Bt; int lda, ldb, K; };

__device__ __forceinline__ void swz_order(int L, int nM, int nN, int& pm, int& pn) {
    const int nwg = nM * nN; int wgid = L;
    { const int q = nwg / NXCD, r = nwg % NXCD, xcd = wgid % NXCD, off = wgid / NXCD; wgid = (xcd < r ? xcd * (q + 1) : r * (q + 1) + (xcd - r) * q) + off; }
    const int nig = WGM * nN, gid = wgid / nig, fm = gid * WGM, gsz = (nM - fm) < WGM ? (nM - fm) : WGM;
    pm = fm + ((wgid % nig) % gsz); pn = (wgid % nig) / gsz;
}

template <class Epi, class Sched>
__device__ __forceinline__ void gemm_phase(LAS unsigned char* lds, const Gemm g, const Sched& S, const Epi& E) {
    int tid = threadIdx.x; asm volatile("" : "+v"(tid));
    const int wid = __builtin_amdgcn_readfirstlane(tid >> 6), lane = tid & 63, wr = wid >> 2, wc = wid & 3, fr = lane & 15, fq = lane >> 4;
    int nt = g.K / BK; asm volatile("" : "+s"(nt));
    unsigned voffA[2], voffB[2];
#pragma unroll
    for (int i = 0; i < 2; ++i) { int R, C; stage_rc(tid * 16 + i * 8192, R, C); const int Rb = (R & ~31) + perm32(R & 31);
        voffA[i] = (unsigned)(R * g.lda + C) * 2u; voffB[i] = (unsigned)(Rb * g.ldb + C) * 2u; }
    const size_t kstep = (size_t)(BK * 2);
    const size_t hstepA = (size_t)HALF * g.lda * 2, hstepB = (size_t)HALF * g.ldb * 2;
    const unsigned ldsw = (unsigned)wid * 1024u;
    const int aoff = lds_byte(wr * 64 + fr, fq * 8), boff = lds_byte(wc * 32 + fr, fq * 8);
#define PG8_SA(b, h) (((b) * 2 + (h)) * HTB)
#define PG8_SB(b, h) ((4 + (b) * 2 + (h)) * HTB)
#define PG8_STAGE(bufoff, gbase, voff) do { _Pragma("unroll") for (int _i = 0; _i < 2; ++_i) \
        __builtin_amdgcn_global_load_lds((const unsigned*)((const char*)(gbase) + (voff)[_i]), (LAS unsigned*)(lds + (bufoff) + ldsw + _i * 8192), 16, 0, 0); } while (0)
#define PG8_LDA(dst, b, h) do { _Pragma("unroll") for (int m = 0; m < 4; ++m) _Pragma("unroll") for (int k = 0; k < 2; ++k) dst[m][k] = *(const LAS bf16x8*)(lds + PG8_SA(b, h) + aoff + m * 2048 + k * 1024); } while (0)
#define PG8_LDB(dst, b, h) do { _Pragma("unroll") for (int n = 0; n < 2; ++n) _Pragma("unroll") for (int k = 0; k < 2; ++k) dst[n][k] = *(const LAS bf16x8*)(lds + PG8_SB(b, h) + boff + n * 2048 + k * 1024); } while (0)
#define PG8_MMA(ai, bj, At, Bt) do { __builtin_amdgcn_s_setprio(1); _Pragma("unroll") for (int m = 0; m < 4; ++m) _Pragma("unroll") for (int n = 0; n < 2; ++n) _Pragma("unroll") for (int k = 0; k < 2; ++k) \
        acc[ai][bj][m][n] = __builtin_amdgcn_mfma_f32_16x16x32_bf16(Bt[n][k], At[m][k], acc[ai][bj][m][n], 0, 0, 0); __builtin_amdgcn_s_setprio(0); } while (0)
#define PG8_WAIT_V(n) asm volatile("s_waitcnt vmcnt(" #n ")" ::: "memory")
#define PG8_WAIT_L(n) asm volatile("s_waitcnt lgkmcnt(" #n ")" ::: "memory")
#define PG8_BAR __builtin_amdgcn_s_barrier()
#define PG8_SCHED __builtin_amdgcn_sched_barrier(0)
    Unit cur, nxt; int ui = 0;
    if (!S.next(0, cur)) return;
    f32x4 acc[2][2][4][2];
#pragma unroll
    for (int a = 0; a < 2; ++a)
#pragma unroll
        for (int b = 0; b < 2; ++b)
#pragma unroll
            for (int m = 0; m < 4; ++m)
#pragma unroll
                for (int n = 0; n < 2; ++n) acc[a][b][m][n] = (f32x4){0.f, 0.f, 0.f, 0.f};
    bf16x8 At[4][2], B0[2][2], B1[2][2];
    const char* cA = (const char*)g.A + cur.aoff; const char* cB = (const char*)g.Bt + cur.boff;
    PG8_STAGE(PG8_SB(0, 0), cB, voffB); PG8_STAGE(PG8_SB(0, 1), cB + hstepB, voffB); PG8_STAGE(PG8_SA(0, 0), cA, voffA); PG8_STAGE(PG8_SA(0, 1), cA + hstepA, voffA);
    if (wr == 1) PG8_BAR;
    PG8_WAIT_V(2); PG8_BAR;
    PG8_STAGE(PG8_SB(1, 0), cB + kstep, voffB); PG8_STAGE(PG8_SA(1, 0), cA + kstep, voffA); PG8_STAGE(PG8_SB(1, 1), cB + hstepB + kstep, voffB);
    PG8_WAIT_V(6); PG8_BAR;
    for (;;) {
        const bool has_next = S.next(ui + 1, nxt);
        const char* nA = has_next ? (const char*)g.A + nxt.aoff : cA; const char* nB = has_next ? (const char*)g.Bt + nxt.boff : cB;
        for (int t = 0; t < nt; t += 2) {
            const bool last = (t == nt - 2);
            const char* a1 = cA + (size_t)(t + 1) * kstep;
            const char* a2 = last ? nA : cA + (size_t)(t + 2) * kstep; const char* b2 = last ? nB : cB + (size_t)(t + 2) * kstep;
            const char* a3 = a2 + kstep; const char* b3 = b2 + kstep;
            PG8_LDB(B0, 0, 0); PG8_LDB(B1, 0, 1); PG8_SCHED; PG8_LDA(At, 0, 0); PG8_STAGE(PG8_SA(1, 1), a1 + hstepA, voffA);
            PG8_WAIT_V(8); PG8_WAIT_L(0); PG8_BAR; PG8_MMA(0, 0, At, B0); PG8_MMA(0, 1, At, B1); PG8_BAR; PG8_SCHED;
            PG8_LDA(At, 0, 1); PG8_STAGE(PG8_SB(0, 0), b2, voffB); PG8_STAGE(PG8_SB(0, 1), b2 + hstepB, voffB); PG8_STAGE(PG8_SA(0, 0), a2, voffA);
            PG8_WAIT_V(8); PG8_WAIT_L(0); PG8_BAR; PG8_MMA(1, 0, At, B0); PG8_MMA(1, 1, At, B1); PG8_BAR; PG8_SCHED;
            PG8_LDB(B0, 1, 0); PG8_LDB(B1, 1, 1); PG8_SCHED; PG8_LDA(At, 1, 0); PG8_STAGE(PG8_SA(0, 1), a2 + hstepA, voffA);
            PG8_WAIT_V(8); PG8_WAIT_L(0); PG8_BAR; PG8_MMA(0, 0, At, B0); PG8_MMA(0, 1, At, B1); PG8_BAR; PG8_SCHED;
            PG8_LDA(At, 1, 1); PG8_STAGE(PG8_SB(1, 0), b3, voffB); PG8_STAGE(PG8_SB(1, 1), b3 + hstepB, voffB); PG8_STAGE(PG8_SA(1, 0), a3, voffA);
            PG8_WAIT_V(8); PG8_WAIT_L(0); PG8_BAR; PG8_MMA(1, 0, At, B0); PG8_MMA(1, 1, At, B1); PG8_BAR; PG8_SCHED;
        }
        if (wr == 0) PG8_BAR;
        { int t2 = threadIdx.x; asm volatile("" : "+v"(t2)); const int fr2 = t2 & 15, fq2 = (t2 >> 4) & 3;
          E(acc, cur, wr, wc, fr2, fq2); }
        if (!has_next) break;
#pragma unroll
        for (int a = 0; a < 2; ++a)
#pragma unroll
            for (int b = 0; b < 2; ++b)
#pragma unroll
                for (int m = 0; m < 4; ++m)
#pragma unroll
                    for (int n = 0; n < 2; ++n) acc[a][b][m][n] = (f32x4){0.f, 0.f, 0.f, 0.f};
        cur = nxt; cA = nA; cB = nB; ++ui;
        if (wr == 1) PG8_BAR;
    }
    PG8_WAIT_V(0);
    PG8_BAR;
#undef PG8_SA
#undef PG8_SB
#undef PG8_STAGE
#undef PG8_LDA
#undef PG8_LDB
#undef PG8_MMA
#undef PG8_WAIT_V
#undef PG8_WAIT_L
#undef PG8_BAR
#undef PG8_SCHED
}

struct SchedStd {
    int nM, nN, G, c, lda, ldb, ldc;
    __device__ __forceinline__ bool next(int i, Unit& u) const {
        const int L = i * G + c; if (L >= nM * nN) return false;
        swz_order(L, nM, nN, u.pm, u.pn);
        u.aoff = (size_t)u.pm * BM * lda * 2; u.boff = (size_t)u.pn * BM * ldb * 2; u.coff = (size_t)u.pm * BM * ldc + (size_t)u.pn * BM; return true;
    }
};
struct SchedQKV {
    int G, c;
    __device__ __forceinline__ bool next(int i, Unit& u) const {
        const int L = i * G + c; if (L >= 1536 + 64) return false;
        if (L < 1536) swz_order(L, 64, 24, u.pm, u.pn); else { const int l2 = L - 1536; u.pm = 64 + (l2 & 3); u.pn = 8 + (l2 >> 2); }
        u.aoff = (size_t)u.pm * BM * D * 2; u.boff = (size_t)u.pn * BM * D * 2; u.coff = 0; return true;
    }
};
struct SchedInT {
    int G, c;
    __device__ __forceinline__ bool next(int i, Unit& u) const {
        const int L = i * G + c; if (L >= 512) return false;
        swz_order(L, 8, 64, u.pm, u.pn);
        u.aoff = (size_t)u.pm * BM * D * 2; u.boff = (size_t)u.pn * BM * D * 2;
        u.coff = ((size_t)((u.pn >> 4) * D + u.pm * BM)) * SEQ + (u.pn & 15) * BM; return true;
    }
};
struct SchedCols {
    int G, c, nU, ldb;
    __device__ __forceinline__ bool next(int i, Unit& u) const {
        const int L = i * G + c; if (L >= nU) return false;
        size_t z = 0; asm volatile("" : "+s"(z));
        u.pm = 0; u.pn = L; u.aoff = z; u.boff = (size_t)L * BM * ldb * 2; u.coff = 0; return true;
    }
};
struct SchedChan {
    int G, c;
    __device__ __forceinline__ bool next(int i, Unit& u) const {
        const int L = i * G + c; if (L >= 512) return false;
        u.pm = L >> 3; u.pn = L & 7;
        size_t z = 0; asm volatile("" : "+s"(z));
        u.aoff = ((size_t)u.pm * BM * 4096 + u.pn * 512) * 2; u.boff = z; u.coff = (size_t)u.pm * BM * D + u.pn * BM; return true;
    }
};

struct EpiPlain {
    bf16_t* O; int ldc;
    __device__ __forceinline__ void operator()(const f32x4 (&acc)[2][2][4][2], const Unit& u, int wr, int wc, int fr, int fq) const {
        bf16_t* base = O + u.coff + (size_t)(wr * 64 + fr) * ldc + wc * 32 + 8 * fq;
#pragma unroll
        for (int ai = 0; ai < 2; ++ai)
#pragma unroll
            for (int m = 0; m < 4; ++m) { bf16_t* rowp = base + (size_t)(ai * HALF + m * 16) * ldc;
#pragma unroll
                for (int bj = 0; bj < 2; ++bj) { const f32x4 v0 = acc[ai][bj][m][0], v1 = acc[ai][bj][m][1];
                    u32x4 w; w.x = cvt_pk_bf16(v0[0], v0[1]); w.y = cvt_pk_bf16(v0[2], v0[3]); w.z = cvt_pk_bf16(v1[0], v1[1]); w.w = cvt_pk_bf16(v1[2], v1[3]);
                    *(u32x4*)(rowp + bj * HALF) = w; } }
    }
};
struct EpiSwiGLU {
    bf16_t* O;
    __device__ __forceinline__ void operator()(const f32x4 (&acc)[2][2][4][2], const Unit& u, int wr, int wc, int fr, int fq) const {
        bf16_t* base = O + (size_t)(u.pm * BM + wr * 64 + fr) * FF + u.pn * 128 + wc * 32 + 8 * fq;
#pragma unroll
        for (int ai = 0; ai < 2; ++ai)
#pragma unroll
            for (int m = 0; m < 4; ++m) { bf16_t* rowp = base + (size_t)(ai * HALF + m * 16) * FF;
                float o[8];
#pragma unroll
                for (int n = 0; n < 2; ++n)
#pragma unroll
                    for (int j = 0; j < 4; ++j) { const float gv = acc[ai][0][m][n][j], uv = acc[ai][1][m][n][j];
                        o[n * 4 + j] = gv * uv * __builtin_amdgcn_rcpf(1.f + __builtin_amdgcn_exp2f(-1.4426950408889634f * gv)); }
                u32x4 w; w.x = cvt_pk_bf16(o[0], o[1]); w.y = cvt_pk_bf16(o[2], o[3]); w.z = cvt_pk_bf16(o[4], o[5]); w.w = cvt_pk_bf16(o[6], o[7]);
                *(u32x4*)rowp = w; }
    }
};
struct EpiFft1 {
    bf16_t* A2; const f32x2* tw;
    __device__ __forceinline__ void operator()(const f32x4 (&acc)[2][2][4][2], const Unit& u, int wr, int wc, int fr, int fq) const {
#pragma unroll
        for (int bj = 0; bj < 2; ++bj) { const int gcol = u.pn * 8 + 4 * bj + wc, b = gcol >> 11, col = gcol & 2047;
#pragma unroll
            for (int m = 0; m < 4; ++m) { const int k1 = 16 * m + fr; float re[8], im[8];
#pragma unroll
                for (int n = 0; n < 2; ++n)
#pragma unroll
                    for (int j = 0; j < 4; ++j) { const int r = 2 * (8 * fq + 4 * n + j) + wr; const f32x2 t = tw[k1 * r];
                        const float ar = acc[0][bj][m][n][j], ai = acc[1][bj][m][n][j];
                        re[n * 4 + j] = ar * t.x + ai * t.y; im[n * 4 + j] = ai * t.x - ar * t.y; }
                bf16_t* dst = A2 + (((size_t)(b * 32 + (k1 >> 1)) * D + col) * 256) + (k1 & 1) * 128 + wr * 32 + 8 * fq;
                u32x4 w; w.x = cvt_pk_bf16(re[0], re[1]); w.y = cvt_pk_bf16(re[2], re[3]); w.z = cvt_pk_bf16(re[4], re[5]); w.w = cvt_pk_bf16(re[6], re[7]);
                *(u32x4*)dst = w;
                w.x = cvt_pk_bf16(im[0], im[1]); w.y = cvt_pk_bf16(im[2], im[3]); w.z = cvt_pk_bf16(im[4], im[5]); w.w = cvt_pk_bf16(im[6], im[7]);
                *(u32x4*)(dst + 64) = w; } }
    }
};
struct EpiFft2 {
    bf16_t* X;
    __device__ __forceinline__ void operator()(const f32x4 (&acc)[2][2][4][2], const Unit& u, int wr, int wc, int fr, int fq) const {
        const int bk = u.pn >> 3, b = bk >> 5, k1p = bk & 31, gq = u.pn & 7;
#pragma unroll
        for (int ai = 0; ai < 2; ++ai)
#pragma unroll
            for (int m = 0; m < 4; ++m) { const int k2 = 16 * m + fr, tok = b * SEQ + 2 * k1p + ai + 64 * k2;
                bf16_t* rowp = X + (size_t)tok * 4096 + gq * 512 + wr * 256 + wc * 32 + 8 * fq;
#pragma unroll
                for (int bj = 0; bj < 2; ++bj) { const f32x4 v0 = acc[ai][bj][m][0], v1 = acc[ai][bj][m][1];
                    u32x4 w; w.x = cvt_pk_bf16(v0[0], v0[1]); w.y = cvt_pk_bf16(v0[2], v0[3]); w.z = cvt_pk_bf16(v1[0], v1[1]); w.w = cvt_pk_bf16(v1[2], v1[3]);
                    *(u32x4*)(rowp + bj * HALF) = w; } }
    }
};
struct EpiQKV {
    bf16_t *Q, *K, *V; const float* rope;
    __device__ __forceinline__ void operator()(const f32x4 (&acc)[2][2][4][2], const Unit& u, int wr, int wc, int fr, int fq) const {
        const int sec = u.pn >> 3, h0 = (u.pn & 7) * 2;
        const bool latent = u.pm < 64;
        const int b = latent ? (u.pm >> 4) : (u.pm - 64);
        const int tok0 = (latent ? (u.pm & 15) * 256 : SEQ) + wr * 64 + fr;
        const int cm = wc >> 1, axis = wc & 1;
#pragma unroll
        for (int ai = 0; ai < 2; ++ai)
#pragma unroll
            for (int m = 0; m < 4; ++m) {
                const int tok = tok0 + ai * HALF + m * 16;
                f32x4 c4 = {1.f, 1.f, 1.f, 1.f}, s4 = {0.f, 0.f, 0.f, 0.f};
                if (sec < 2 && latent) { const int pos = axis ? (tok & 63) : (tok >> 6); c4 = *(const f32x4*)(rope + pos * 16 + 4 * fq); s4 = *(const f32x4*)(rope + 1024 + pos * 16 + 4 * fq); }
#pragma unroll
                for (int bj = 0; bj < 2; ++bj) {
                    const int h = h0 + bj;
                    f32x4 v0 = acc[ai][bj][m][0], v1 = acc[ai][bj][m][1];
                    bf16_t* dst;
                    if (sec < 2) {
                        const f32x4 a = v0 * c4 - v1 * s4, bb = v1 * c4 + v0 * s4; v0 = a; v1 = bb;
                        if (sec == 0) { v0 = v0 * QSCALE; v1 = v1 * QSCALE; dst = Q + ((size_t)(((b * NH + h) * 2 + cm) * SEQ + tok)) * HD + axis * 32 + 8 * fq; }
                        else dst = K + ((size_t)(((b * NH + h) * 2 + cm) * SK + tok)) * HD + axis * 32 + 8 * fq;
                    } else dst = V + ((size_t)((b * NH + h) * SK + tok)) * VD + wc * 32 + 8 * fq;
                    u32x4 w; w.x = cvt_pk_bf16(v0[0], v0[1]); w.y = cvt_pk_bf16(v0[2], v0[3]); w.z = cvt_pk_bf16(v1[0], v1[1]); w.w = cvt_pk_bf16(v1[2], v1[3]);
                    *(u32x4*)dst = w;
                }
            }
    }
};
}

namespace att {
constexpr int NT = SK / 64;
constexpr int PD = 3, NS = PD + 1;
constexpr int KSL = 16384, VSL = 16384;
constexpr int KR = 0, VR = NS * KSL;
constexpr int XCH = 0, OST = 65536, SUBG = 132 * 1024, LAMO = SUBG + 512;
static_assert(VR + NS * VSL <= SUBG, "attention rings overlap the constants");
constexpr float THR = 8.f;
__device__ __forceinline__ float xmax(float v) { auto rr = __builtin_amdgcn_permlane32_swap(__float_as_uint(v), __float_as_uint(v), false, false); return fmaxf(__uint_as_float(rr[0]), __uint_as_float(rr[1])); }
__device__ __forceinline__ float xsum(float v) { auto rr = __builtin_amdgcn_permlane32_swap(__float_as_uint(v), __float_as_uint(v), false, false); return __uint_as_float(rr[0]) + __uint_as_float(rr[1]); }
#define MX3(a, b, c) __builtin_fmaxf(__builtin_fmaxf((a), (b)), (c))

__device__ __forceinline__ void attn_unit(int b, int h, int qb, const bf16_t* Q, const bf16_t* K, const bf16_t* V, bf16_t* O, LAS unsigned char* lds) {
    int tid = threadIdx.x; asm volatile("" : "+v"(tid));
    const int lane = tid & 63, r32 = lane & 31, hi = lane >> 5; const int wid = __builtin_amdgcn_readfirstlane(tid >> 6);
    const int cm = wid >> 2, wq = wid & 3;
    const bf16_t* Qp = Q + ((size_t)(((b * NH + h) * 2 + cm) * SEQ + qb * 128 + wq * 32 + r32)) * HD + hi * 8;
    const int kkey = tid >> 3;
    const bf16_t* K0g = K + ((size_t)((b * NH + h) * 2) * SK) * HD + (size_t)kkey * HD + (((tid & 7) ^ ((kkey >> 1) & 7)) * 8);
    const bf16_t* K1g = K0g + (size_t)SK * HD;
    const bf16_t* Vg0 = V + (size_t)((b * NH + h) * SK) * VD + (size_t)((((tid >> 6) & 3) * 16) + ((tid >> 2) & 15)) * VD + (tid >> 8) * 32 + (tid & 3) * 8;
    const bf16_t* Vg1 = Vg0 + 64;
    const unsigned wbase = (unsigned)wid * 1024u;
    const unsigned lds_base = (unsigned)(size_t)lds;
    const int toff = (qb * 17) % NT;
#define GLDS16(gsrc, ldsoff) do { unsigned keep_; const unsigned dst_ = (unsigned)__builtin_amdgcn_readfirstlane((int)(lds_base + (ldsoff))); \
        asm volatile("s_mov_b32 %0, m0\n\ts_mov_b32 m0, %2\n\ts_nop 0\n\tglobal_load_lds_dwordx4 %1, off\n\ts_mov_b32 m0, %0" : "=&s"(keep_) : "v"(gsrc), "s"(dst_) : "memory"); } while (0)
#define ATT_TILE(t) ({ int tt_ = (t) + toff; if (tt_ >= NT) tt_ -= NT; if (tt_ >= NT) tt_ -= NT; tt_; })
#define ATT_DMAK(t, sl) do { const size_t ko_ = (size_t)ATT_TILE(t) * 64 * HD; \
        GLDS16(K0g + ko_, KR + (sl) * KSL + wbase); GLDS16(K1g + ko_, KR + (sl) * KSL + 8192 + wbase); } while (0)
#define ATT_DMAV(t, sl) do { const size_t vo_ = (size_t)ATT_TILE(t) * 64 * VD; \
        GLDS16(Vg0 + vo_, VR + (sl) * VSL + wbase); GLDS16(Vg1 + vo_, VR + (sl) * VSL + 8192 + wbase); } while (0)
#define ATT_WAITBAR(N) do { asm volatile("s_waitcnt vmcnt(%0)" :: "n"(N) : "memory"); __builtin_amdgcn_s_barrier(); } while (0)
    static_assert(PD == 3, "the DMA schedule below is written for PD = 3 (4-slot rings)");
    ATT_DMAK(0, 0); ATT_DMAK(1, 1); ATT_DMAV(0, 0); ATT_DMAK(2, 2); ATT_DMAV(1, 1); ATT_DMAK(3, 3); ATT_DMAV(2, 2);
    bf16x8 qr[4];
#pragma unroll
    for (int d0 = 0; d0 < 4; ++d0) qr[d0] = *(const bf16x8*)(Qp + d0 * 16);
    f32x16 o[4];
#pragma unroll
    for (int e = 0; e < 4; ++e) o[e] = (f32x16){};
    float mrun, lsum = 0.f;
    int kro4[4];
#pragma unroll
    for (int d0 = 0; d0 < 4; ++d0) kro4[d0] = cm * 8192 + r32 * 128 + (((2 * d0 + hi) ^ ((r32 >> 1) & 7)) * 16);
    const int vro = VR + ((lane >> 4) & 1) * 32 + (lane & 3) * 8 + (4 * hi + ((lane & 15) >> 2)) * 64;
#define ATT_QK(P0, P1, so) do { P0 = (f32x16){}; P1 = (f32x16){}; _Pragma("unroll") for (int d0 = 0; d0 < 4; ++d0) { \
        const bf16x8 k0_ = *(const LAS bf16x8*)(lds + (so) + kro4[d0]); const bf16x8 k1_ = *(const LAS bf16x8*)(lds + (so) + kro4[d0] + 4096); \
        P0 = __builtin_amdgcn_mfma_f32_32x32x16_bf16(k0_, qr[d0], P0, 0, 0, 0); P1 = __builtin_amdgcn_mfma_f32_32x32x16_bf16(k1_, qr[d0], P1, 0, 0, 0); } } while (0)
    f32x16 pA0, pA1, pB0, pB1;
    ATT_WAITBAR(12);
    ATT_QK(pA0, pA1, KR);
    { float a_ = -1e30f;
#pragma unroll
      for (int j = 0; j < 16; ++j) a_ = MX3(a_, pA0[j], pA1[j]);
      mrun = xmax(a_);
#pragma unroll
      for (int j = 0; j < 16; ++j) { pA0[j] = __builtin_amdgcn_exp2f(pA0[j] - mrun); pA1[j] = __builtin_amdgcn_exp2f(pA1[j] - mrun); } }
    asm volatile("s_waitcnt lgkmcnt(0)" ::: "memory"); __builtin_amdgcn_s_barrier();
    ATT_DMAK(4, 0);
    ATT_WAITBAR(8);
    bf16x8 kf[8];
#pragma unroll
    for (int d0 = 0; d0 < 4; ++d0) { kf[2 * d0] = *(const LAS bf16x8*)(lds + KR + 1 * KSL + kro4[d0]); kf[2 * d0 + 1] = *(const LAS bf16x8*)(lds + KR + 1 * KSL + kro4[d0] + 4096); }
    asm volatile("s_waitcnt lgkmcnt(0)" ::: "memory"); __builtin_amdgcn_s_barrier();
    int sl0 = 0, sl1 = 1;
#define SBAR() __builtin_amdgcn_sched_barrier(0)
#define VTR(ks, eb, half) __builtin_bit_cast(s16x4, __builtin_amdgcn_ds_read_tr16_b64_v4i16((LAS s16x4*)(lds + sl0 * VSL + vro + (eb) * 4096 + (ks) * 1024 + (half) * 512)))
#define ATT_STEP(P0, P1, N0, N1, t) do { \
        ATT_DMAK((t) + 5, sl1); ATT_DMAV((t) + 3, (sl0 == 0 ? NS - 1 : sl0 - 1)); \
        const int sl2_ = (sl1 == NS - 1) ? 0 : sl1 + 1; \
        s16x4 vl_[4][4], vh_[4][4]; \
        _Pragma("unroll") for (int eb = 0; eb < 4; ++eb) { vl_[0][eb] = VTR(0, eb, 0); vh_[0][eb] = VTR(0, eb, 1); } \
        SBAR(); \
        N0 = (f32x16){}; N1 = (f32x16){}; \
        float ls_ = 0.f; unsigned w0_[8], w1_[8]; \
        _Pragma("unroll") for (int i = 0; i < 8; ++i) { \
            if ((i & 1) == 0) N0 = __builtin_amdgcn_mfma_f32_32x32x16_bf16(kf[i], qr[i >> 1], N0, 0, 0, 0); \
            else              N1 = __builtin_amdgcn_mfma_f32_32x32x16_bf16(kf[i], qr[i >> 1], N1, 0, 0, 0); \
            ls_ += (P0[2 * i] + P0[2 * i + 1]) + (P1[2 * i] + P1[2 * i + 1]); \
            w0_[i] = cvt_pk_bf16(P0[2 * i], P0[2 * i + 1]); w1_[i] = cvt_pk_bf16(P1[2 * i], P1[2 * i + 1]); \
            SBAR(); } \
        lsum += ls_; \
        bf16x8 pa_[4]; \
        pa_[0] = __builtin_bit_cast(bf16x8, (u32x4){w0_[0], w0_[1], w0_[2], w0_[3]}); pa_[1] = __builtin_bit_cast(bf16x8, (u32x4){w0_[4], w0_[5], w0_[6], w0_[7]}); \
        pa_[2] = __builtin_bit_cast(bf16x8, (u32x4){w1_[0], w1_[1], w1_[2], w1_[3]}); pa_[3] = __builtin_bit_cast(bf16x8, (u32x4){w1_[4], w1_[5], w1_[6], w1_[7]}); \
        float al_ = 1.f; bool resc_ = false; float mxn_ = -1e30f; \
        _Pragma("unroll") for (int ks = 0; ks < 4; ++ks) { \
            _Pragma("unroll") for (int eb = 0; eb < 4; ++eb) { \
                const bf16x8 vf_ = (bf16x8){vl_[ks][eb][0], vl_[ks][eb][1], vl_[ks][eb][2], vl_[ks][eb][3], vh_[ks][eb][0], vh_[ks][eb][1], vh_[ks][eb][2], vh_[ks][eb][3]}; \
                o[eb] = __builtin_amdgcn_mfma_f32_32x32x16_bf16(vf_, pa_[ks], o[eb], 0, 0, 0); \
                if (ks < 3) { vl_[ks + 1][eb] = VTR(ks + 1, eb, 0); vh_[ks + 1][eb] = VTR(ks + 1, eb, 1); } \
                if (ks == 0) { _Pragma("unroll") for (int j = 0; j < 4; ++j) mxn_ = MX3(mxn_, N0[eb * 4 + j], N1[eb * 4 + j]); } \
                if (ks == 1 || ks == 3) { const int i_ = (ks >> 1) * 4 + eb; \
                    N0[2 * i_] = __builtin_amdgcn_exp2f(N0[2 * i_] - mrun); N0[2 * i_ + 1] = __builtin_amdgcn_exp2f(N0[2 * i_ + 1] - mrun); \
                    N1[2 * i_] = __builtin_amdgcn_exp2f(N1[2 * i_] - mrun); N1[2 * i_ + 1] = __builtin_amdgcn_exp2f(N1[2 * i_ + 1] - mrun); } \
                if (ks == 2) { kf[2 * eb] = *(const LAS bf16x8*)(lds + KR + sl2_ * KSL + kro4[eb]); kf[2 * eb + 1] = *(const LAS bf16x8*)(lds + KR + sl2_ * KSL + kro4[eb] + 4096); } \
                SBAR(); } \
            if (ks == 0) { mxn_ = xmax(mxn_); \
                if ((t) + 1 < NT && __any(mxn_ > mrun + THR)) { const float mn_ = fmaxf(mrun, mxn_); al_ = __builtin_amdgcn_exp2f(mrun - mn_); mrun = mn_; lsum *= al_; resc_ = true; } \
                SBAR(); } } \
        if (resc_) { _Pragma("unroll") for (int e = 0; e < 4; ++e) _Pragma("unroll") for (int i = 0; i < 16; ++i) o[e][i] *= al_; } \
        SBAR(); \
        asm volatile("s_waitcnt vmcnt(8) lgkmcnt(0)" ::: "memory"); __builtin_amdgcn_s_barrier(); \
        SBAR(); \
        sl0 = sl1; sl1 = sl2_; \
    } while (0)
    for (int t = 0; t < NT; t += 2) {
        ATT_STEP(pA0, pA1, pB0, pB1, t);
        ATT_STEP(pB0, pB1, pA0, pA1, t + 1);
    }
    asm volatile("s_waitcnt vmcnt(0)" ::: "memory"); __builtin_amdgcn_s_barrier();
#undef SBAR
#undef VTR
#undef ATT_STEP
#undef ATT_QK
#undef ATT_DMAK
#undef ATT_TILE
#undef GLDS16
#undef ATT_DMAV
#undef ATT_WAITBAR
    const float linv = 1.f / xsum(lsum);
    LAS float* xch = (LAS float*)(lds + XCH) + wq * 64 * 64 + lane;
    if (cm == 1) {
#pragma unroll
        for (int e = 0; e < 4; ++e)
#pragma unroll
            for (int i = 0; i < 16; ++i) xch[(e * 16 + i) * 64] = o[e][i] * linv;
    }
    __syncthreads();
    if (cm == 0) {
        const float lam = *(const LAS float*)(lds + LAMO);
        float ss = 0.f;
#pragma unroll
        for (int e = 0; e < 4; ++e)
#pragma unroll
            for (int i = 0; i < 16; ++i) { const float v = o[e][i] * linv - lam * xch[(e * 16 + i) * 64]; o[e][i] = v; ss += v * v; }
        ss = xsum(ss);
        const float rn = __builtin_amdgcn_rsqf(ss * (1.f / VD) + RMS_EPS);
        const LAS float* sg = (const LAS float*)(lds + SUBG);
        LAS unsigned char* stg = lds + OST + wq * (32 * 272);
#pragma unroll
        for (int e = 0; e < 4; ++e)
#pragma unroll
            for (int i4 = 0; i4 < 4; ++i4) { const int e0 = 32 * e + 8 * i4 + 4 * hi;
                const f32x4 g4 = *(const LAS f32x4*)(sg + e0);
                u32x2 w; w.x = cvt_pk_bf16(o[e][4 * i4] * rn * g4[0], o[e][4 * i4 + 1] * rn * g4[1]); w.y = cvt_pk_bf16(o[e][4 * i4 + 2] * rn * g4[2], o[e][4 * i4 + 3] * rn * g4[3]);
                *(LAS u32x2*)(stg + r32 * 272 + e0 * 2) = w; }
        asm volatile("s_waitcnt lgkmcnt(0)" ::: "memory");
        bf16_t* Ow = O + ((size_t)(b * SEQ + qb * 128 + wq * 32)) * D + h * VD;
#pragma unroll
        for (int it = 0; it < 8; ++it) { const int id = it * 64 + lane, row = id >> 4, ch = id & 15;
            const u32x4 v = *(const LAS u32x4*)(stg + row * 272 + ch * 16);
            *(u32x4*)(Ow + (size_t)row * D + ch * 8) = v; }
    }
    __syncthreads();
}
}

#define XB_TMO      128
#define XB_XCNT(j)  (256  + 64 * (j))
#define XB_XSUB(j)  (1280 + 64 * (j))
#define XB_XGEN(j)  (2304 + 64 * (j))
#define XB_TOP      3328
#define XB_TOPGEN   3392
#define XCD_BAR_WORDS 3456
#define XB_SPIN_CAP (1u << 20)
__device__ __forceinline__ unsigned xb_ld(unsigned* p)              { return __hip_atomic_load(p, __ATOMIC_RELAXED, __HIP_MEMORY_SCOPE_AGENT); }
__device__ __forceinline__ unsigned xb_add(unsigned* p, unsigned v) { return __hip_atomic_fetch_add(p, v, __ATOMIC_RELAXED, __HIP_MEMORY_SCOPE_AGENT); }
__device__ __forceinline__ unsigned xb_xcc_id() { return (unsigned)__builtin_amdgcn_s_getreg((3 << 11) | 20) & 0xFu; }
#define XB_SPIN(cond, bar) do { unsigned _sp = 0; while (cond) { __builtin_amdgcn_s_sleep(1); \
    if ((++_sp & 255u) == 0u) { if (xb_ld(&(bar)[XB_TMO])) break; if (_sp > XB_SPIN_CAP) { atomicAdd(&(bar)[XB_TMO], 1u); break; } } } } while (0)
__device__ __forceinline__ void xcd_barrier_complete(unsigned* bar, unsigned x, unsigned& nloc, unsigned& nx) {
    const unsigned G = gridDim.x;
    unsigned sum, cnt, mine, sp = 0u;
    for (;;) {
        sum = 0u; cnt = 0u; mine = 0u;
#pragma unroll
        for (unsigned j = 0; j < 16; ++j) { const unsigned c = xb_ld(&bar[XB_XCNT(j)]); sum += c; cnt += (c > 0u) ? 1u : 0u; mine = (j == x) ? c : mine; }
        if (sum == G) break;
        __builtin_amdgcn_s_sleep(1);
        if ((++sp & 255u) == 0u) { if (xb_ld(&bar[XB_TMO])) break; if (sp > XB_SPIN_CAP) { atomicAdd(&bar[XB_TMO], 1u); break; } }
    }
    nloc = mine > 0u ? mine : 1u; nx = cnt > 0u ? cnt : 1u;
}
__device__ __forceinline__ void xcd_barrier(unsigned* bar, volatile LAS unsigned* st) {
    asm volatile("s_waitcnt vmcnt(0)" ::: "memory");
    __syncthreads();
    if (threadIdx.x == 0) {
        const unsigned x = xb_xcc_id();
        __builtin_amdgcn_s_waitcnt(0);
        unsigned nloc = st[0], nx = st[1];
        if (nloc == 0u) { xcd_barrier_complete(bar, x, nloc, nx); st[0] = nloc; st[1] = nx; }
        const unsigned old = xb_add(&bar[XB_XSUB(x)], 1u);
        const unsigned gen = old / nloc;
        if (old + 1u == (gen + 1u) * nloc) {
            __builtin_amdgcn_fence(__ATOMIC_RELEASE, "agent");
            asm volatile("s_waitcnt vmcnt(0)" ::: "memory");
            const unsigned og = xb_add(&bar[XB_TOP], 1u);
            const unsigned tg = og / nx;
            if (og + 1u == (tg + 1u) * nx) xb_add(&bar[XB_TOPGEN], 1u);
            else XB_SPIN(xb_ld(&bar[XB_TOPGEN]) == tg, bar);
            __builtin_amdgcn_fence(__ATOMIC_ACQUIRE, "agent");
            xb_add(&bar[XB_XGEN(x)], 1u);
            asm volatile("s_waitcnt vmcnt(0)" ::: "memory");
        } else {
            XB_SPIN(xb_ld(&bar[XB_XGEN(x)]) == gen, bar);
            __builtin_amdgcn_fence(__ATOMIC_ACQUIRE, "agent");
            asm volatile("s_waitcnt vmcnt(0)" ::: "memory");
        }
    }
    __syncthreads();
}
constexpr int LDS_BARST = 140 * 1024;

#ifndef PH_MASK
#define PH_MASK 0xFFFFFFu
#endif
#ifndef REP_ATT
#define REP_ATT 1
#endif
#ifndef REP_GU
#define REP_GU 1
#endif
#ifndef REP_SYNC
#define REP_SYNC 0
#endif
#ifndef REP_ROW
#define REP_ROW 1
#endif
#ifndef REP_P0
#define REP_P0 1
#endif
#define PH(k) if constexpr ((PH_MASK >> (k)) & 1u)
struct Args {
    const float *x, *c, *ctx, *c_ctx, *mod_w, *mod_b, *norm_g, *w_gu, *w_dn, *w_qkv, *w_o, *lam, *subg, *w_in, *w_out;
    float* out; unsigned char* ws;
};

__device__ __forceinline__ void transpose_item(const float* W, int K, int Nsrc, int Ndst, bf16_t* WT, int mode, LAS float* scr, int item, int lane) {
    const int nblk = Ndst / 32, kb = item / nblk, nb = item % nblk, k0 = 64 * kb, n0 = 32 * nb, i = lane & 31;
    int src;
    if (mode == 1 && n0 < 4096) src = n0 + ((i >> 2) & 1) * 16 + ((i >> 3) & 3) * 4 + (i & 3);
    else if (mode == 2) { const int tile = n0 >> 8, r0 = n0 & 255; src = (r0 < 128 ? tile * 128 + r0 : FF + tile * 128 + r0 - 128) + i; }
    else src = n0 + i;
#pragma unroll 8
    for (int q = 0; q < 32; ++q) { const int kk = 2 * q + (lane >> 5); scr[kk * 33 + i] = W[(size_t)(k0 + kk) * Nsrc + src]; }
    asm volatile("s_waitcnt lgkmcnt(0)" ::: "memory");
    const int c = lane & 7;
#pragma unroll
    for (int j = 0; j < 4; ++j) { const int n = (lane >> 3) + 8 * j; const LAS float* s = scr + (8 * c) * 33 + n;
        u32x4 o; o.x = cvt_pk_bf16(s[0 * 33], s[1 * 33]); o.y = cvt_pk_bf16(s[2 * 33], s[3 * 33]); o.z = cvt_pk_bf16(s[4 * 33], s[5 * 33]); o.w = cvt_pk_bf16(s[6 * 33], s[7 * 33]);
        *(u32x4*)(WT + (size_t)(n0 + n) * K + k0 + 8 * c) = o; }
    asm volatile("s_waitcnt lgkmcnt(0)" ::: "memory");
}

__device__ __forceinline__ void row_op(int lane, const bf16_t* y, const float* xin, const float* gate, const float* gy, float* xout,
                                       const float* gh, const float* sh, const float* sc, bf16_t* hb) {
    asm volatile("" : "+v"(lane));
    f32x4 v[8];
#pragma unroll
    for (int j = 0; j < 8; ++j) v[j] = *(const f32x4*)(xin + j * 256 + lane * 4);
    if (y) {
        u32x2 yw[8]; float ss = 0.f;
#pragma unroll
        for (int j = 0; j < 8; ++j) { yw[j] = *(const u32x2*)(y + j * 256 + lane * 4);
            const float a = bflo(yw[j].x), b = bfhi(yw[j].x), c = bflo(yw[j].y), d = bfhi(yw[j].y); ss += (a * a + b * b) + (c * c + d * d); }
        const float ry = __builtin_amdgcn_rsqf(wave_sum(ss) * (1.f / D) + RMS_EPS);
#pragma unroll
        for (int j = 0; j < 8; ++j) { const f32x4 g4 = *(const f32x4*)(gate + j * 256 + lane * 4), w4 = *(const f32x4*)(gy + j * 256 + lane * 4);
            const f32x4 yv = {bflo(yw[j].x), bfhi(yw[j].x), bflo(yw[j].y), bfhi(yw[j].y)};
            v[j] = v[j] + g4 * (yv * ry * w4); }
#pragma unroll
        for (int j = 0; j < 8; ++j) *(f32x4*)(xout + j * 256 + lane * 4) = v[j];
    }
    if (hb) {
        float ss = 0.f;
#pragma unroll
        for (int j = 0; j < 8; ++j) ss += (v[j].x * v[j].x + v[j].y * v[j].y) + (v[j].z * v[j].z + v[j].w * v[j].w);
        const float r = __builtin_amdgcn_rsqf(wave_sum(ss) * (1.f / D) + RMS_EPS);
#pragma unroll
        for (int j = 0; j < 8; ++j) { const f32x4 g4 = *(const f32x4*)(gh + j * 256 + lane * 4), s4 = *(const f32x4*)(sh + j * 256 + lane * 4), c4 = *(const f32x4*)(sc + j * 256 + lane * 4);
            const f32x4 hv = v[j] * r * g4 * (c4 + 1.f) + s4;
            u32x2 w; w.x = cvt_pk_bf16(hv.x, hv.y); w.y = cvt_pk_bf16(hv.z, hv.w);
            *(u32x2*)(hb + j * 256 + lane * 4) = w; }
    }
}

template <bool HAS_Y, bool HAS_H, bool XIN_BF = false, bool XOUT_BF = false>
__device__ __forceinline__ void row_phase(int lane, int gw, int NGW, const bf16_t* Y, const void* Xin_, void* Xout_, const float* ada_layer, int cg, const float* gy,
                                          const float* gh, int csh, int csc, bf16_t* Hout, bool perm, const float* ada_mod = nullptr) {
    const float* Xin = (const float*)Xin_; float* Xout = (float*)Xout_; const bf16_t* XinB = (const bf16_t*)Xin_; bf16_t* XoutB = (bf16_t*)Xout_;
    asm volatile("" : "+v"(lane));
    const int b = gw & 3;
    const float* ad = ada_layer + (size_t)b * 6 * D;
    const float* adm = (ada_mod ? ada_mod : ada_layer) + (size_t)b * 6 * D;
    f32x4 pa[8], pb[8], pc[8];
#pragma unroll
    for (int j = 0; j < 8; ++j) { const int c = j * 256 + lane * 4;
        if (HAS_Y) pa[j] = *(const f32x4*)(ad + cg * D + c) * *(const f32x4*)(gy + c);
        if (HAS_H) { pb[j] = *(const f32x4*)(gh + c) * (*(const f32x4*)(adm + csc * D + c) + 1.f); pc[j] = *(const f32x4*)(adm + csh * D + c); } }
    for (int idx = gw; idx < M; idx += NGW) {
        const int t = idx >> 2; const size_t row = (size_t)b * SEQ + t;
        f32x4 v[8];
        if (XIN_BF) {
#pragma unroll
            for (int j = 0; j < 8; ++j) { const u32x2 xw = *(const u32x2*)(XinB + row * D + j * 256 + lane * 4); v[j] = (f32x4){bflo(xw.x), bfhi(xw.x), bflo(xw.y), bfhi(xw.y)}; }
        } else {
#pragma unroll
            for (int j = 0; j < 8; ++j) v[j] = *(const f32x4*)(Xin + row * D + j * 256 + lane * 4);
        }
        if (HAS_Y) {
            u32x2 yw[8]; float ss = 0.f;
#pragma unroll
            for (int j = 0; j < 8; ++j) { yw[j] = *(const u32x2*)(Y + row * D + j * 256 + lane * 4);
                const float a0 = bflo(yw[j].x), a1 = bfhi(yw[j].x), a2 = bflo(yw[j].y), a3 = bfhi(yw[j].y); ss += (a0 * a0 + a1 * a1) + (a2 * a2 + a3 * a3); }
            const float ry = __builtin_amdgcn_rsqf(wave_sum(ss) * (1.f / D) + RMS_EPS);
#pragma unroll
            for (int j = 0; j < 8; ++j) { const f32x4 yv = {bflo(yw[j].x), bfhi(yw[j].x), bflo(yw[j].y), bfhi(yw[j].y)};
                v[j] = v[j] + pa[j] * (yv * ry);
                if (XOUT_BF) { u32x2 w; w.x = cvt_pk_bf16(v[j].x, v[j].y); w.y = cvt_pk_bf16(v[j].z, v[j].w); *(u32x2*)(XoutB + row * D + j * 256 + lane * 4) = w;
                    v[j] = (f32x4){bflo(w.x), bfhi(w.x), bflo(w.y), bfhi(w.y)}; }
                else *(f32x4*)(Xout + row * D + j * 256 + lane * 4) = v[j]; }
        }
        if (HAS_H) {
            float ss = 0.f;
#pragma unroll
            for (int j = 0; j < 8; ++j) ss += (v[j].x * v[j].x + v[j].y * v[j].y) + (v[j].z * v[j].z + v[j].w * v[j].w);
            const float r = __builtin_amdgcn_rsqf(wave_sum(ss) * (1.f / D) + RMS_EPS);
            const size_t hrow = perm ? (size_t)b * SEQ + (t & 63) * 64 + (t >> 6) : row;
#pragma unroll
            for (int j = 0; j < 8; ++j) { const f32x4 hv = v[j] * r * pb[j] + pc[j];
                u32x2 w; w.x = cvt_pk_bf16(hv.x, hv.y); w.y = cvt_pk_bf16(hv.z, hv.w);
                *(u32x2*)(Hout + hrow * D + j * 256 + lane * 4) = w; }
        }
    }
}

__global__ void __launch_bounds__(512, 2) fwd_megakernel(Args a) {
    extern __shared__ __attribute__((aligned(16))) unsigned char lds_raw[];
    LAS unsigned char* lds = (LAS unsigned char*)lds_raw;
    cg::grid_group grid = cg::this_grid();
    const int tid = threadIdx.x, lane = tid & 63, wave = __builtin_amdgcn_readfirstlane(tid >> 6);
    const int G = gridDim.x, bx = blockIdx.x;
    const int gw = bx * 8 + wave, NGW = G * 8;
    if (tid < 2) ((LAS unsigned*)(lds + LDS_BARST))[tid] = 0u;
    if (tid == 0) (void)xb_add(&((unsigned*)a.ws)[XB_XCNT(xb_xcc_id())], 1u);
    __syncthreads();
#define GRID_BAR() xcd_barrier((unsigned*)WSB, (volatile LAS unsigned*)(lds + LDS_BARST))
#define WSB ({ unsigned char* _w = a.ws; asm volatile("" : "+s"(_w)); _w; })
#define ADA ((float*)(WSB + WS_ADA))
#define ROPE ((float*)(WSB + WS_ROPE))
#define D1T ((bf16_t*)(WSB + WS_D1))
#define D2T ((bf16_t*)(WSB + WS_D2))
#define CS2 ((bf16_t*)(WSB + WS_CS2))
#define TWT ((f32x2*)(WSB + WS_TW))
#define Wqkv ((bf16_t*)(WSB + WS_WQKV))
#define Wo ((bf16_t*)(WSB + WS_WO))
#define Win ((bf16_t*)(WSB + WS_WIN))
#define Wout ((bf16_t*)(WSB + WS_WOUT))
#define Wgu ((bf16_t*)(WSB + WS_WGU))
#define Wdn ((bf16_t*)(WSB + WS_WDN))
#define HB ((bf16_t*)(WSB + WS_HB))
#define YB ((bf16_t*)(WSB + WS_YB))
#define Qb ((bf16_t*)(WSB + WS_Q))
#define Kb ((bf16_t*)(WSB + WS_K))
#define Vb ((bf16_t*)(WSB + WS_V))
#define Ob ((bf16_t*)(WSB + WS_O))
#define HID ((bf16_t*)(WSB + WS_HID))
#define Ub ((bf16_t*)(WSB + WS_U))
#define A2b ((bf16_t*)(WSB + WS_A2))
#define Xb ((bf16_t*)(WSB + WS_X))
#define Fb ((bf16_t*)(WSB + WS_F))
#define XR ((bf16_t*)(WSB + WS_XR))

    for (int rep0 = 0; rep0 < REP_P0; ++rep0) {
        LAS float* sl = (LAS float*)(lds + 69632);
        LAS float* red = (LAS float*)lds;
        if (bx < 192) {
            for (int i = tid; i < 5 * D; i += 512) { const float cv = (i < 4 * D) ? a.c[i] : a.c_ctx[i - 4 * D]; sl[i] = silu_f(cv); }
            __syncthreads();
            for (int it = bx; it < 192; it += G) {
                const int layer = it / 96, n0 = (it % 96) * 128;
                const float* wp = a.mod_w + (size_t)layer * D * 6 * D + (size_t)(wave * 256) * 6 * D + n0 + lane * 2;
                float ac[5][2];
#pragma unroll
                for (int r = 0; r < 5; ++r) { ac[r][0] = 0.f; ac[r][1] = 0.f; }
#pragma unroll 8
                for (int k = 0; k < 256; ++k) { const f32x2 w = *(const f32x2*)(wp + (size_t)k * 6 * D);
#pragma unroll
                    for (int r = 0; r < 5; ++r) { const float s = sl[r * D + wave * 256 + k]; ac[r][0] += s * w.x; ac[r][1] += s * w.y; } }
#pragma unroll
                for (int r = 0; r < 5; ++r) { red[(wave * 5 + r) * 128 + lane * 2] = ac[r][0]; red[(wave * 5 + r) * 128 + lane * 2 + 1] = ac[r][1]; }
                __syncthreads();
                for (int i = tid; i < 5 * 128; i += 512) { const int r = i >> 7, cc = i & 127; float s = a.mod_b[layer * 6 * D + n0 + cc];
#pragma unroll
                    for (int w = 0; w < 8; ++w) s += red[(w * 5 + r) * 128 + cc];
                    ADA[(size_t)(layer * 5 + r) * 6 * D + n0 + cc] = s; }
                __syncthreads();
            }
        }
        __syncthreads();
        LAS float* scr = (LAS float*)(lds + wave * 8704);
        constexpr int I_QKV = 32 * 192, I_SQ = 32 * 64, I_GU = 32 * 352, I_DN = 88 * 64;
        constexpr int NITEMS = I_QKV + 3 * I_SQ + 2 * I_GU + 2 * I_DN;
        for (int it = gw; it < NITEMS; it += NGW) {
            int r = it;
            if (r < I_QKV) { transpose_item(a.w_qkv, D, NQKV, NQKV, Wqkv, 1, scr, r, lane); continue; } r -= I_QKV;
            if (r < I_SQ) { transpose_item(a.w_o, D, D, D, Wo, 0, scr, r, lane); continue; } r -= I_SQ;
            if (r < I_SQ) { transpose_item(a.w_in, D, D, D, Win, 0, scr, r, lane); continue; } r -= I_SQ;
            if (r < I_SQ) { transpose_item(a.w_out, D, D, D, Wout, 0, scr, r, lane); continue; } r -= I_SQ;
            if (r < 2 * I_GU) { const int l = r / I_GU; transpose_item(a.w_gu + (size_t)l * D * NGU, D, NGU, NGU, Wgu + (size_t)l * NGU * D, 2, scr, r % I_GU, lane); continue; } r -= 2 * I_GU;
            { const int l = r / I_DN; transpose_item(a.w_dn + (size_t)l * FF * D, FF, D, D, Wdn + (size_t)l * D * FF, 0, scr, r % I_DN, lane); }
        }
        const int gt = bx * 512 + tid, NGT = G * 512;
        if (gt < 1024) { const int pos = gt >> 4, f = gt & 15; const float inv = powf(10000.f, -(float)f / 16.f); const float ang = (float)pos * inv;
            ROPE[gt] = cosf(ang); ROPE[1024 + gt] = sinf(ang); }
        for (int i = gt; i < 256 * 128; i += NGT) { const int m = i >> 7, k = i & 127, part = m >> 7, rp = (m >> 6) & 1, k1 = m & 63, rp2 = k >> 6, aa = k & 63;
            float sv, cv; sincospif((float)((k1 * aa) & 63) * (1.f / 32.f), &sv, &cv); const float v = (rp == rp2) ? (part ? -sv : cv) * 0.125f : 0.f;
            D1T[i] = (bf16_t)(cvt_pk_bf16(v, v) & 0xffffu); }
        for (int i = gt; i < 256 * 256; i += NGT) { const int m = i >> 8, k = i & 255, kp = m >> 7, po = (m >> 6) & 1, k2 = m & 63, kp2 = k >> 7, part = (k >> 6) & 1, rp = (k >> 5) & 1, r = 2 * (k & 31) + rp;
            float sv, cv; sincospif((float)((k2 * r) & 63) * (1.f / 32.f), &sv, &cv);
            const float v = (kp == kp2) ? (po == 0 ? (part == 0 ? cv : sv) : (part == 0 ? -sv : cv)) * 0.125f : 0.f;
            D2T[i] = (bf16_t)(cvt_pk_bf16(v, v) & 0xffffu); }
        for (int i = gt; i < 256 * 512; i += NGT) { const int kc = i >> 9, k = i & 511, part = k >> 8, cc = k & 255;
            float sv, cv; sincospif((float)((kc * cc) & 255) * (1.f / 128.f), &sv, &cv); const float v = (part ? sv : cv) * (1.f / 16.f);
            CS2[i] = (bf16_t)(cvt_pk_bf16(v, v) & 0xffffu); }
        for (int i = gt; i < 4096; i += NGT) { float sv, cv; sincospif((float)i * (1.f / 2048.f), &sv, &cv); TWT[i] = (f32x2){cv, sv}; }
    }
    grid.sync();

    for (int rs = 0; rs < REP_SYNC; ++rs) GRID_BAR();
    row_phase<false, true>(lane, gw, NGW, nullptr, a.x, nullptr, ADA, 0, nullptr, a.norm_g, 0, 1, HB, false);
    for (int row = M + gw; row < MT; row += NGW) { const float* ad = ADA + (size_t)4 * 6 * D;
        row_op(lane, nullptr, a.ctx + (size_t)(row - M) * D, nullptr, nullptr, nullptr, a.norm_g, ad, ad + D, HB + (size_t)row * D); }
    GRID_BAR();

    PH(0) { pg8::Gemm g{HB, Wqkv, D, D, D}; pg8::SchedQKV S{G, bx}; pg8::EpiQKV E{Qb, Kb, Vb, ROPE};
      pg8::gemm_phase(lds, g, S, E); }
    GRID_BAR();

    {
        if (tid < 128) ((LAS float*)(lds + att::SUBG))[tid] = a.subg[tid] * 0.8f;
        if (wave == 0) { const float p01 = wave_sum(a.lam[lane] * a.lam[64 + lane]), p23 = wave_sum(a.lam[128 + lane] * a.lam[192 + lane]);
            if (lane == 0) *(LAS float*)(lds + att::LAMO) = expf(p01) - expf(p23) + 0.2f; }
        __syncthreads();
        for (int rep = 0; rep < REP_ATT; ++rep)
        if (G == 256) { for (int i = 0; i < 8; ++i) { const int bh = (bx & 7) * 8 + i, qb = bx >> 3; att::attn_unit(bh >> 4, bh & 15, qb, Qb, Kb, Vb, Ob, lds); } }
        else { for (int u = bx; u < 2048; u += G) { const int bh = u >> 5, qb = u & 31; att::attn_unit(bh >> 4, bh & 15, qb, Qb, Kb, Vb, Ob, lds); } }
    }
    GRID_BAR();

    PH(1) { pg8::Gemm g{Ob, Wo, D, D, D}; pg8::SchedStd S{64, 8, G, bx, D, D, D}; pg8::EpiPlain E{YB, D}; pg8::gemm_phase(lds, g, S, E); }
    GRID_BAR();

    row_phase<true, true, false, true>(lane, gw, NGW, YB, a.x, XR, ADA, 2, a.norm_g + D, a.norm_g + 2 * D, 3, 4, HB, false);
    GRID_BAR();

    for (int repg = 0; repg < REP_GU; ++repg)
    PH(2) { pg8::Gemm g{HB, Wgu, D, D, D}; pg8::SchedStd S{64, 44, G, bx, D, D, 0}; pg8::EpiSwiGLU E{HID}; pg8::gemm_phase(lds, g, S, E); }
    GRID_BAR();
    PH(3) { pg8::Gemm g{HID, Wdn, FF, FF, FF}; pg8::SchedStd S{64, 8, G, bx, FF, FF, D}; pg8::EpiPlain E{YB, D}; pg8::gemm_phase(lds, g, S, E); }
    GRID_BAR();

    row_phase<true, true, true, true>(lane, gw, NGW, YB, XR, XR, ADA, 5, a.norm_g + 3 * D, a.norm_g + 4 * D, 0, 1, HB, true, ADA + (size_t)5 * 6 * D);
    GRID_BAR();

    PH(4) { pg8::Gemm g{Win, HB, D, D, D}; pg8::SchedInT S{G, bx}; pg8::EpiPlain E{Ub, SEQ}; pg8::gemm_phase(lds, g, S, E); }
    GRID_BAR();
    PH(5) { pg8::Gemm g{D1T, Ub, 128, 128, 128}; pg8::SchedCols S{G, bx, 1024, 128}; pg8::EpiFft1 E{A2b, TWT}; pg8::gemm_phase(lds, g, S, E); }
    GRID_BAR();
    PH(6) { pg8::Gemm g{D2T, A2b, 256, 256, 256}; pg8::SchedCols S{G, bx, 1024, 256}; pg8::EpiFft2 E{Xb}; pg8::gemm_phase(lds, g, S, E); }
    GRID_BAR();
    PH(10) { pg8::Gemm g{Xb, CS2, 4096, 512, 512}; pg8::SchedChan S{G, bx}; pg8::EpiPlain E{Fb, D}; pg8::gemm_phase(lds, g, S, E); }
    GRID_BAR();
    PH(7) { pg8::Gemm g{Fb, Wout, D, D, D}; pg8::SchedStd S{64, 8, G, bx, D, D, D}; pg8::EpiPlain E{YB, D}; pg8::gemm_phase(lds, g, S, E); }
    GRID_BAR();

    row_phase<true, true, true, true>(lane, gw, NGW, YB, XR, XR, ADA + (size_t)5 * 6 * D, 2, a.norm_g + 5 * D, a.norm_g + 6 * D, 3, 4, HB, false);
    GRID_BAR();

    PH(8) { pg8::Gemm g{HB, Wgu + (size_t)NGU * D, D, D, D}; pg8::SchedStd S{64, 44, G, bx, D, D, 0}; pg8::EpiSwiGLU E{HID}; pg8::gemm_phase(lds, g, S, E); }
    GRID_BAR();
    PH(9) { pg8::Gemm g{HID, Wdn + (size_t)D * FF, FF, FF, FF}; pg8::SchedStd S{64, 8, G, bx, FF, FF, D}; pg8::EpiPlain E{YB, D}; pg8::gemm_phase(lds, g, S, E); }
    GRID_BAR();

    row_phase<true, false, true, false>(lane, gw, NGW, YB, XR, a.out, ADA + (size_t)5 * 6 * D, 5, a.norm_g + 7 * D, nullptr, 0, 0, nullptr, false);
}

extern "C" void kernel_launch(void* const* d_in, const int* in_sizes, int n_in, void* d_out, int out_size, void* d_ws, size_t ws_size, hipStream_t stream) {
    static int grid = 0;
    if (grid == 0) {
        if (n_in != 15 || in_sizes[0] != M * D || out_size != M * D || ws_size < WS_END) {
            fprintf(stderr, "kernel_launch: unexpected shapes / workspace (n_in %d, in0 %d, out %d, ws %zu, need %zu)\n", n_in, n_in > 0 ? in_sizes[0] : -1, out_size, ws_size, (size_t)WS_END);
            grid = -1; return; }
        int dev = 0, cus = 0, per_cu = 0;
        hipGetDevice(&dev);
        hipDeviceGetAttribute(&cus, hipDeviceAttributeMultiprocessorCount, dev);
        if (hipFuncSetAttribute((const void*)fwd_megakernel, hipFuncAttributeMaxDynamicSharedMemorySize, LDS_BYTES) != hipSuccess) { fprintf(stderr, "kernel_launch: hipFuncSetAttribute failed\n"); grid = -1; return; }
        hipOccupancyMaxActiveBlocksPerMultiprocessor(&per_cu, (const void*)fwd_megakernel, 512, LDS_BYTES);
        if (per_cu < 1) { fprintf(stderr, "kernel_launch: occupancy query says %d blocks per CU\n", per_cu); per_cu = 1; }
        (void)hipGetLastError();
        grid = cus * 1;
    }
    if (grid < 0) return;
    if (hipMemsetAsync(d_ws, 0, 16384, stream) != hipSuccess) { fprintf(stderr, "kernel_launch: hipMemsetAsync of the barrier words failed\n"); return; }
    Args a{};
    a.x = (const float*)d_in[0]; a.c = (const float*)d_in[1]; a.ctx = (const float*)d_in[2]; a.c_ctx = (const float*)d_in[3];
    a.mod_w = (const float*)d_in[4]; a.mod_b = (const float*)d_in[5]; a.norm_g = (const float*)d_in[6]; a.w_gu = (const float*)d_in[7]; a.w_dn = (const float*)d_in[8];
    a.w_qkv = (const float*)d_in[9]; a.w_o = (const float*)d_in[10]; a.lam = (const float*)d_in[11]; a.subg = (const float*)d_in[12]; a.w_in = (const float*)d_in[13]; a.w_out = (const float*)d_in[14];
    a.out = (float*)d_out; a.ws = (unsigned char*)d_ws;
    void* args[] = {&a};
    hipError_t e = hipLaunchCooperativeKernel((const void*)fwd_megakernel, dim3(grid), dim3(512), args, LDS_BYTES, stream);
    if (e != hipSuccess) fprintf(stderr, "cooperative launch failed: %s (grid %d)\n", hipGetErrorString(e), grid);
}
```

```cpp
#include <hip/hip_runtime.h>
#include <hip/hip_cooperative_groups.h>
#include <cstdio>
#include <cstdint>
namespace cg = cooperative_groups;

#define LAS __attribute__((address_space(3)))
typedef unsigned short bf16_t;
typedef short bf16x8 __attribute__((ext_vector_type(8)));
typedef short s16x4 __attribute__((ext_vector_type(4)));
typedef float f32x4 __attribute__((ext_vector_type(4)));
typedef float f32x2 __attribute__((ext_vector_type(2)));
typedef float f32x16 __attribute__((ext_vector_type(16)));
typedef unsigned u32x4 __attribute__((ext_vector_type(4)));
typedef unsigned u32x2 __attribute__((ext_vector_type(2)));

constexpr int D = 2048, NB = 4, SEQ = 4096, M = NB * SEQ, LC = 256, MC = NB * LC, MT = M + MC;
constexpr int NH = 16, HD = 64, VD = 128, NQKV = 6144, FF = 5632, NGU = 2 * FF, SK = SEQ + LC;
constexpr float RMS_EPS = 1e-6f;
constexpr float QSCALE = 0.125f * 1.4426950408889634f;

constexpr size_t MiB = 1u << 20;
constexpr size_t WS_ADA = 1 * MiB;
constexpr size_t WS_ROPE = 1 * MiB + 768 * 1024;
constexpr size_t WS_D1 = 2 * MiB;
constexpr size_t WS_D2 = 2 * MiB + 64 * 1024;
constexpr size_t WS_CS2 = 2 * MiB + 192 * 1024;
constexpr size_t WS_TW = 2 * MiB + 448 * 1024;
constexpr size_t WS_WQKV = 3 * MiB;
constexpr size_t WS_WO = 27 * MiB;
constexpr size_t WS_WIN = 35 * MiB;
constexpr size_t WS_WOUT = 43 * MiB;
constexpr size_t WS_WGU = 51 * MiB;
constexpr size_t WS_WDN = 139 * MiB;
constexpr size_t WS_HB = 183 * MiB;
constexpr size_t WS_YB = 251 * MiB;
constexpr size_t WS_R = 315 * MiB;
constexpr size_t WS_Q = WS_R;
constexpr size_t WS_K = WS_R + 64 * MiB;
constexpr size_t WS_V = WS_R + 132 * MiB;
constexpr size_t WS_O = WS_R + 200 * MiB;
constexpr size_t WS_HID = WS_R;
constexpr size_t WS_U = WS_R + 200 * MiB;
constexpr size_t WS_A2 = WS_R;
constexpr size_t WS_X = WS_R + 128 * MiB;
constexpr size_t WS_F = WS_R;
constexpr size_t WS_XR = WS_R + 264 * MiB;
constexpr size_t WS_END = WS_R + 328 * MiB;

constexpr int LDS_BYTES = 147456;

typedef __bf16 bf16x2_t __attribute__((ext_vector_type(2)));
__device__ __forceinline__ unsigned cvt_pk_bf16(float lo, float hi) { const f32x2 v = {lo, hi}; const bf16x2_t b = __builtin_convertvector(v, bf16x2_t); return __builtin_bit_cast(unsigned, b); }
__device__ __forceinline__ float bf2f(unsigned short b) { return __uint_as_float(((unsigned)b) << 16); }
__device__ __forceinline__ float bflo(unsigned w) { return __uint_as_float(w << 16); }
__device__ __forceinline__ float bfhi(unsigned w) { return __uint_as_float(w & 0xffff0000u); }
__device__ __forceinline__ float wave_sum(float v) {
#pragma unroll
    for (int o = 1; o < 64; o <<= 1) v += __shfl_xor(v, o);
    return v;
}
__device__ __forceinline__ float silu_f(float v) { return v / (1.f + __expf(-v)); }

namespace pg8 {
constexpr int BM = 256, BK = 64, HALF = 128, HTB = HALF * BK * 2, NXCD = 8, WGM = 8;
__host__ __device__ __forceinline__ int lds_byte(int r, int c) { const int st = (r >> 4) * 2 + (c >> 5), rr = r & 15, cc = c & 31, ob = rr * 64 + cc * 2; return st * 1024 + (ob ^ (((ob >> 9) & 1) << 5)); }
__host__ __device__ __forceinline__ void stage_rc(int b, int& R, int& C) { const int st = b / 1024, sb = b % 1024, swz = sb ^ (((sb >> 9) & 1) << 5); R = (st >> 1) * 16 + swz / 64; C = (st & 1) * 32 + (swz % 64) / 2; }
__host__ __device__ __forceinline__ int perm32(int rho) { const int n = rho >> 4, i = rho & 15; return 8 * (i >> 2) + 4 * n + (i & 3); }

struct Unit { int pm, pn; size_t aoff, boff, coff; };
struct Gemm { const bf16_t* A; const bf16_t* Bt; int lda, ldb, K; };

__device__ __forceinline__ void swz_order(int L, int nM, int nN, int& pm, int& pn) {
    const int nwg = nM * nN; int wgid = L;
    { const int q = nwg / NXCD, r = nwg % NXCD, xcd = wgid % NXCD, off = wgid / NXCD; wgid = (xcd < r ? xcd * (q + 1) : r * (q + 1) + (xcd - r) * q) + off; }
    const int nig = WGM * nN, gid = wgid / nig, fm = gid * WGM, gsz = (nM - fm) < WGM ? (nM - fm) : WGM;
    pm = fm + ((wgid % nig) % gsz); pn = (wgid % nig) / gsz;
}

template <class Epi, class Sched>
__device__ __forceinline__ void gemm_phase(LAS unsigned char* lds, const Gemm g, const Sched& S, const Epi& E) {
    int tid = threadIdx.x; asm volatile("" : "+v"(tid));
    const int wid = __builtin_amdgcn_readfirstlane(tid >> 6), lane = tid & 63, wr = wid >> 2, wc = wid & 3, fr = lane & 15, fq = lane >> 4;
    int nt = g.K / BK; asm volatile("" : "+s"(nt));
    unsigned voffA[2], voffB[2];
#pragma unroll
    for (int i = 0; i < 2; ++i) { int R, C; stage_rc(tid * 16 + i * 8192, R, C); const int Rb = (R & ~31) + perm32(R & 31);
        voffA[i] = (unsigned)(R * g.lda + C) * 2u; voffB[i] = (unsigned)(Rb * g.ldb + C) * 2u; }
    const size_t kstep = (size_t)(BK * 2);
    const size_t hstepA = (size_t)HALF * g.lda * 2, hstepB = (size_t)HALF * g.ldb * 2;
    const unsigned ldsw = (unsigned)wid * 1024u;
    const int aoff = lds_byte(wr * 64 + fr, fq * 8), boff = lds_byte(wc * 32 + fr, fq * 8);
#define PG8_SA(b, h) (((b) * 2 + (h)) * HTB)
#define PG8_SB(b, h) ((4 + (b) * 2 + (h)) * HTB)
#define PG8_STAGE(bufoff, gbase, voff) do { _Pragma("unroll") for (int _i = 0; _i < 2; ++_i) \
        __builtin_amdgcn_global_load_lds((const unsigned*)((const char*)(gbase) + (voff)[_i]), (LAS unsigned*)(lds + (bufoff) + ldsw + _i * 8192), 16, 0, 0); } while (0)
#define PG8_LDA(dst, b, h) do { _Pragma("unroll") for (int m = 0; m < 4; ++m) _Pragma("unroll") for (int k = 0; k < 2; ++k) dst[m][k] = *(const LAS bf16x8*)(lds + PG8_SA(b, h) + aoff + m * 2048 + k * 1024); } while (0)
#define PG8_LDB(dst, b, h) do { _Pragma("unroll") for (int n = 0; n < 2; ++n) _Pragma("unroll") for (int k = 0; k < 2; ++k) dst[n][k] = *(const LAS bf16x8*)(lds + PG8_SB(b, h) + boff + n * 2048 + k * 1024); } while (0)
#define PG8_MMA(ai, bj, At, Bt) do { __builtin_amdgcn_s_setprio(1); _Pragma("unroll") for (int m = 0; m < 4; ++m) _Pragma("unroll") for (int n = 0; n < 2; ++n) _Pragma("unroll") for (int k = 0; k < 2; ++k) \
        acc[ai][bj][m][n] = __builtin_amdgcn_mfma_f32_16x16x32_bf16(Bt[n][k], At[m][k], acc[ai][bj][m][n], 0, 0, 0); __builtin_amdgcn_s_setprio(0); } while (0)
#define PG8_WAIT_V(n) asm volatile("s_waitcnt vmcnt(" #n ")" ::: "memory")
#define PG8_WAIT_L(n) asm volatile("s_waitcnt lgkmcnt(" #n ")" ::: "memory")
#define PG8_BAR __builtin_amdgcn_s_barrier()
#define PG8_SCHED __builtin_amdgcn_sched_barrier(0)
    Unit cur, nxt; int ui = 0;
    if (!S.next(0, cur)) return;
    f32x4 acc[2][2][4][2];
#pragma unroll
    for (int a = 0; a < 2; ++a)
#pragma unroll
        for (int b = 0; b < 2; ++b)
#pragma unroll
            for (int m = 0; m < 4; ++m)
#pragma unroll
                for (int n = 0; n < 2; ++n) acc[a][b][m][n] = (f32x4){0.f, 0.f, 0.f, 0.f};
    bf16x8 At[4][2], B0[2][2], B1[2][2];
    const char* cA = (const char*)g.A + cur.aoff; const char* cB = (const char*)g.Bt + cur.boff;
    PG8_STAGE(PG8_SB(0, 0), cB, voffB); PG8_STAGE(PG8_SB(0, 1), cB + hstepB, voffB); PG8_STAGE(PG8_SA(0, 0), cA, voffA); PG8_STAGE(PG8_SA(0, 1), cA + hstepA, voffA);
    if (wr == 1) PG8_BAR;
    PG8_WAIT_V(2); PG8_BAR;
    PG8_STAGE(PG8_SB(1, 0), cB + kstep, voffB); PG8_STAGE(PG8_SA(1, 0), cA + kstep, voffA); PG8_STAGE(PG8_SB(1, 1), cB + hstepB + kstep, voffB);
    PG8_WAIT_V(6); PG8_BAR;
    for (;;) {
        const bool has_next = S.next(ui + 1, nxt);
        const char* nA = has_next ? (const char*)g.A + nxt.aoff : cA; const char* nB = has_next ? (const char*)g.Bt + nxt.boff : cB;
        for (int t = 0; t < nt; t += 2) {
            const bool last = (t == nt - 2);
            const char* a1 = cA + (size_t)(t + 1) * kstep;
            const char* a2 = last ? nA : cA + (size_t)(t + 2) * kstep; const char* b2 = last ? nB : cB + (size_t)(t + 2) * kstep;
            const char* a3 = a2 + kstep; const char* b3 = b2 + kstep;
            PG8_LDB(B0, 0, 0); PG8_LDB(B1, 0, 1); PG8_SCHED; PG8_LDA(At, 0, 0); PG8_STAGE(PG8_SA(1, 1), a1 + hstepA, voffA);
            PG8_WAIT_V(8); PG8_WAIT_L(0); PG8_BAR; PG8_MMA(0, 0, At, B0); PG8_MMA(0, 1, At, B1); PG8_BAR; PG8_SCHED;
            PG8_LDA(At, 0, 1); PG8_STAGE(PG8_SB(0, 0), b2, voffB); PG8_STAGE(PG8_SB(0, 1), b2 + hstepB, voffB); PG8_STAGE(PG8_SA(0, 0), a2, voffA);
            PG8_WAIT_V(8); PG8_WAIT_L(0); PG8_BAR; PG8_MMA(1, 0, At, B0); PG8_MMA(1, 1, At, B1); PG8_BAR; PG8_SCHED;
            PG8_LDB(B0, 1, 0); PG8_LDB(B1, 1, 1); PG8_SCHED; PG8_LDA(At, 1, 0); PG8_STAGE(PG8_SA(0, 1), a2 + hstepA, voffA);
            PG8_WAIT_V(8); PG8_WAIT_L(0); PG8_BAR; PG8_MMA(0, 0, At, B0); PG8_MMA(0, 1, At, B1); PG8_BAR; PG8_SCHED;
            PG8_LDA(At, 1, 1); PG8_STAGE(PG8_SB(1, 0), b3, voffB); PG8_STAGE(PG8_SB(1, 1), b3 + hstepB, voffB); PG8_STAGE(PG8_SA(1, 0), a3, voffA);
            PG8_WAIT_V(8); PG8_WAIT_L(0); PG8_BAR; PG8_MMA(1, 0, At, B0); PG8_MMA(1, 1, At, B1); PG8_BAR; PG8_SCHED;
        }
        if (wr == 0) PG8_BAR;
        { int t2 = threadIdx.x; asm volatile("" : "+v"(t2)); const int fr2 = t2 & 15, fq2 = (t2 >> 4) & 3;
          E(acc, cur, wr, wc, fr2, fq2); }
        if (!has_next) break;
#pragma unroll
        for (int a = 0; a < 2; ++a)
#pragma unroll
            for (int b = 0; b < 2; ++b)
#pragma unroll
                for (int m = 0; m < 4; ++m)
#pragma unroll
                    for (int n = 0; n < 2; ++n) acc[a][b][m][n] = (f32x4){0.f, 0.f, 0.f, 0.f};
        cur = nxt; cA = nA; cB = nB; ++ui;
        if (wr == 1) PG8_BAR;
    }
    PG8_WAIT_V(0);
    PG8_BAR;
#undef PG8_SA
#undef PG8_SB
#undef PG8_STAGE
#undef PG8_LDA
#undef PG8_LDB
#undef PG8_MMA
#undef PG8_WAIT_V
#undef PG8_WAIT_L
#undef PG8_BAR
#undef PG8_SCHED
}

struct SchedStd {
    int nM, nN, G, c, lda, ldb, ldc;
    __device__ __forceinline__ bool next(int i, Unit& u) const {
        const int L = i * G + c; if (L >= nM * nN) return false;
        swz_order(L, nM, nN, u.pm, u.pn);
        u.aoff = (size_t)u.pm * BM * lda * 2; u.boff = (size_t)u.pn * BM * ldb * 2; u.coff = (size_t)u.pm * BM * ldc + (size_t)u.pn * BM; return true;
    }
};
struct SchedQKV {
    int G, c;
    __device__ __forceinline__ bool next(int i, Unit& u) const {
        const int L = i * G + c; if (L >= 1536 + 64) return false;
        if (L < 1536) swz_order(L, 64, 24, u.pm, u.pn); else { const int l2 = L - 1536; u.pm = 64 + (l2 & 3); u.pn = 8 + (l2 >> 2); }
        u.aoff = (size_t)u.pm * BM * D * 2; u.boff = (size_t)u.pn * BM * D * 2; u.coff = 0; return true;
    }
};
struct SchedInT {
    int G, c;
    __device__ __forceinline__ bool next(int i, Unit& u) const {
        const int L = i * G + c; if (L >= 512) return false;
        swz_order(L, 8, 64, u.pm, u.pn);
        u.aoff = (size_t)u.pm * BM * D * 2; u.boff = (size_t)u.pn * BM * D * 2;
        u.coff = ((size_t)((u.pn >> 4) * D + u.pm * BM)) * SEQ + (u.pn & 15) * BM; return true;
    }
};
struct SchedCols {
    int G, c, nU, ldb;
    __device__ __forceinline__ bool next(int i, Unit& u) const {
        const int L = i * G + c; if (L >= nU) return false;
        size_t z = 0; asm volatile("" : "+s"(z));
        u.pm = 0; u.pn = L; u.aoff = z; u.boff = (size_t)L * BM * ldb * 2; u.coff = 0; return true;
    }
};
struct SchedChan {
    int G, c;
    __device__ __forceinline__ bool next(int i, Unit& u) const {
        const int L = i * G + c; if (L >= 512) return false;
        u.pm = L >> 3; u.pn = L & 7;
        size_t z = 0; asm volatile("" : "+s"(z));
        u.aoff = ((size_t)u.pm * BM * 4096 + u.pn * 512) * 2; u.boff = z; u.coff = (size_t)u.pm * BM * D + u.pn * BM; return true;
    }
};

struct EpiPlain {
    bf16_t* O; int ldc;
    __device__ __forceinline__ void operator()(const f32x4 (&acc)[2][2][4][2], const Unit& u, int wr, int wc, int fr, int fq) const {
        bf16_t* base = O + u.coff + (size_t)(wr * 64 + fr) * ldc + wc * 32 + 8 * fq;
#pragma unroll
        for (int ai = 0; ai < 2; ++ai)
#pragma unroll
            for (int m = 0; m < 4; ++m) { bf16_t* rowp = base + (size_t)(ai * HALF + m * 16) * ldc;
#pragma unroll
                for (int bj = 0; bj < 2; ++bj) { const f32x4 v0 = acc[ai][bj][m][0], v1 = acc[ai][bj][m][1];
                    u32x4 w; w.x = cvt_pk_bf16(v0[0], v0[1]); w.y = cvt_pk_bf16(v0[2], v0[3]); w.z = cvt_pk_bf16(v1[0], v1[1]); w.w = cvt_pk_bf16(v1[2], v1[3]);
                    *(u32x4*)(rowp + bj * HALF) = w; } }
    }
};
struct EpiSwiGLU {
    bf16_t* O;
    __device__ __forceinline__ void operator()(const f32x4 (&acc)[2][2][4][2], const Unit& u, int wr, int wc, int fr, int fq) const {
        bf16_t* base = O + (size_t)(u.pm * BM + wr * 64 + fr) * FF + u.pn * 128 + wc * 32 + 8 * fq;
#pragma unroll
        for (int ai = 0; ai < 2; ++ai)
#pragma unroll
            for (int m = 0; m < 4; ++m) { bf16_t* rowp = base + (size_t)(ai * HALF + m * 16) * FF;
                float o[8];
#pragma unroll
                for (int n = 0; n < 2; ++n)
#pragma unroll
                    for (int j = 0; j < 4; ++j) { const float gv = acc[ai][0][m][n][j], uv = acc[ai][1][m][n][j];
                        o[n * 4 + j] = gv * uv * __builtin_amdgcn_rcpf(1.f + __builtin_amdgcn_exp2f(-1.4426950408889634f * gv)); }
                u32x4 w; w.x = cvt_pk_bf16(o[0], o[1]); w.y = cvt_pk_bf16(o[2], o[3]); w.z = cvt_pk_bf16(o[4], o[5]); w.w = cvt_pk_bf16(o[6], o[7]);
                *(u32x4*)rowp = w; }
    }
};
struct EpiFft1 {
    bf16_t* A2; const f32x2* tw;
    __device__ __forceinline__ void operator()(const f32x4 (&acc)[2][2][4][2], const Unit& u, int wr, int wc, int fr, int fq) const {
#pragma unroll
        for (int bj = 0; bj < 2; ++bj) { const int gcol = u.pn * 8 + 4 * bj + wc, b = gcol >> 11, col = gcol & 2047;
#pragma unroll
            for (int m = 0; m < 4; ++m) { const int k1 = 16 * m + fr; float re[8], im[8];
#pragma unroll
                for (int n = 0; n < 2; ++n)
#pragma unroll
                    for (int j = 0; j < 4; ++j) { const int r = 2 * (8 * fq + 4 * n + j) + wr; const f32x2 t = tw[k1 * r];
                        const float ar = acc[0][bj][m][n][j], ai = acc[1][bj][m][n][j];
                        re[n * 4 + j] = ar * t.x + ai * t.y; im[n * 4 + j] = ai * t.x - ar * t.y; }
                bf16_t* dst = A2 + (((size_t)(b * 32 + (k1 >> 1)) * D + col) * 256) + (k1 & 1) * 128 + wr * 32 + 8 * fq;
                u32x4 w; w.x = cvt_pk_bf16(re[0], re[1]); w.y = cvt_pk_bf16(re[2], re[3]); w.z = cvt_pk_bf16(re[4], re[5]); w.w = cvt_pk_bf16(re[6], re[7]);
                *(u32x4*)dst = w;
                w.x = cvt_pk_bf16(im[0], im[1]); w.y = cvt_pk_bf16(im[2], im[3]); w.z = cvt_pk_bf16(im[4], im[5]); w.w = cvt_pk_bf16(im[6], im[7]);
                *(u32x4*)(dst + 64) = w; } }
    }
};
struct EpiFft2 {
    bf16_t* X;
    __device__ __forceinline__ void operator()(const f32x4 (&acc)[2][2][4][2], const Unit& u, int wr, int wc, int fr, int fq) const {
        const int bk = u.pn >> 3, b = bk >> 5, k1p = bk & 31, gq = u.pn & 7;
#pragma unroll
        for (int ai = 0; ai < 2; ++ai)
#pragma unroll
            for (int m = 0; m < 4; ++m) { const int k2 = 16 * m + fr, tok = b * SEQ + 2 * k1p + ai + 64 * k2;
                bf16_t* rowp = X + (size_t)tok * 4096 + gq * 512 + wr * 256 + wc * 32 + 8 * fq;
#pragma unroll
                for (int bj = 0; bj < 2; ++bj) { const f32x4 v0 = acc[ai][bj][m][0], v1 = acc[ai][bj][m][1];
                    u32x4 w; w.x = cvt_pk_bf16(v0[0], v0[1]); w.y = cvt_pk_bf16(v0[2], v0[3]); w.z = cvt_pk_bf16(v1[0], v1[1]); w.w = cvt_pk_bf16(v1[2], v1[3]);
                    *(u32x4*)(rowp + bj * HALF) = w; } }
    }
};
struct EpiQKV {
    bf16_t *Q, *K, *V; const float* rope;
    __device__ __forceinline__ void operator()(const f32x4 (&acc)[2][2][4][2], const Unit& u, int wr, int wc, int fr, int fq) const {
        const int sec = u.pn >> 3, h0 = (u.pn & 7) * 2;
        const bool latent = u.pm < 64;
        const int b = latent ? (u.pm >> 4) : (u.pm - 64);
        const int tok0 = (latent ? (u.pm & 15) * 256 : SEQ) + wr * 64 + fr;
        const int cm = wc >> 1, axis = wc & 1;
#pragma unroll
        for (int ai = 0; ai < 2; ++ai)
#pragma unroll
            for (int m = 0; m < 4; ++m) {
                const int tok = tok0 + ai * HALF + m * 16;
                f32x4 c4 = {1.f, 1.f, 1.f, 1.f}, s4 = {0.f, 0.f, 0.f, 0.f};
                if (sec < 2 && latent) { const int pos = axis ? (tok & 63) : (tok >> 6); c4 = *(const f32x4*)(rope + pos * 16 + 4 * fq); s4 = *(const f32x4*)(rope + 1024 + pos * 16 + 4 * fq); }
#pragma unroll
                for (int bj = 0; bj < 2; ++bj) {
                    const int h = h0 + bj;
                    f32x4 v0 = acc[ai][bj][m][0], v1 = acc[ai][bj][m][1];
                    bf16_t* dst;
                    if (sec < 2) {
                        const f32x4 a = v0 * c4 - v1 * s4, bb = v1 * c4 + v0 * s4; v0 = a; v1 = bb;
                        if (sec == 0) { v0 = v0 * QSCALE; v1 = v1 * QSCALE; dst = Q + ((size_t)(((b * NH + h) * 2 + cm) * SEQ + tok)) * HD + axis * 32 + 8 * fq; }
                        else dst = K + ((size_t)(((b * NH + h) * 2 + cm) * SK + tok)) * HD + axis * 32 + 8 * fq;
                    } else dst = V + ((size_t)((b * NH + h) * SK + tok)) * VD + wc * 32 + 8 * fq;
                    u32x4 w; w.x = cvt_pk_bf16(v0[0], v0[1]); w.y = cvt_pk_bf16(v0[2], v0[3]); w.z = cvt_pk_bf16(v1[0], v1[1]); w.w = cvt_pk_bf16(v1[2], v1[3]);
                    *(u32x4*)dst = w;
                }
            }
    }
};
}

namespace att {
constexpr int NT = SK / 64;
constexpr int PD = 3, NS = PD + 1;
constexpr int KSL = 16384, VSL = 16384;
constexpr int KR = 0, VR = NS * KSL;
constexpr int XCH = 0, OST = 65536, SUBG = 132 * 1024, LAMO = SUBG + 512;
static_assert(VR + NS * VSL <= SUBG, "attention rings overlap the constants");
constexpr float THR = 8.f;
__device__ __forceinline__ float xmax(float v) { auto rr = __builtin_amdgcn_permlane32_swap(__float_as_uint(v), __float_as_uint(v), false, false); return fmaxf(__uint_as_float(rr[0]), __uint_as_float(rr[1])); }
__device__ __forceinline__ float xsum(float v) { auto rr = __builtin_amdgcn_permlane32_swap(__float_as_uint(v), __float_as_uint(v), false, false); return __uint_as_float(rr[0]) + __uint_as_float(rr[1]); }
#define MX3(a, b, c) __builtin_fmaxf(__builtin_fmaxf((a), (b)), (c))

__device__ __forceinline__ void attn_unit(int b, int h, int qb, const bf16_t* Q, const bf16_t* K, const bf16_t* V, bf16_t* O, LAS unsigned char* lds) {
    int tid = threadIdx.x; asm volatile("" : "+v"(tid));
    const int lane = tid & 63, r32 = lane & 31, hi = lane >> 5; const int wid = __builtin_amdgcn_readfirstlane(tid >> 6);
    const int cm = wid >> 2, wq = wid & 3;
    const bf16_t* Qp = Q + ((size_t)(((b * NH + h) * 2 + cm) * SEQ + qb * 128 + wq * 32 + r32)) * HD + hi * 8;
    const int kkey = tid >> 3;
    const bf16_t* K0g = K + ((size_t)((b * NH + h) * 2) * SK) * HD + (size_t)kkey * HD + (((tid & 7) ^ ((kkey >> 1) & 7)) * 8);
    const bf16_t* K1g = K0g + (size_t)SK * HD;
    const bf16_t* Vg0 = V + (size_t)((b * NH + h) * SK) * VD + (size_t)((((tid >> 6) & 3) * 16) + ((tid >> 2) & 15)) * VD + (tid >> 8) * 32 + (tid & 3) * 8;
    const bf16_t* Vg1 = Vg0 + 64;
    const unsigned wbase = (unsigned)wid * 1024u;
    const unsigned lds_base = (unsigned)(size_t)lds;
    const int toff = (qb * 17) % NT;
#define GLDS16(gsrc, ldsoff) do { unsigned keep_; const unsigned dst_ = (unsigned)__builtin_amdgcn_readfirstlane((int)(lds_base + (ldsoff))); \
        asm volatile("s_mov_b32 %0, m0\n\ts_mov_b32 m0, %2\n\ts_nop 0\n\tglobal_load_lds_dwordx4 %1, off\n\ts_mov_b32 m0, %0" : "=&s"(keep_) : "v"(gsrc), "s"(dst_) : "memory"); } while (0)
#define ATT_TILE(t) ({ int tt_ = (t) + toff; if (tt_ >= NT) tt_ -= NT; if (tt_ >= NT) tt_ -= NT; tt_; })
#define ATT_DMAK(t, sl) do { const size_t ko_ = (size_t)ATT_TILE(t) * 64 * HD; \
        GLDS16(K0g + ko_, KR + (sl) * KSL + wbase); GLDS16(K1g + ko_, KR + (sl) * KSL + 8192 + wbase); } while (0)
#define ATT_DMAV(t, sl) do { const size_t vo_ = (size_t)ATT_TILE(t) * 64 * VD; \
        GLDS16(Vg0 + vo_, VR + (sl) * VSL + wbase); GLDS16(Vg1 + vo_, VR + (sl) * VSL + 8192 + wbase); } while (0)
#define ATT_WAITBAR(N) do { asm volatile("s_waitcnt vmcnt(%0)" :: "n"(N) : "memory"); __builtin_amdgcn_s_barrier(); } while (0)
    static_assert(PD == 3, "the DMA schedule below is written for PD = 3 (4-slot rings)");
    ATT_DMAK(0, 0); ATT_DMAK(1, 1); ATT_DMAK(2, 2); ATT_DMAK(3, 3); ATT_DMAV(0, 0); ATT_DMAV(1, 1);
    bf16x8 qr[4];
#pragma unroll
    for (int d0 = 0; d0 < 4; ++d0) qr[d0] = *(const bf16x8*)(Qp + d0 * 16);
    f32x16 o[4];
#pragma unroll
    for (int e = 0; e < 4; ++e) o[e] = (f32x16){};
    float mrun, lsum = 0.f;
    int kro4[4];
#pragma unroll
    for (int d0 = 0; d0 < 4; ++d0) kro4[d0] = cm * 8192 + r32 * 128 + (((2 * d0 + hi) ^ ((r32 >> 1) & 7)) * 16);
    const int vro = VR + ((lane >> 4) & 1) * 32 + (lane & 3) * 8 + (4 * hi + ((lane & 15) >> 2)) * 64;
#define ATT_QK(P0, P1, so) do { P0 = (f32x16){}; P1 = (f32x16){}; _Pragma("unroll") for (int d0 = 0; d0 < 4; ++d0) { \
        const bf16x8 k0_ = *(const LAS bf16x8*)(lds + (so) + kro4[d0]); const bf16x8 k1_ = *(const LAS bf16x8*)(lds + (so) + kro4[d0] + 4096); \
        P0 = __builtin_amdgcn_mfma_f32_32x32x16_bf16(k0_, qr[d0], P0, 0, 0, 0); P1 = __builtin_amdgcn_mfma_f32_32x32x16_bf16(k1_, qr[d0], P1, 0, 0, 0); } } while (0)
    f32x16 pA0, pA1, pB0, pB1;
    ATT_WAITBAR(10);
    ATT_QK(pA0, pA1, KR);
    { float a_ = -1e30f;
#pragma unroll
      for (int j = 0; j < 16; ++j) a_ = MX3(a_, pA0[j], pA1[j]);
      mrun = xmax(a_);
#pragma unroll
      for (int j = 0; j < 16; ++j) { pA0[j] = __builtin_amdgcn_exp2f(pA0[j] - mrun); pA1[j] = __builtin_amdgcn_exp2f(pA1[j] - mrun); } }
    f32x16 negm;
#pragma unroll
    for (int j = 0; j < 16; ++j) negm[j] = -mrun;
    ATT_WAITBAR(0);
    bf16x8 kf[8];
#pragma unroll
    for (int d0 = 0; d0 < 4; ++d0) { kf[2 * d0] = *(const LAS bf16x8*)(lds + KR + 1 * KSL + kro4[d0]); kf[2 * d0 + 1] = *(const LAS bf16x8*)(lds + KR + 1 * KSL + kro4[d0] + 4096); }
    asm volatile("s_waitcnt lgkmcnt(0)" ::: "memory"); __builtin_amdgcn_s_barrier();
    int sl0 = 0, sl1 = 1;
#define SBAR() __builtin_amdgcn_sched_barrier(0)
#define VTR(ks, eb, half) __builtin_bit_cast(s16x4, __builtin_amdgcn_ds_read_tr16_b64_v4i16((LAS s16x4*)(lds + sl0 * VSL + vro + (eb) * 4096 + (ks) * 1024 + (half) * 512)))
#define ATT_STEP(P0, P1, N0, N1, t, FIRST) do { \
        if (FIRST) { ATT_DMAK((t) + 4, sl0); ATT_DMAK((t) + 5, sl1); ATT_DMAV((t) + 2, (sl1 == NS - 1 ? 0 : sl1 + 1)); ATT_DMAV((t) + 3, (sl0 == 0 ? NS - 1 : sl0 - 1)); } \
        const int sl2_ = (sl1 == NS - 1) ? 0 : sl1 + 1; \
        s16x4 vl_[4][4], vh_[4][4]; \
        _Pragma("unroll") for (int eb = 0; eb < 4; ++eb) { vl_[0][eb] = VTR(0, eb, 0); vh_[0][eb] = VTR(0, eb, 1); } \
        SBAR(); \
        float ls_ = 0.f; unsigned w0_[8], w1_[8]; \
        _Pragma("unroll") for (int i = 0; i < 8; ++i) { \
            if (i == 0)            N0 = __builtin_amdgcn_mfma_f32_32x32x16_bf16(kf[i], qr[i >> 1], negm, 0, 0, 0); \
            else if (i == 1)       N1 = __builtin_amdgcn_mfma_f32_32x32x16_bf16(kf[i], qr[i >> 1], negm, 0, 0, 0); \
            else if ((i & 1) == 0) N0 = __builtin_amdgcn_mfma_f32_32x32x16_bf16(kf[i], qr[i >> 1], N0, 0, 0, 0); \
            else                   N1 = __builtin_amdgcn_mfma_f32_32x32x16_bf16(kf[i], qr[i >> 1], N1, 0, 0, 0); \
            ls_ += (P0[2 * i] + P0[2 * i + 1]) + (P1[2 * i] + P1[2 * i + 1]); \
            w0_[i] = cvt_pk_bf16(P0[2 * i], P0[2 * i + 1]); w1_[i] = cvt_pk_bf16(P1[2 * i], P1[2 * i + 1]); \
            SBAR(); } \
        lsum += ls_; \
        bf16x8 pa_[4]; \
        pa_[0] = __builtin_bit_cast(bf16x8, (u32x4){w0_[0], w0_[1], w0_[2], w0_[3]}); pa_[1] = __builtin_bit_cast(bf16x8, (u32x4){w0_[4], w0_[5], w0_[6], w0_[7]}); \
        pa_[2] = __builtin_bit_cast(bf16x8, (u32x4){w1_[0], w1_[1], w1_[2], w1_[3]}); pa_[3] = __builtin_bit_cast(bf16x8, (u32x4){w1_[4], w1_[5], w1_[6], w1_[7]}); \
        float al_ = 1.f; bool resc_ = false; float mxn_ = -1e30f; \
        _Pragma("unroll") for (int ks = 0; ks < 4; ++ks) { \
            _Pragma("unroll") for (int eb = 0; eb < 4; ++eb) { \
                const bf16x8 vf_ = (bf16x8){vl_[ks][eb][0], vl_[ks][eb][1], vl_[ks][eb][2], vl_[ks][eb][3], vh_[ks][eb][0], vh_[ks][eb][1], vh_[ks][eb][2], vh_[ks][eb][3]}; \
                o[eb] = __builtin_amdgcn_mfma_f32_32x32x16_bf16(vf_, pa_[ks], o[eb], 0, 0, 0); \
                if (ks < 3) { vl_[ks + 1][eb] = VTR(ks + 1, eb, 0); vh_[ks + 1][eb] = VTR(ks + 1, eb, 1); } \
                if (ks == 0) { _Pragma("unroll") for (int j = 0; j < 4; ++j) mxn_ = MX3(mxn_, N0[eb * 4 + j], N1[eb * 4 + j]); } \
                if (ks == 1 || ks == 3) { const int i_ = (ks >> 1) * 4 + eb; \
                    N0[2 * i_] = __builtin_amdgcn_exp2f(N0[2 * i_]); N0[2 * i_ + 1] = __builtin_amdgcn_exp2f(N0[2 * i_ + 1]); \
                    N1[2 * i_] = __builtin_amdgcn_exp2f(N1[2 * i_]); N1[2 * i_ + 1] = __builtin_amdgcn_exp2f(N1[2 * i_ + 1]); } \
                if (ks == 2) { kf[2 * eb] = *(const LAS bf16x8*)(lds + KR + sl2_ * KSL + kro4[eb]); kf[2 * eb + 1] = *(const LAS bf16x8*)(lds + KR + sl2_ * KSL + kro4[eb] + 4096); } \
                SBAR(); } \
            if (ks == 0) { mxn_ = xmax(mxn_); \
                if ((t) + 1 < NT && __any(mxn_ > THR)) { const float dl_ = fmaxf(mxn_, 0.f); al_ = __builtin_amdgcn_exp2f(-dl_); mrun += dl_; lsum *= al_; resc_ = true; \
                    _Pragma("unroll") for (int j = 0; j < 16; ++j) { N0[j] -= dl_; N1[j] -= dl_; negm[j] = -mrun; } } \
                SBAR(); } } \
        if (resc_) { _Pragma("unroll") for (int e = 0; e < 4; ++e) _Pragma("unroll") for (int i = 0; i < 16; ++i) o[e][i] *= al_; } \
        SBAR(); \
        if (!(FIRST)) { asm volatile("s_waitcnt vmcnt(0) lgkmcnt(0)" ::: "memory"); __builtin_amdgcn_s_barrier(); } \
        SBAR(); \
        sl0 = sl1; sl1 = sl2_; \
    } while (0)
    if (cm == 1) __builtin_amdgcn_s_setprio(1);
    for (int t = 0; t < NT; t += 2) {
        ATT_STEP(pA0, pA1, pB0, pB1, t, true);
        ATT_STEP(pB0, pB1, pA0, pA1, t + 1, false);
    }
    __builtin_amdgcn_s_setprio(0);
    asm volatile("s_waitcnt vmcnt(0)" ::: "memory"); __builtin_amdgcn_s_barrier();
#undef SBAR
#undef VTR
#undef ATT_STEP
#undef ATT_QK
#undef ATT_DMAK
#undef ATT_TILE
#undef GLDS16
#undef ATT_DMAV
#undef ATT_WAITBAR
    const float linv = 1.f / xsum(lsum);
    LAS float* xch = (LAS float*)(lds + XCH) + wq * 64 * 64 + lane;
    if (cm == 1) {
#pragma unroll
        for (int e = 0; e < 4; ++e)
#pragma unroll
            for (int i = 0; i < 16; ++i) xch[(e * 16 + i) * 64] = o[e][i] * linv;
    }
    __syncthreads();
    if (cm == 0) {
        const float lam = *(const LAS float*)(lds + LAMO);
        float ss = 0.f;
#pragma unroll
        for (int e = 0; e < 4; ++e)
#pragma unroll
            for (int i = 0; i < 16; ++i) { const float v = o[e][i] * linv - lam * xch[(e * 16 + i) * 64]; o[e][i] = v; ss += v * v; }
        ss = xsum(ss);
        const float rn = __builtin_amdgcn_rsqf(ss * (1.f / VD) + RMS_EPS);
        const LAS float* sg = (const LAS float*)(lds + SUBG);
        LAS unsigned char* stg = lds + OST + wq * (32 * 272);
#pragma unroll
        for (int e = 0; e < 4; ++e)
#pragma unroll
            for (int i4 = 0; i4 < 4; ++i4) { const int e0 = 32 * e + 8 * i4 + 4 * hi;
                const f32x4 g4 = *(const LAS f32x4*)(sg + e0);
                u32x2 w; w.x = cvt_pk_bf16(o[e][4 * i4] * rn * g4[0], o[e][4 * i4 + 1] * rn * g4[1]); w.y = cvt_pk_bf16(o[e][4 * i4 + 2] * rn * g4[2], o[e][4 * i4 + 3] * rn * g4[3]);
                *(LAS u32x2*)(stg + r32 * 272 + e0 * 2) = w; }
        asm volatile("s_waitcnt lgkmcnt(0)" ::: "memory");
        bf16_t* Ow = O + ((size_t)(b * SEQ + qb * 128 + wq * 32)) * D + h * VD;
#pragma unroll
        for (int it = 0; it < 8; ++it) { const int id = it * 64 + lane, row = id >> 4, ch = id & 15;
            const u32x4 v = *(const LAS u32x4*)(stg + row * 272 + ch * 16);
            *(u32x4*)(Ow + (size_t)row * D + ch * 8) = v; }
    }
    __syncthreads();
}
}

#define XB_TMO      128
#define XB_XCNT(j)  (256  + 64 * (j))
#define XB_XSUB(j)  (1280 + 64 * (j))
#define XB_XGEN(j)  (2304 + 64 * (j))
#define XB_TOP      3328
#define XB_TOPGEN   3392
#define XCD_BAR_WORDS 3456
#define XB_SPIN_CAP (1u << 20)
__device__ __forceinline__ unsigned xb_ld(unsigned* p)              { return __hip_atomic_load(p, __ATOMIC_RELAXED, __HIP_MEMORY_SCOPE_AGENT); }
__device__ __forceinline__ unsigned xb_add(unsigned* p, unsigned v) { return __hip_atomic_fetch_add(p, v, __ATOMIC_RELAXED, __HIP_MEMORY_SCOPE_AGENT); }
__device__ __forceinline__ unsigned xb_xcc_id() { return (unsigned)__builtin_amdgcn_s_getreg((3 << 11) | 20) & 0xFu; }
#define XB_SPIN(cond, bar) do { unsigned _sp = 0; while (cond) { __builtin_amdgcn_s_sleep(1); \
    if ((++_sp & 255u) == 0u) { if (xb_ld(&(bar)[XB_TMO])) break; if (_sp > XB_SPIN_CAP) { atomicAdd(&(bar)[XB_TMO], 1u); break; } } } } while (0)
__device__ __forceinline__ void xcd_barrier_complete(unsigned* bar, unsigned x, unsigned& nloc, unsigned& nx) {
    const unsigned G = gridDim.x;
    unsigned sum, cnt, mine, sp = 0u;
    for (;;) {
        sum = 0u; cnt = 0u; mine = 0u;
#pragma unroll
        for (unsigned j = 0; j < 16; ++j) { const unsigned c = xb_ld(&bar[XB_XCNT(j)]); sum += c; cnt += (c > 0u) ? 1u : 0u; mine = (j == x) ? c : mine; }
        if (sum == G) break;
        __builtin_amdgcn_s_sleep(1);
        if ((++sp & 255u) == 0u) { if (xb_ld(&bar[XB_TMO])) break; if (sp > XB_SPIN_CAP) { atomicAdd(&bar[XB_TMO], 1u); break; } }
    }
    nloc = mine > 0u ? mine : 1u; nx = cnt > 0u ? cnt : 1u;
}
__device__ __forceinline__ void xcd_barrier(unsigned* bar, volatile LAS unsigned* st) {
    asm volatile("s_waitcnt vmcnt(0)" ::: "memory");
    __syncthreads();
    if (threadIdx.x == 0) {
        const unsigned x = xb_xcc_id();
        __builtin_amdgcn_s_waitcnt(0);
        unsigned nloc = st[0], nx = st[1];
        if (nloc == 0u) { xcd_barrier_complete(bar, x, nloc, nx); st[0] = nloc; st[1] = nx; }
        const unsigned old = xb_add(&bar[XB_XSUB(x)], 1u);
        const unsigned gen = old / nloc;
        if (old + 1u == (gen + 1u) * nloc) {
            __builtin_amdgcn_fence(__ATOMIC_RELEASE, "agent");
            asm volatile("s_waitcnt vmcnt(0)" ::: "memory");
            const unsigned og = xb_add(&bar[XB_TOP], 1u);
            const unsigned tg = og / nx;
            if (og + 1u == (tg + 1u) * nx) xb_add(&bar[XB_TOPGEN], 1u);
            else XB_SPIN(xb_ld(&bar[XB_TOPGEN]) == tg, bar);
            __builtin_amdgcn_fence(__ATOMIC_ACQUIRE, "agent");
            xb_add(&bar[XB_XGEN(x)], 1u);
            asm volatile("s_waitcnt vmcnt(0)" ::: "memory");
        } else {
            XB_SPIN(xb_ld(&bar[XB_XGEN(x)]) == gen, bar);
            __builtin_amdgcn_fence(__ATOMIC_ACQUIRE, "agent");
            asm volatile("s_waitcnt vmcnt(0)" ::: "memory");
        }
    }
    __syncthreads();
}
constexpr int LDS_BARST = 140 * 1024;

#ifndef PH_MASK
#define PH_MASK 0xFFFFFFu
#endif
#ifndef REP_ATT
#define REP_ATT 1
#endif
#ifndef REP_GU
#define REP_GU 1
#endif
#ifndef REP_SYNC
#define REP_SYNC 0
#endif
#ifndef REP_ROW
#define REP_ROW 1
#endif
#ifndef REP_P0
#define REP_P0 1
#endif
#define PH(k) if constexpr ((PH_MASK >> (k)) & 1u)
struct Args {
    const float *x, *c, *ctx, *c_ctx, *mod_w, *mod_b, *norm_g, *w_gu, *w_dn, *w_qkv, *w_o, *lam, *subg, *w_in, *w_out;
    float* out; unsigned char* ws;
};

__device__ __forceinline__ void transpose_item(const float* W, int K, int Nsrc, int Ndst, bf16_t* WT, int mode, LAS float* scr, int item, int lane) {
    const int nblk = Ndst / 32, kb = item / nblk, nb = item % nblk, k0 = 64 * kb, n0 = 32 * nb, i = lane & 31;
    int src;
    if (mode == 1 && n0 < 4096) src = n0 + ((i >> 2) & 1) * 16 + ((i >> 3) & 3) * 4 + (i & 3);
    else if (mode == 2) { const int tile = n0 >> 8, r0 = n0 & 255; src = (r0 < 128 ? tile * 128 + r0 : FF + tile * 128 + r0 - 128) + i; }
    else src = n0 + i;
#pragma unroll 8
    for (int q = 0; q < 32; ++q) { const int kk = 2 * q + (lane >> 5); scr[kk * 33 + i] = W[(size_t)(k0 + kk) * Nsrc + src]; }
    asm volatile("s_waitcnt lgkmcnt(0)" ::: "memory");
    const int c = lane & 7;
#pragma unroll
    for (int j = 0; j < 4; ++j) { const int n = (lane >> 3) + 8 * j; const LAS float* s = scr + (8 * c) * 33 + n;
        u32x4 o; o.x = cvt_pk_bf16(s[0 * 33], s[1 * 33]); o.y = cvt_pk_bf16(s[2 * 33], s[3 * 33]); o.z = cvt_pk_bf16(s[4 * 33], s[5 * 33]); o.w = cvt_pk_bf16(s[6 * 33], s[7 * 33]);
        *(u32x4*)(WT + (size_t)(n0 + n) * K + k0 + 8 * c) = o; }
    asm volatile("s_waitcnt lgkmcnt(0)" ::: "memory");
}

__device__ __forceinline__ void row_op(int lane, const bf16_t* y, const float* xin, const float* gate, const float* gy, float* xout,
                                       const float* gh, const float* sh, const float* sc, bf16_t* hb) {
    asm volatile("" : "+v"(lane));
    f32x4 v[8];
#pragma unroll
    for (int j = 0; j < 8; ++j) v[j] = *(const f32x4*)(xin + j * 256 + lane * 4);
    if (y) {
        u32x2 yw[8]; float ss = 0.f;
#pragma unroll
        for (int j = 0; j < 8; ++j) { yw[j] = *(const u32x2*)(y + j * 256 + lane * 4);
            const float a = bflo(yw[j].x), b = bfhi(yw[j].x), c = bflo(yw[j].y), d = bfhi(yw[j].y); ss += (a * a + b * b) + (c * c + d * d); }
        const float ry = __builtin_amdgcn_rsqf(wave_sum(ss) * (1.f / D) + RMS_EPS);
#pragma unroll
        for (int j = 0; j < 8; ++j) { const f32x4 g4 = *(const f32x4*)(gate + j * 256 + lane * 4), w4 = *(const f32x4*)(gy + j * 256 + lane * 4);
            const f32x4 yv = {bflo(yw[j].x), bfhi(yw[j].x), bflo(yw[j].y), bfhi(yw[j].y)};
            v[j] = v[j] + g4 * (yv * ry * w4); }
#pragma unroll
        for (int j = 0; j < 8; ++j) *(f32x4*)(xout + j * 256 + lane * 4) = v[j];
    }
    if (hb) {
        float ss = 0.f;
#pragma unroll
        for (int j = 0; j < 8; ++j) ss += (v[j].x * v[j].x + v[j].y * v[j].y) + (v[j].z * v[j].z + v[j].w * v[j].w);
        const float r = __builtin_amdgcn_rsqf(wave_sum(ss) * (1.f / D) + RMS_EPS);
#pragma unroll
        for (int j = 0; j < 8; ++j) { const f32x4 g4 = *(const f32x4*)(gh + j * 256 + lane * 4), s4 = *(const f32x4*)(sh + j * 256 + lane * 4), c4 = *(const f32x4*)(sc + j * 256 + lane * 4);
            const f32x4 hv = v[j] * r * g4 * (c4 + 1.f) + s4;
            u32x2 w; w.x = cvt_pk_bf16(hv.x, hv.y); w.y = cvt_pk_bf16(hv.z, hv.w);
            *(u32x2*)(hb + j * 256 + lane * 4) = w; }
    }
}

template <bool HAS_Y, bool HAS_H, bool XIN_BF = false, bool XOUT_BF = false>
__device__ __forceinline__ void row_phase(int lane, int gw, int NGW, const bf16_t* Y, const void* Xin_, void* Xout_, const float* ada_layer, int cg, const float* gy,
                                          const float* gh, int csh, int csc, bf16_t* Hout, bool perm, const float* ada_mod = nullptr) {
    const float* Xin = (const float*)Xin_; float* Xout = (float*)Xout_; const bf16_t* XinB = (const bf16_t*)Xin_; bf16_t* XoutB = (bf16_t*)Xout_;
    asm volatile("" : "+v"(lane));
    const int b = gw & 3;
    const float* ad = ada_layer + (size_t)b * 6 * D;
    const float* adm = (ada_mod ? ada_mod : ada_layer) + (size_t)b * 6 * D;
    f32x4 pa[8], pb[8], pc[8];
#pragma unroll
    for (int j = 0; j < 8; ++j) { const int c = j * 256 + lane * 4;
        if (HAS_Y) pa[j] = *(const f32x4*)(ad + cg * D + c) * *(const f32x4*)(gy + c);
        if (HAS_H) { pb[j] = *(const f32x4*)(gh + c) * (*(const f32x4*)(adm + csc * D + c) + 1.f); pc[j] = *(const f32x4*)(adm + csh * D + c); } }
    for (int idx = gw; idx < M; idx += NGW) {
        const int t = idx >> 2; const size_t row = (size_t)b * SEQ + t;
        f32x4 v[8];
        if (XIN_BF) {
#pragma unroll
            for (int j = 0; j < 8; ++j) { const u32x2 xw = *(const u32x2*)(XinB + row * D + j * 256 + lane * 4); v[j] = (f32x4){bflo(xw.x), bfhi(xw.x), bflo(xw.y), bfhi(xw.y)}; }
        } else {
#pragma unroll
            for (int j = 0; j < 8; ++j) v[j] = *(const f32x4*)(Xin + row * D + j * 256 + lane * 4);
        }
        if (HAS_Y) {
            u32x2 yw[8]; float ss = 0.f;
#pragma unroll
            for (int j = 0; j < 8; ++j) { yw[j] = *(const u32x2*)(Y + row * D + j * 256 + lane * 4);
                const float a0 = bflo(yw[j].x), a1 = bfhi(yw[j].x), a2 = bflo(yw[j].y), a3 = bfhi(yw[j].y); ss += (a0 * a0 + a1 * a1) + (a2 * a2 + a3 * a3); }
            const float ry = __builtin_amdgcn_rsqf(wave_sum(ss) * (1.f / D) + RMS_EPS);
#pragma unroll
            for (int j = 0; j < 8; ++j) { const f32x4 yv = {bflo(yw[j].x), bfhi(yw[j].x), bflo(yw[j].y), bfhi(yw[j].y)};
                v[j] = v[j] + pa[j] * (yv * ry);
                if (XOUT_BF) { u32x2 w; w.x = cvt_pk_bf16(v[j].x, v[j].y); w.y = cvt_pk_bf16(v[j].z, v[j].w); *(u32x2*)(XoutB + row * D + j * 256 + lane * 4) = w;
                    v[j] = (f32x4){bflo(w.x), bfhi(w.x), bflo(w.y), bfhi(w.y)}; }
                else *(f32x4*)(Xout + row * D + j * 256 + lane * 4) = v[j]; }
        }
        if (HAS_H) {
            float ss = 0.f;
#pragma unroll
            for (int j = 0; j < 8; ++j) ss += (v[j].x * v[j].x + v[j].y * v[j].y) + (v[j].z * v[j].z + v[j].w * v[j].w);
            const float r = __builtin_amdgcn_rsqf(wave_sum(ss) * (1.f / D) + RMS_EPS);
            const size_t hrow = perm ? (size_t)b * SEQ + (t & 63) * 64 + (t >> 6) : row;
#pragma unroll
            for (int j = 0; j < 8; ++j) { const f32x4 hv = v[j] * r * pb[j] + pc[j];
                u32x2 w; w.x = cvt_pk_bf16(hv.x, hv.y); w.y = cvt_pk_bf16(hv.z, hv.w);
                *(u32x2*)(Hout + hrow * D + j * 256 + lane * 4) = w; }
        }
    }
}

__global__ void __launch_bounds__(512, 2) fwd_megakernel(Args a) {
    extern __shared__ __attribute__((aligned(16))) unsigned char lds_raw[];
    LAS unsigned char* lds = (LAS unsigned char*)lds_raw;
    cg::grid_group grid = cg::this_grid();
    const int tid = threadIdx.x, lane = tid & 63, wave = __builtin_amdgcn_readfirstlane(tid >> 6);
    const int G = gridDim.x, bx = blockIdx.x;
    const int gw = bx * 8 + wave, NGW = G * 8;
    if (tid < 2) ((LAS unsigned*)(lds + LDS_BARST))[tid] = 0u;
    if (tid == 0) (void)xb_add(&((unsigned*)a.ws)[XB_XCNT(xb_xcc_id())], 1u);
    __syncthreads();
#define GRID_BAR() xcd_barrier((unsigned*)WSB, (volatile LAS unsigned*)(lds + LDS_BARST))
#define WSB ({ unsigned char* _w = a.ws; asm volatile("" : "+s"(_w)); _w; })
#define ADA ((float*)(WSB + WS_ADA))
#define ROPE ((float*)(WSB + WS_ROPE))
#define D1T ((bf16_t*)(WSB + WS_D1))
#define D2T ((bf16_t*)(WSB + WS_D2))
#define CS2 ((bf16_t*)(WSB + WS_CS2))
#define TWT ((f32x2*)(WSB + WS_TW))
#define Wqkv ((bf16_t*)(WSB + WS_WQKV))
#define Wo ((bf16_t*)(WSB + WS_WO))
#define Win ((bf16_t*)(WSB + WS_WIN))
#define Wout ((bf16_t*)(WSB + WS_WOUT))
#define Wgu ((bf16_t*)(WSB + WS_WGU))
#define Wdn ((bf16_t*)(WSB + WS_WDN))
#define HB ((bf16_t*)(WSB + WS_HB))
#define YB ((bf16_t*)(WSB + WS_YB))
#define Qb ((bf16_t*)(WSB + WS_Q))
#define Kb ((bf16_t*)(WSB + WS_K))
#define Vb ((bf16_t*)(WSB + WS_V))
#define Ob ((bf16_t*)(WSB + WS_O))
#define HID ((bf16_t*)(WSB + WS_HID))
#define Ub ((bf16_t*)(WSB + WS_U))
#define A2b ((bf16_t*)(WSB + WS_A2))
#define Xb ((bf16_t*)(WSB + WS_X))
#define Fb ((bf16_t*)(WSB + WS_F))
#define XR ((bf16_t*)(WSB + WS_XR))

    for (int rep0 = 0; rep0 < REP_P0; ++rep0) {
        LAS float* sl = (LAS float*)(lds + 69632);
        LAS float* red = (LAS float*)lds;
        if (bx < 192) {
            for (int i = tid; i < 5 * D; i += 512) { const float cv = (i < 4 * D) ? a.c[i] : a.c_ctx[i - 4 * D]; sl[i] = silu_f(cv); }
            __syncthreads();
            for (int it = bx; it < 192; it += G) {
                const int layer = it / 96, n0 = (it % 96) * 128;
                const float* wp = a.mod_w + (size_t)layer * D * 6 * D + (size_t)(wave * 256) * 6 * D + n0 + lane * 2;
                float ac[5][2];
#pragma unroll
                for (int r = 0; r < 5; ++r) { ac[r][0] = 0.f; ac[r][1] = 0.f; }
#pragma unroll 8
                for (int k = 0; k < 256; ++k) { const f32x2 w = *(const f32x2*)(wp + (size_t)k * 6 * D);
#pragma unroll
                    for (int r = 0; r < 5; ++r) { const float s = sl[r * D + wave * 256 + k]; ac[r][0] += s * w.x; ac[r][1] += s * w.y; } }
#pragma unroll
                for (int r = 0; r < 5; ++r) { red[(wave * 5 + r) * 128 + lane * 2] = ac[r][0]; red[(wave * 5 + r) * 128 + lane * 2 + 1] = ac[r][1]; }
                __syncthreads();
                for (int i = tid; i < 5 * 128; i += 512) { const int r = i >> 7, cc = i & 127; float s = a.mod_b[layer * 6 * D + n0 + cc];
#pragma unroll
                    for (int w = 0; w < 8; ++w) s += red[(w * 5 + r) * 128 + cc];
                    ADA[(size_t)(layer * 5 + r) * 6 * D + n0 + cc] = s; }
                __syncthreads();
            }
        }
        __syncthreads();
        LAS float* scr = (LAS float*)(lds + wave * 8704);
        constexpr int I_QKV = 32 * 192, I_SQ = 32 * 64, I_GU = 32 * 352, I_DN = 88 * 64;
        constexpr int NITEMS = I_QKV + 3 * I_SQ + 2 * I_GU + 2 * I_DN;
        for (int it = gw; it < NITEMS; it += NGW) {
            int r = it;
            if (r < I_QKV) { transpose_item(a.w_qkv, D, NQKV, NQKV, Wqkv, 1, scr, r, lane); continue; } r -= I_QKV;
            if (r < I_SQ) { transpose_item(a.w_o, D, D, D, Wo, 0, scr, r, lane); continue; } r -= I_SQ;
            if (r < I_SQ) { transpose_item(a.w_in, D, D, D, Win, 0, scr, r, lane); continue; } r -= I_SQ;
            if (r < I_SQ) { transpose_item(a.w_out, D, D, D, Wout, 0, scr, r, lane); continue; } r -= I_SQ;
            if (r < 2 * I_GU) { const int l = r / I_GU; transpose_item(a.w_gu + (size_t)l * D * NGU, D, NGU, NGU, Wgu + (size_t)l * NGU * D, 2, scr, r % I_GU, lane); continue; } r -= 2 * I_GU;
            { const int l = r / I_DN; transpose_item(a.w_dn + (size_t)l * FF * D, FF, D, D, Wdn + (size_t)l * D * FF, 0, scr, r % I_DN, lane); }
        }
        const int gt = bx * 512 + tid, NGT = G * 512;
        if (gt < 1024) { const int pos = gt >> 4, f = gt & 15; const float inv = powf(10000.f, -(float)f / 16.f); const float ang = (float)pos * inv;
            ROPE[gt] = cosf(ang); ROPE[1024 + gt] = sinf(ang); }
        for (int i = gt; i < 256 * 128; i += NGT) { const int m = i >> 7, k = i & 127, part = m >> 7, rp = (m >> 6) & 1, k1 = m & 63, rp2 = k >> 6, aa = k & 63;
            float sv, cv; sincospif((float)((k1 * aa) & 63) * (1.f / 32.f), &sv, &cv); const float v = (rp == rp2) ? (part ? -sv : cv) * 0.125f : 0.f;
            D1T[i] = (bf16_t)(cvt_pk_bf16(v, v) & 0xffffu); }
        for (int i = gt; i < 256 * 256; i += NGT) { const int m = i >> 8, k = i & 255, kp = m >> 7, po = (m >> 6) & 1, k2 = m & 63, kp2 = k >> 7, part = (k >> 6) & 1, rp = (k >> 5) & 1, r = 2 * (k & 31) + rp;
            float sv, cv; sincospif((float)((k2 * r) & 63) * (1.f / 32.f), &sv, &cv);
            const float v = (kp == kp2) ? (po == 0 ? (part == 0 ? cv : sv) : (part == 0 ? -sv : cv)) * 0.125f : 0.f;
            D2T[i] = (bf16_t)(cvt_pk_bf16(v, v) & 0xffffu); }
        for (int i = gt; i < 256 * 512; i += NGT) { const int kc = i >> 9, k = i & 511, part = k >> 8, cc = k & 255;
            float sv, cv; sincospif((float)((kc * cc) & 255) * (1.f / 128.f), &sv, &cv); const float v = (part ? sv : cv) * (1.f / 16.f);
            CS2[i] = (bf16_t)(cvt_pk_bf16(v, v) & 0xffffu); }
        for (int i = gt; i < 4096; i += NGT) { float sv, cv; sincospif((float)i * (1.f / 2048.f), &sv, &cv); TWT[i] = (f32x2){cv, sv}; }
    }
    grid.sync();

    for (int rs = 0; rs < REP_SYNC; ++rs) GRID_BAR();
    row_phase<false, true>(lane, gw, NGW, nullptr, a.x, nullptr, ADA, 0, nullptr, a.norm_g, 0, 1, HB, false);
    for (int row = M + gw; row < MT; row += NGW) { const float* ad = ADA + (size_t)4 * 6 * D;
        row_op(lane, nullptr, a.ctx + (size_t)(row - M) * D, nullptr, nullptr, nullptr, a.norm_g, ad, ad + D, HB + (size_t)row * D); }
    GRID_BAR();

    PH(0) { pg8::Gemm g{HB, Wqkv, D, D, D}; pg8::SchedQKV S{G, bx}; pg8::EpiQKV E{Qb, Kb, Vb, ROPE};
      pg8::gemm_phase(lds, g, S, E); }
    GRID_BAR();

    {
        if (tid < 128) ((LAS float*)(lds + att::SUBG))[tid] = a.subg[tid] * 0.8f;
        if (wave == 0) { const float p01 = wave_sum(a.lam[lane] * a.lam[64 + lane]), p23 = wave_sum(a.lam[128 + lane] * a.lam[192 + lane]);
            if (lane == 0) *(LAS float*)(lds + att::LAMO) = expf(p01) - expf(p23) + 0.2f; }
        __syncthreads();
        for (int rep = 0; rep < REP_ATT; ++rep)
        if (G == 256) { for (int i = 0; i < 8; ++i) { const int bh = (bx & 7) * 8 + i, qb = bx >> 3; att::attn_unit(bh >> 4, bh & 15, qb, Qb, Kb, Vb, Ob, lds); } }
        else { for (int u = bx; u < 2048; u += G) { const int bh = u >> 5, qb = u & 31; att::attn_unit(bh >> 4, bh & 15, qb, Qb, Kb, Vb, Ob, lds); } }
    }
    GRID_BAR();

    PH(1) { pg8::Gemm g{Ob, Wo, D, D, D}; pg8::SchedStd S{64, 8, G, bx, D, D, D}; pg8::EpiPlain E{YB, D}; pg8::gemm_phase(lds, g, S, E); }
    GRID_BAR();

    row_phase<true, true, false, true>(lane, gw, NGW, YB, a.x, XR, ADA, 2, a.norm_g + D, a.norm_g + 2 * D, 3, 4, HB, false);
    GRID_BAR();

    for (int repg = 0; repg < REP_GU; ++repg)
    PH(2) { pg8::Gemm g{HB, Wgu, D, D, D}; pg8::SchedStd S{64, 44, G, bx, D, D, 0}; pg8::EpiSwiGLU E{HID}; pg8::gemm_phase(lds, g, S, E); }
    GRID_BAR();
    PH(3) { pg8::Gemm g{HID, Wdn, FF, FF, FF}; pg8::SchedStd S{64, 8, G, bx, FF, FF, D}; pg8::EpiPlain E{YB, D}; pg8::gemm_phase(lds, g, S, E); }
    GRID_BAR();

    row_phase<true, true, true, true>(lane, gw, NGW, YB, XR, XR, ADA, 5, a.norm_g + 3 * D, a.norm_g + 4 * D, 0, 1, HB, true, ADA + (size_t)5 * 6 * D);
    GRID_BAR();

    PH(4) { pg8::Gemm g{Win, HB, D, D, D}; pg8::SchedInT S{G, bx}; pg8::EpiPlain E{Ub, SEQ}; pg8::gemm_phase(lds, g, S, E); }
    GRID_BAR();
    PH(5) { pg8::Gemm g{D1T, Ub, 128, 128, 128}; pg8::SchedCols S{G, bx, 1024, 128}; pg8::EpiFft1 E{A2b, TWT}; pg8::gemm_phase(lds, g, S, E); }
    GRID_BAR();
    PH(6) { pg8::Gemm g{D2T, A2b, 256, 256, 256}; pg8::SchedCols S{G, bx, 1024, 256}; pg8::EpiFft2 E{Xb}; pg8::gemm_phase(lds, g, S, E); }
    GRID_BAR();
    PH(10) { pg8::Gemm g{Xb, CS2, 4096, 512, 512}; pg8::SchedChan S{G, bx}; pg8::EpiPlain E{Fb, D}; pg8::gemm_phase(lds, g, S, E); }
    GRID_BAR();
    PH(7) { pg8::Gemm g{Fb, Wout, D, D, D}; pg8::SchedStd S{64, 8, G, bx, D, D, D}; pg8::EpiPlain E{YB, D}; pg8::gemm_phase(lds, g, S, E); }
    GRID_BAR();

    row_phase<true, true, true, true>(lane, gw, NGW, YB, XR, XR, ADA + (size_t)5 * 6 * D, 2, a.norm_g + 5 * D, a.norm_g + 6 * D, 3, 4, HB, false);
    GRID_BAR();

    PH(8) { pg8::Gemm g{HB, Wgu + (size_t)NGU * D, D, D, D}; pg8::SchedStd S{64, 44, G, bx, D, D, 0}; pg8::EpiSwiGLU E{HID}; pg8::gemm_phase(lds, g, S, E); }
    GRID_BAR();
    PH(9) { pg8::Gemm g{HID, Wdn + (size_t)D * FF, FF, FF, FF}; pg8::SchedStd S{64, 8, G, bx, FF, FF, D}; pg8::EpiPlain E{YB, D}; pg8::gemm_phase(lds, g, S, E); }
    GRID_BAR();

    row_phase<true, false, true, false>(lane, gw, NGW, YB, XR, a.out, ADA + (size_t)5 * 6 * D, 5, a.norm_g + 7 * D, nullptr, 0, 0, nullptr, false);
}

extern "C" void kernel_launch(void* const* d_in, const int* in_sizes, int n_in, void* d_out, int out_size, void* d_ws, size_t ws_size, hipStream_t stream) {
    static int grid = 0;
    if (grid == 0) {
        if (n_in != 15 || in_sizes[0] != M * D || out_size != M * D || ws_size < WS_END) {
            fprintf(stderr, "kernel_launch: unexpected shapes / workspace (n_in %d, in0 %d, out %d, ws %zu, need %zu)\n", n_in, n_in > 0 ? in_sizes[0] : -1, out_size, ws_size, (size_t)WS_END);
            grid = -1; return; }
        int dev = 0, cus = 0, per_cu = 0;
        hipGetDevice(&dev);
        hipDeviceGetAttribute(&cus, hipDeviceAttributeMultiprocessorCount, dev);
        if (hipFuncSetAttribute((const void*)fwd_megakernel, hipFuncAttributeMaxDynamicSharedMemorySize, LDS_BYTES) != hipSuccess) { fprintf(stderr, "kernel_launch: hipFuncSetAttribute failed\n"); grid = -1; return; }
        hipOccupancyMaxActiveBlocksPerMultiprocessor(&per_cu, (const void*)fwd_megakernel, 512, LDS_BYTES);
        if (per_cu < 1) { fprintf(stderr, "kernel_launch: occupancy query says %d blocks per CU\n", per_cu); per_cu = 1; }
        (void)hipGetLastError();
        grid = cus * 1;
    }
    if (grid < 0) return;
    if (hipMemsetAsync(d_ws, 0, 16384, stream) != hipSuccess) { fprintf(stderr, "kernel_launch: hipMemsetAsync of the barrier words failed\n"); return; }
    Args a{};
    a.x = (const float*)d_in[0]; a.c = (const float*)d_in[1]; a.ctx = (const float*)d_in[2]; a.c_ctx = (const float*)d_in[3];
    a.mod_w = (const float*)d_in[4]; a.mod_b = (const float*)d_in[5]; a.norm_g = (const float*)d_in[6]; a.w_gu = (const float*)d_in[7]; a.w_dn = (const float*)d_in[8];
    a.w_qkv = (const float*)d_in[9]; a.w_o = (const float*)d_in[10]; a.lam = (const float*)d_in[11]; a.subg = (const float*)d_in[12]; a.w_in = (const float*)d_in[13]; a.w_out = (const float*)d_in[14];
    a.out = (float*)d_out; a.ws = (unsigned char*)d_ws;
    void* args[] = {&a};
    hipError_t e = hipLaunchCooperativeKernel((const void*)fwd_megakernel, dim3(grid), dim3(512), args, LDS_BYTES, stream);
    if (e != hipSuccess) fprintf(stderr, "cooperative launch failed: %s (grid %d)\n", hipGetErrorString(e), grid);
}
```

```cpp
#include <hip/hip_runtime.h>
#include <hip/hip_cooperative_groups.h>
#include <cstdio>
#include <cstdint>
namespace cg = cooperative_groups;

#define LAS __attribute__((address_space(3)))
typedef unsigned short bf16_t;
typedef short bf16x8 __attribute__((ext_vector_type(8)));
typedef short s16x4 __attribute__((ext_vector_type(4)));
typedef float f32x4 __attribute__((ext_vector_type(4)));
typedef float f32x2 __attribute__((ext_vector_type(2)));
typedef float f32x16 __attribute__((ext_vector_type(16)));
typedef unsigned u32x4 __attribute__((ext_vector_type(4)));
typedef unsigned u32x2 __attribute__((ext_vector_type(2)));

constexpr int D = 2048, NB = 4, SEQ = 4096, M = NB * SEQ, LC = 256, MC = NB * LC, MT = M + MC;
constexpr int NH = 16, HD = 64, VD = 128, NQKV = 6144, FF = 5632, NGU = 2 * FF, SK = SEQ + LC;
constexpr float RMS_EPS = 1e-6f;
constexpr float QSCALE = 0.125f * 1.4426950408889634f;

constexpr size_t MiB = 1u << 20;
constexpr size_t WS_ADA = 1 * MiB;
constexpr size_t WS_ROPE = 1 * MiB + 768 * 1024;
constexpr size_t WS_D1 = 2 * MiB;
constexpr size_t WS_D2 = 2 * MiB + 64 * 1024;
constexpr size_t WS_CS2 = 2 * MiB + 192 * 1024;
constexpr size_t WS_TW = 2 * MiB + 448 * 1024;
constexpr size_t WS_WQKV = 3 * MiB;
constexpr size_t WS_WO = 27 * MiB;
constexpr size_t WS_WIN = 35 * MiB;
constexpr size_t WS_WOUT = 43 * MiB;
constexpr size_t WS_WGU = 51 * MiB;
constexpr size_t WS_WDN = 139 * MiB;
constexpr size_t WS_HB = 183 * MiB;
constexpr size_t WS_YB = 251 * MiB;
constexpr size_t WS_R = 315 * MiB;
constexpr size_t WS_Q = WS_R;
constexpr size_t WS_K = WS_R + 64 * MiB;
constexpr size_t WS_V = WS_R + 132 * MiB;
constexpr size_t WS_O = WS_R + 200 * MiB;
constexpr size_t WS_HID = WS_R;
constexpr size_t WS_U = WS_R + 200 * MiB;
constexpr size_t WS_A2 = WS_R;
constexpr size_t WS_X = WS_R + 128 * MiB;
constexpr size_t WS_F = WS_R;
constexpr size_t WS_XR = WS_R + 264 * MiB;
constexpr size_t WS_SLOT = WS_R + 328 * MiB;
constexpr size_t WS_SLOT_BYTES = 2 * MiB;
constexpr size_t WS_END = WS_R + 332 * MiB;
constexpr size_t WS_XCNT = 32768;
constexpr size_t WS_XTMO = 24576;
constexpr size_t WS_ZERO_BYTES = 262144;

constexpr int LDS_BYTES = 147456;

typedef __bf16 bf16x2_t __attribute__((ext_vector_type(2)));
__device__ __forceinline__ unsigned cvt_pk_bf16(float lo, float hi) { const f32x2 v = {lo, hi}; const bf16x2_t b = __builtin_convertvector(v, bf16x2_t); return __builtin_bit_cast(unsigned, b); }
__device__ __forceinline__ float bf2f(unsigned short b) { return __uint_as_float(((unsigned)b) << 16); }
__device__ __forceinline__ float bflo(unsigned w) { return __uint_as_float(w << 16); }
__device__ __forceinline__ float bfhi(unsigned w) { return __uint_as_float(w & 0xffff0000u); }
__device__ __forceinline__ float wave_sum(float v) {
#pragma unroll
    for (int o = 1; o < 64; o <<= 1) v += __shfl_xor(v, o);
    return v;
}
__device__ __forceinline__ float silu_f(float v) { return v / (1.f + __expf(-v)); }

namespace pg8 {
constexpr int BM = 256, BK = 64, HALF = 128, HTB = HALF * BK * 2, NXCD = 8, WGM = 8;
__host__ __device__ __forceinline__ int lds_byte(int r, int c) { const int st = (r >> 4) * 2 + (c >> 5), rr = r & 15, cc = c & 31, ob = rr * 64 + cc * 2; return st * 1024 + (ob ^ (((ob >> 9) & 1) << 5)); }
__host__ __device__ __forceinline__ void stage_rc(int b, int& R, int& C) { const int st = b / 1024, sb = b % 1024, swz = sb ^ (((sb >> 9) & 1) << 5); R = (st >> 1) * 16 + swz / 64; C = (st & 1) * 32 + (swz % 64) / 2; }
__host__ __device__ __forceinline__ int perm32(int rho) { const int n = rho >> 4, i = rho & 15; return 8 * (i >> 2) + 4 * n + (i & 3); }

struct Unit { int pm, pn; size_t aoff, boff, coff; };
struct Gemm { const bf16_t* A; const bf16_t* Bt; int lda, ldb, K; };

__device__ __forceinline__ void swz_order(int L, int nM, int nN, int& pm, int& pn) {
    const int nwg = nM * nN; int wgid = L;
    { const int q = nwg / NXCD, r = nwg % NXCD, xcd = wgid % NXCD, off = wgid / NXCD; wgid = (xcd < r ? xcd * (q + 1) : r * (q + 1) + (xcd - r) * q) + off; }
    const int nig = WGM * nN, gid = wgid / nig, fm = gid * WGM, gsz = (nM - fm) < WGM ? (nM - fm) : WGM;
    pm = fm + ((wgid % nig) % gsz); pn = (wgid % nig) / gsz;
}

template <class Epi, class Sched>
__device__ __forceinline__ void gemm_phase(LAS unsigned char* lds, const Gemm g, const Sched& S, const Epi& E) {
    int tid = threadIdx.x; asm volatile("" : "+v"(tid));
    const int wid = __builtin_amdgcn_readfirstlane(tid >> 6), lane = tid & 63, wr = wid >> 2, wc = wid & 3, fr = lane & 15, fq = lane >> 4;
    int nt = g.K / BK; asm volatile("" : "+s"(nt));
    unsigned voffA[2], voffB[2];
#pragma unroll
    for (int i = 0; i < 2; ++i) { int R, C; stage_rc(tid * 16 + i * 8192, R, C); const int Rb = (R & ~31) + perm32(R & 31);
        voffA[i] = (unsigned)(R * g.lda + C) * 2u; voffB[i] = (unsigned)(Rb * g.ldb + C) * 2u; }
    const size_t kstep = (size_t)(BK * 2);
    const size_t hstepA = (size_t)HALF * g.lda * 2, hstepB = (size_t)HALF * g.ldb * 2;
    const unsigned ldsw = (unsigned)wid * 1024u;
    const int aoff = lds_byte(wr * 64 + fr, fq * 8), boff = lds_byte(wc * 32 + fr, fq * 8);
#define PG8_SA(b, h) (((b) * 2 + (h)) * HTB)
#define PG8_SB(b, h) ((4 + (b) * 2 + (h)) * HTB)
#define PG8_STAGE(bufoff, gbase, voff) do { _Pragma("unroll") for (int _i = 0; _i < 2; ++_i) \
        __builtin_amdgcn_global_load_lds((const unsigned*)((const char*)(gbase) + (voff)[_i]), (LAS unsigned*)(lds + (bufoff) + ldsw + _i * 8192), 16, 0, 0); } while (0)
#define PG8_LDA(dst, b, h) do { _Pragma("unroll") for (int m = 0; m < 4; ++m) _Pragma("unroll") for (int k = 0; k < 2; ++k) dst[m][k] = *(const LAS bf16x8*)(lds + PG8_SA(b, h) + aoff + m * 2048 + k * 1024); } while (0)
#define PG8_LDB(dst, b, h) do { _Pragma("unroll") for (int n = 0; n < 2; ++n) _Pragma("unroll") for (int k = 0; k < 2; ++k) dst[n][k] = *(const LAS bf16x8*)(lds + PG8_SB(b, h) + boff + n * 2048 + k * 1024); } while (0)
#define PG8_MMA(ai, bj, At, Bt) do { __builtin_amdgcn_s_setprio(1); _Pragma("unroll") for (int m = 0; m < 4; ++m) _Pragma("unroll") for (int n = 0; n < 2; ++n) _Pragma("unroll") for (int k = 0; k < 2; ++k) \
        acc[ai][bj][m][n] = __builtin_amdgcn_mfma_f32_16x16x32_bf16(Bt[n][k], At[m][k], acc[ai][bj][m][n], 0, 0, 0); __builtin_amdgcn_s_setprio(0); } while (0)
#define PG8_WAIT_V(n) asm volatile("s_waitcnt vmcnt(" #n ")" ::: "memory")
#define PG8_WAIT_L(n) asm volatile("s_waitcnt lgkmcnt(" #n ")" ::: "memory")
#define PG8_BAR __builtin_amdgcn_s_barrier()
#define PG8_SCHED __builtin_amdgcn_sched_barrier(0)
    Unit cur, nxt; int ui = 0;
    if (!S.next(0, cur)) return;
    f32x4 acc[2][2][4][2];
#pragma unroll
    for (int a = 0; a < 2; ++a)
#pragma unroll
        for (int b = 0; b < 2; ++b)
#pragma unroll
            for (int m = 0; m < 4; ++m)
#pragma unroll
                for (int n = 0; n < 2; ++n) acc[a][b][m][n] = (f32x4){0.f, 0.f, 0.f, 0.f};
    bf16x8 At[4][2], B0[2][2], B1[2][2];
    const char* cA = (const char*)g.A + cur.aoff; const char* cB = (const char*)g.Bt + cur.boff;
    PG8_STAGE(PG8_SB(0, 0), cB, voffB); PG8_STAGE(PG8_SB(0, 1), cB + hstepB, voffB); PG8_STAGE(PG8_SA(0, 0), cA, voffA); PG8_STAGE(PG8_SA(0, 1), cA + hstepA, voffA);
    if (wr == 1) PG8_BAR;
    PG8_WAIT_V(2); PG8_BAR;
    PG8_STAGE(PG8_SB(1, 0), cB + kstep, voffB); PG8_STAGE(PG8_SA(1, 0), cA + kstep, voffA); PG8_STAGE(PG8_SB(1, 1), cB + hstepB + kstep, voffB);
    PG8_WAIT_V(6); PG8_BAR;
    for (;;) {
        const bool has_next = S.next(ui + 1, nxt);
        const char* nA = has_next ? (const char*)g.A + nxt.aoff : cA; const char* nB = has_next ? (const char*)g.Bt + nxt.boff : cB;
        for (int t = 0; t < nt; t += 2) {
            const bool last = (t == nt - 2);
            const char* a1 = cA + (size_t)(t + 1) * kstep;
            const char* a2 = last ? nA : cA + (size_t)(t + 2) * kstep; const char* b2 = last ? nB : cB + (size_t)(t + 2) * kstep;
            const char* a3 = a2 + kstep; const char* b3 = b2 + kstep;
            PG8_LDB(B0, 0, 0); PG8_LDB(B1, 0, 1); PG8_SCHED; PG8_LDA(At, 0, 0); PG8_STAGE(PG8_SA(1, 1), a1 + hstepA, voffA);
            PG8_WAIT_V(8); PG8_WAIT_L(0); PG8_BAR; PG8_MMA(0, 0, At, B0); PG8_MMA(0, 1, At, B1); PG8_BAR; PG8_SCHED;
            PG8_LDA(At, 0, 1); PG8_STAGE(PG8_SB(0, 0), b2, voffB); PG8_STAGE(PG8_SB(0, 1), b2 + hstepB, voffB); PG8_STAGE(PG8_SA(0, 0), a2, voffA);
            PG8_WAIT_V(8); PG8_WAIT_L(0); PG8_BAR; PG8_MMA(1, 0, At, B0); PG8_MMA(1, 1, At, B1); PG8_BAR; PG8_SCHED;
            PG8_LDB(B0, 1, 0); PG8_LDB(B1, 1, 1); PG8_SCHED; PG8_LDA(At, 1, 0); PG8_STAGE(PG8_SA(0, 1), a2 + hstepA, voffA);
            PG8_WAIT_V(8); PG8_WAIT_L(0); PG8_BAR; PG8_MMA(0, 0, At, B0); PG8_MMA(0, 1, At, B1); PG8_BAR; PG8_SCHED;
            PG8_LDA(At, 1, 1); PG8_STAGE(PG8_SB(1, 0), b3, voffB); PG8_STAGE(PG8_SB(1, 1), b3 + hstepB, voffB); PG8_STAGE(PG8_SA(1, 0), a3, voffA);
            PG8_WAIT_V(8); PG8_WAIT_L(0); PG8_BAR; PG8_MMA(1, 0, At, B0); PG8_MMA(1, 1, At, B1); PG8_BAR; PG8_SCHED;
        }
        if (wr == 0) PG8_BAR;
        { int t2 = threadIdx.x; asm volatile("" : "+v"(t2)); const int fr2 = t2 & 15, fq2 = (t2 >> 4) & 3;
          E(acc, cur, wr, wc, fr2, fq2); }
        if (!has_next) break;
#pragma unroll
        for (int a = 0; a < 2; ++a)
#pragma unroll
            for (int b = 0; b < 2; ++b)
#pragma unroll
                for (int m = 0; m < 4; ++m)
#pragma unroll
                    for (int n = 0; n < 2; ++n) acc[a][b][m][n] = (f32x4){0.f, 0.f, 0.f, 0.f};
        cur = nxt; cA = nA; cB = nB; ++ui;
        if (wr == 1) PG8_BAR;
    }
    PG8_WAIT_V(0);
    PG8_BAR;
#undef PG8_SA
#undef PG8_SB
#undef PG8_STAGE
#undef PG8_LDA
#undef PG8_LDB
#undef PG8_MMA
#undef PG8_WAIT_V
#undef PG8_WAIT_L
#undef PG8_BAR
#undef PG8_SCHED
}

struct SchedStd {
    int nM, nN, G, c, lda, ldb, ldc;
    __device__ __forceinline__ bool next(int i, Unit& u) const {
        const int L = i * G + c; if (L >= nM * nN) return false;
        swz_order(L, nM, nN, u.pm, u.pn);
        u.aoff = (size_t)u.pm * BM * lda * 2; u.boff = (size_t)u.pn * BM * ldb * 2; u.coff = (size_t)u.pm * BM * ldc + (size_t)u.pn * BM; return true;
    }
};
struct SchedQKV {
    int G, c;
    __device__ __forceinline__ bool next(int i, Unit& u) const {
        const int L = i * G + c; if (L >= 1536 + 64) return false;
        if (L < 1536) swz_order(L, 64, 24, u.pm, u.pn); else { const int l2 = L - 1536; u.pm = 64 + (l2 & 3); u.pn = 8 + (l2 >> 2); }
        u.aoff = (size_t)u.pm * BM * D * 2; u.boff = (size_t)u.pn * BM * D * 2; u.coff = 0; return true;
    }
};
struct SchedInT {
    int G, c;
    __device__ __forceinline__ bool next(int i, Unit& u) const {
        const int L = i * G + c; if (L >= 512) return false;
        swz_order(L, 8, 64, u.pm, u.pn);
        u.aoff = (size_t)u.pm * BM * D * 2; u.boff = (size_t)u.pn * BM * D * 2;
        u.coff = ((size_t)((u.pn >> 4) * D + u.pm * BM)) * SEQ + (u.pn & 15) * BM; return true;
    }
};
struct SchedCols {
    int G, c, nU, ldb;
    __device__ __forceinline__ bool next(int i, Unit& u) const {
        const int L = i * G + c; if (L >= nU) return false;
        size_t z = 0; asm volatile("" : "+s"(z));
        u.pm = 0; u.pn = L; u.aoff = z; u.boff = (size_t)L * BM * ldb * 2; u.coff = 0; return true;
    }
};
struct SchedChan {
    int G, c;
    __device__ __forceinline__ bool next(int i, Unit& u) const {
        const int L = i * G + c; if (L >= 512) return false;
        u.pm = L >> 3; u.pn = L & 7;
        size_t z = 0; asm volatile("" : "+s"(z));
        u.aoff = ((size_t)u.pm * BM * 4096 + u.pn * 512) * 2; u.boff = z; u.coff = (size_t)u.pm * BM * D + u.pn * BM; return true;
    }
};

struct SchedPanel {
    int c, lda, ldb;
    __device__ __forceinline__ bool next(int i, Unit& u) const {
        if (i >= 2) return false;
        const int xcd = c & 7, j = c >> 3;
        u.pm = i * 32 + xcd * 4 + (j >> 3); u.pn = j & 7;
        u.aoff = (size_t)u.pm * BM * lda * 2; u.boff = (size_t)u.pn * BM * ldb * 2; u.coff = 0; return true;
    }
};

struct EpiPlain {
    bf16_t* O; int ldc;
    __device__ __forceinline__ void operator()(const f32x4 (&acc)[2][2][4][2], const Unit& u, int wr, int wc, int fr, int fq) const {
        bf16_t* base = O + u.coff + (size_t)(wr * 64 + fr) * ldc + wc * 32 + 8 * fq;
#pragma unroll
        for (int ai = 0; ai < 2; ++ai)
#pragma unroll
            for (int m = 0; m < 4; ++m) { bf16_t* rowp = base + (size_t)(ai * HALF + m * 16) * ldc;
#pragma unroll
                for (int bj = 0; bj < 2; ++bj) { const f32x4 v0 = acc[ai][bj][m][0], v1 = acc[ai][bj][m][1];
                    u32x4 w; w.x = cvt_pk_bf16(v0[0], v0[1]); w.y = cvt_pk_bf16(v0[2], v0[3]); w.z = cvt_pk_bf16(v1[0], v1[1]); w.w = cvt_pk_bf16(v1[2], v1[3]);
                    *(u32x4*)(rowp + bj * HALF) = w; } }
    }
};
struct EpiSwiGLU {
    bf16_t* O;
    __device__ __forceinline__ void operator()(const f32x4 (&acc)[2][2][4][2], const Unit& u, int wr, int wc, int fr, int fq) const {
        bf16_t* base = O + (size_t)(u.pm * BM + wr * 64 + fr) * FF + u.pn * 128 + wc * 32 + 8 * fq;
#pragma unroll
        for (int ai = 0; ai < 2; ++ai)
#pragma unroll
            for (int m = 0; m < 4; ++m) { bf16_t* rowp = base + (size_t)(ai * HALF + m * 16) * FF;
                float o[8];
#pragma unroll
                for (int n = 0; n < 2; ++n)
#pragma unroll
                    for (int j = 0; j < 4; ++j) { const float gv = acc[ai][0][m][n][j], uv = acc[ai][1][m][n][j];
                        o[n * 4 + j] = gv * uv * __builtin_amdgcn_rcpf(1.f + __builtin_amdgcn_exp2f(-1.4426950408889634f * gv)); }
                u32x4 w; w.x = cvt_pk_bf16(o[0], o[1]); w.y = cvt_pk_bf16(o[2], o[3]); w.z = cvt_pk_bf16(o[4], o[5]); w.w = cvt_pk_bf16(o[6], o[7]);
                *(u32x4*)rowp = w; }
    }
};
struct EpiFft1 {
    bf16_t* A2; const f32x2* tw;
    __device__ __forceinline__ void operator()(const f32x4 (&acc)[2][2][4][2], const Unit& u, int wr, int wc, int fr, int fq) const {
#pragma unroll
        for (int bj = 0; bj < 2; ++bj) { const int gcol = u.pn * 8 + 4 * bj + wc, b = gcol >> 11, col = gcol & 2047;
#pragma unroll
            for (int m = 0; m < 4; ++m) { const int k1 = 16 * m + fr; float re[8], im[8];
#pragma unroll
                for (int n = 0; n < 2; ++n)
#pragma unroll
                    for (int j = 0; j < 4; ++j) { const int r = 2 * (8 * fq + 4 * n + j) + wr; const f32x2 t = tw[k1 * r];
                        const float ar = acc[0][bj][m][n][j], ai = acc[1][bj][m][n][j];
                        re[n * 4 + j] = ar * t.x + ai * t.y; im[n * 4 + j] = ai * t.x - ar * t.y; }
                bf16_t* dst = A2 + (((size_t)(b * 32 + (k1 >> 1)) * D + col) * 256) + (k1 & 1) * 128 + wr * 32 + 8 * fq;
                u32x4 w; w.x = cvt_pk_bf16(re[0], re[1]); w.y = cvt_pk_bf16(re[2], re[3]); w.z = cvt_pk_bf16(re[4], re[5]); w.w = cvt_pk_bf16(re[6], re[7]);
                *(u32x4*)dst = w;
                w.x = cvt_pk_bf16(im[0], im[1]); w.y = cvt_pk_bf16(im[2], im[3]); w.z = cvt_pk_bf16(im[4], im[5]); w.w = cvt_pk_bf16(im[6], im[7]);
                *(u32x4*)(dst + 64) = w; } }
    }
};
struct EpiFft2 {
    bf16_t* X;
    __device__ __forceinline__ void operator()(const f32x4 (&acc)[2][2][4][2], const Unit& u, int wr, int wc, int fr, int fq) const {
        const int bk = u.pn >> 3, b = bk >> 5, k1p = bk & 31, gq = u.pn & 7;
#pragma unroll
        for (int ai = 0; ai < 2; ++ai)
#pragma unroll
            for (int m = 0; m < 4; ++m) { const int k2 = 16 * m + fr, tok = b * SEQ + 2 * k1p + ai + 64 * k2;
                bf16_t* rowp = X + (size_t)tok * 4096 + gq * 512 + wr * 256 + wc * 32 + 8 * fq;
#pragma unroll
                for (int bj = 0; bj < 2; ++bj) { const f32x4 v0 = acc[ai][bj][m][0], v1 = acc[ai][bj][m][1];
                    u32x4 w; w.x = cvt_pk_bf16(v0[0], v0[1]); w.y = cvt_pk_bf16(v0[2], v0[3]); w.z = cvt_pk_bf16(v1[0], v1[1]); w.w = cvt_pk_bf16(v1[2], v1[3]);
                    *(u32x4*)(rowp + bj * HALF) = w; } }
    }
};
struct RowExchange {
    unsigned long long* slots; unsigned tag; unsigned* tmo;
    __device__ __forceinline__ void run(const float (&ssl)[2][4], const Unit& u, int wr, int wc, int fr, int fq, LAS unsigned char* xl, int wid, int lane) const {
        LAS float* P = (LAS float*)xl;
        LAS float* S = (LAS float*)(xl + 4096);
#pragma unroll
        for (int ai = 0; ai < 2; ++ai)
#pragma unroll
            for (int m = 0; m < 4; ++m) { float v = ssl[ai][m]; v += __shfl_xor(v, 16); v += __shfl_xor(v, 32);
                if (fq == 0) P[(ai * HALF + wr * 64 + m * 16 + fr) * 4 + wc] = v; }
        asm volatile("s_waitcnt lgkmcnt(0)" ::: "memory"); __builtin_amdgcn_s_barrier(); asm volatile("" ::: "memory");
        const int row = wid * 32 + (lane & 31), half = lane >> 5;
        unsigned long long* sl = slots + (size_t)(u.pm * BM + row) * 8;
        if (lane < 32) { const float tot = (P[row * 4 + 0] + P[row * 4 + 1]) + (P[row * 4 + 2] + P[row * 4 + 3]);
            __hip_atomic_store(sl + u.pn, ((unsigned long long)tag << 32) | __float_as_uint(tot), __ATOMIC_RELAXED, __HIP_MEMORY_SCOPE_AGENT); }
        float t = 0.f; unsigned spins = 0u;
        for (;;) {
            const unsigned long long w0 = __hip_atomic_load(sl + 4 * half + 0, __ATOMIC_RELAXED, __HIP_MEMORY_SCOPE_AGENT), w1 = __hip_atomic_load(sl + 4 * half + 1, __ATOMIC_RELAXED, __HIP_MEMORY_SCOPE_AGENT);
            const unsigned long long w2 = __hip_atomic_load(sl + 4 * half + 2, __ATOMIC_RELAXED, __HIP_MEMORY_SCOPE_AGENT), w3 = __hip_atomic_load(sl + 4 * half + 3, __ATOMIC_RELAXED, __HIP_MEMORY_SCOPE_AGENT);
            const bool ok = ((unsigned)(w0 >> 32) == tag) & ((unsigned)(w1 >> 32) == tag) & ((unsigned)(w2 >> 32) == tag) & ((unsigned)(w3 >> 32) == tag);
            t = (__uint_as_float((unsigned)w0) + __uint_as_float((unsigned)w1)) + (__uint_as_float((unsigned)w2) + __uint_as_float((unsigned)w3));
            if (__all(ok)) break;
            if (++spins > (1u << 16)) { if (lane == 0) __hip_atomic_store(tmo, 1u, __ATOMIC_RELAXED, __HIP_MEMORY_SCOPE_AGENT); break; }
            __builtin_amdgcn_s_sleep(1);
        }
        t += __shfl_xor(t, 32);
        if (lane < 32) S[row] = __builtin_amdgcn_rsqf(t * (1.f / D) + RMS_EPS);
        asm volatile("s_waitcnt lgkmcnt(0)" ::: "memory"); __builtin_amdgcn_s_barrier(); asm volatile("" ::: "memory");
    }
};
template <bool XIN_BF, bool HAS_H, bool OUT_F32>
struct EpiNormRes {
    const void* xin; bf16_t* xr; float* outf;
    const float* gate; const float* gy;
    bf16_t* hb; const float* gh; const float* sh; const float* sc; bool perm;
    RowExchange e1, e2; LAS unsigned char* xl;
    __device__ __forceinline__ void operator()(f32x4 (&acc)[2][2][4][2], const Unit& u, int wr, int wc, int fr, int fq) const {
        int t2 = threadIdx.x; asm volatile("" : "+v"(t2)); const int wid = __builtin_amdgcn_readfirstlane(t2 >> 6), lane = t2 & 63;
        const int b = u.pm >> 4, col0 = u.pn * BM + wc * 32 + 8 * fq;
        const LAS float* S = (const LAS float*)(xl + 4096);
        float ssl[2][4];
#pragma unroll
        for (int ai = 0; ai < 2; ++ai)
#pragma unroll
            for (int m = 0; m < 4; ++m) { float q = 0.f;
#pragma unroll
                for (int bj = 0; bj < 2; ++bj)
#pragma unroll
                    for (int n = 0; n < 2; ++n) { const f32x4 v = acc[ai][bj][m][n]; q += (v[0] * v[0] + v[1] * v[1]) + (v[2] * v[2] + v[3] * v[3]); }
                ssl[ai][m] = q; }
        u32x4 xb[2][4][2]; f32x4 xf[4][2][2];
        const size_t offb = (size_t)(u.pm * BM + wr * 64 + fr) * D + col0;
        if (XIN_BF) {
#pragma unroll
            for (int ai = 0; ai < 2; ++ai)
#pragma unroll
                for (int m = 0; m < 4; ++m)
#pragma unroll
                    for (int bj = 0; bj < 2; ++bj) xb[ai][m][bj] = *(const u32x4*)((const bf16_t*)xin + offb + (size_t)(ai * HALF + m * 16) * D + bj * HALF);
        } else {
#pragma unroll
            for (int m = 0; m < 4; ++m)
#pragma unroll
                for (int bj = 0; bj < 2; ++bj) { xf[m][bj][0] = *(const f32x4*)((const float*)xin + offb + (size_t)(m * 16) * D + bj * HALF); xf[m][bj][1] = *(const f32x4*)((const float*)xin + offb + (size_t)(m * 16) * D + bj * HALF + 4); }
        }
        e1.run(ssl, u, wr, wc, fr, fq, xl, wid, lane);
        f32x4 pa[2][2];
#pragma unroll
        for (int bj = 0; bj < 2; ++bj)
#pragma unroll
            for (int n = 0; n < 2; ++n) { const int c = col0 + bj * HALF + 4 * n; pa[bj][n] = *(const f32x4*)(gate + (size_t)b * 6 * D + c) * *(const f32x4*)(gy + c); }
#pragma unroll
        for (int ai = 0; ai < 2; ++ai) {
#pragma unroll
            for (int m = 0; m < 4; ++m) { const int r = ai * HALF + wr * 64 + m * 16 + fr; const float ry = S[r]; const size_t off = (size_t)(u.pm * BM + r) * D + col0; float q = 0.f;
#pragma unroll
                for (int bj = 0; bj < 2; ++bj) {
                    f32x4 x0, x1;
                    if (XIN_BF) { const u32x4 w = xb[ai][m][bj]; x0 = (f32x4){bflo(w.x), bfhi(w.x), bflo(w.y), bfhi(w.y)}; x1 = (f32x4){bflo(w.z), bfhi(w.z), bflo(w.w), bfhi(w.w)}; }
                    else { x0 = xf[m][bj][0]; x1 = xf[m][bj][1]; }
                    f32x4 v0 = x0 + pa[bj][0] * (acc[ai][bj][m][0] * ry), v1 = x1 + pa[bj][1] * (acc[ai][bj][m][1] * ry);
                    if (OUT_F32) { *(f32x4*)(outf + off + bj * HALF) = v0; *(f32x4*)(outf + off + bj * HALF + 4) = v1; }
                    else { u32x4 w; w.x = cvt_pk_bf16(v0[0], v0[1]); w.y = cvt_pk_bf16(v0[2], v0[3]); w.z = cvt_pk_bf16(v1[0], v1[1]); w.w = cvt_pk_bf16(v1[2], v1[3]);
                        *(u32x4*)(xr + off + bj * HALF) = w;
                        v0 = (f32x4){bflo(w.x), bfhi(w.x), bflo(w.y), bfhi(w.y)}; v1 = (f32x4){bflo(w.z), bfhi(w.z), bflo(w.w), bfhi(w.w)};
                        q += ((v0[0] * v0[0] + v0[1] * v0[1]) + (v0[2] * v0[2] + v0[3] * v0[3])) + ((v1[0] * v1[0] + v1[1] * v1[1]) + (v1[2] * v1[2] + v1[3] * v1[3]));
                        acc[ai][bj][m][0] = v0; acc[ai][bj][m][1] = v1; } }
                ssl[ai][m] = q; }
            if (!XIN_BF && ai == 0) {
#pragma unroll
                for (int m = 0; m < 4; ++m)
#pragma unroll
                    for (int bj = 0; bj < 2; ++bj) { xf[m][bj][0] = *(const f32x4*)((const float*)xin + offb + (size_t)(HALF + m * 16) * D + bj * HALF); xf[m][bj][1] = *(const f32x4*)((const float*)xin + offb + (size_t)(HALF + m * 16) * D + bj * HALF + 4); }
            }
        }
        if (HAS_H) {
            e2.run(ssl, u, wr, wc, fr, fq, xl, wid, lane);
            f32x4 pb[2][2], pc[2][2];
#pragma unroll
            for (int bj = 0; bj < 2; ++bj)
#pragma unroll
                for (int n = 0; n < 2; ++n) { const int c = col0 + bj * HALF + 4 * n; pb[bj][n] = *(const f32x4*)(gh + c) * (*(const f32x4*)(sc + (size_t)b * 6 * D + c) + 1.f); pc[bj][n] = *(const f32x4*)(sh + (size_t)b * 6 * D + c); }
#pragma unroll
            for (int ai = 0; ai < 2; ++ai)
#pragma unroll
                for (int m = 0; m < 4; ++m) { const int r = ai * HALF + wr * 64 + m * 16 + fr; const float r1 = S[r];
                    const int tok = (u.pm & 15) * BM + r; const size_t hrow = (size_t)b * SEQ + (perm ? (tok & 63) * 64 + (tok >> 6) : tok);
#pragma unroll
                    for (int bj = 0; bj < 2; ++bj) { const f32x4 h0 = acc[ai][bj][m][0] * r1 * pb[bj][0] + pc[bj][0], h1 = acc[ai][bj][m][1] * r1 * pb[bj][1] + pc[bj][1];
                        u32x4 w; w.x = cvt_pk_bf16(h0[0], h0[1]); w.y = cvt_pk_bf16(h0[2], h0[3]); w.z = cvt_pk_bf16(h1[0], h1[1]); w.w = cvt_pk_bf16(h1[2], h1[3]);
                        *(u32x4*)(hb + hrow * D + col0 + bj * HALF) = w; } }
        }
    }
};
struct EpiQKV {
    bf16_t *Q, *K, *V; const float* rope;
    __device__ __forceinline__ void operator()(const f32x4 (&acc)[2][2][4][2], const Unit& u, int wr, int wc, int fr, int fq) const {
        const int sec = u.pn >> 3, h0 = (u.pn & 7) * 2;
        const bool latent = u.pm < 64;
        const int b = latent ? (u.pm >> 4) : (u.pm - 64);
        const int tok0 = (latent ? (u.pm & 15) * 256 : SEQ) + wr * 64 + fr;
        const int cm = wc >> 1, axis = wc & 1;
#pragma unroll
        for (int ai = 0; ai < 2; ++ai)
#pragma unroll
            for (int m = 0; m < 4; ++m) {
                const int tok = tok0 + ai * HALF + m * 16;
                f32x4 c4 = {1.f, 1.f, 1.f, 1.f}, s4 = {0.f, 0.f, 0.f, 0.f};
                if (sec < 2 && latent) { const int pos = axis ? (tok & 63) : (tok >> 6); c4 = *(const f32x4*)(rope + pos * 16 + 4 * fq); s4 = *(const f32x4*)(rope + 1024 + pos * 16 + 4 * fq); }
#pragma unroll
                for (int bj = 0; bj < 2; ++bj) {
                    const int h = h0 + bj;
                    f32x4 v0 = acc[ai][bj][m][0], v1 = acc[ai][bj][m][1];
                    bf16_t* dst;
                    if (sec < 2) {
                        const f32x4 a = v0 * c4 - v1 * s4, bb = v1 * c4 + v0 * s4; v0 = a; v1 = bb;
                        if (sec == 0) { v0 = v0 * QSCALE; v1 = v1 * QSCALE; dst = Q + ((size_t)(((b * NH + h) * 2 + cm) * SEQ + tok)) * HD + axis * 32 + 8 * fq; }
                        else dst = K + ((size_t)(((b * NH + h) * 2 + cm) * SK + tok)) * HD + axis * 32 + 8 * fq;
                    } else dst = V + ((size_t)((b * NH + h) * SK + tok)) * VD + wc * 32 + 8 * fq;
                    u32x4 w; w.x = cvt_pk_bf16(v0[0], v0[1]); w.y = cvt_pk_bf16(v0[2], v0[3]); w.z = cvt_pk_bf16(v1[0], v1[1]); w.w = cvt_pk_bf16(v1[2], v1[3]);
                    *(u32x4*)dst = w;
                }
            }
    }
};
}

namespace att {
constexpr int NT = SK / 64;
constexpr int PD = 3, NS = PD + 1;
constexpr int KSL = 16384, VSL = 16384;
constexpr int KR = 0, VR = NS * KSL;
constexpr int XCH = 0, OST = 65536, SUBG = 132 * 1024, LAMO = SUBG + 512;
static_assert(VR + NS * VSL <= SUBG, "attention rings overlap the constants");
constexpr float THR = 8.f;
__device__ __forceinline__ float xmax(float v) { auto rr = __builtin_amdgcn_permlane32_swap(__float_as_uint(v), __float_as_uint(v), false, false); return fmaxf(__uint_as_float(rr[0]), __uint_as_float(rr[1])); }
__device__ __forceinline__ float xsum(float v) { auto rr = __builtin_amdgcn_permlane32_swap(__float_as_uint(v), __float_as_uint(v), false, false); return __uint_as_float(rr[0]) + __uint_as_float(rr[1]); }
#define MX3(a, b, c) __builtin_fmaxf(__builtin_fmaxf((a), (b)), (c))
__device__ __forceinline__ float fadd_s(float a, float b) { float r; asm("v_add_f32_e32 %0, %1, %2" : "=v"(r) : "v"(a), "v"(b)); return r; }

__device__ __forceinline__ void attn_unit(int b, int h, int qb, const bf16_t* Q, const bf16_t* K, const bf16_t* V, bf16_t* O, LAS unsigned char* lds) {
    int tid = threadIdx.x; asm volatile("" : "+v"(tid));
    const int lane = tid & 63, r32 = lane & 31, hi = lane >> 5; const int wid = __builtin_amdgcn_readfirstlane(tid >> 6);
    const int cm = wid >> 2, wq = wid & 3;
    const bf16_t* Qp = Q + ((size_t)(((b * NH + h) * 2 + cm) * SEQ + qb * 128 + wq * 32 + r32)) * HD + hi * 8;
    const int kkey = tid >> 3;
    const bf16_t* K0g = K + ((size_t)((b * NH + h) * 2) * SK) * HD + (size_t)kkey * HD + (((tid & 7) ^ ((kkey >> 1) & 7)) * 8);
    const bf16_t* K1g = K0g + (size_t)SK * HD;
    const bf16_t* Vg0 = V + (size_t)((b * NH + h) * SK) * VD + (size_t)((((tid >> 6) & 3) * 16) + ((tid >> 2) & 15)) * VD + (tid >> 8) * 32 + (tid & 3) * 8;
    const bf16_t* Vg1 = Vg0 + 64;
    const unsigned wbase = (unsigned)wid * 1024u;
    const unsigned lds_base = (unsigned)(size_t)lds;
    const int toff = (qb * 17) % NT;
#define GLDS16(gsrc, ldsoff) do { unsigned keep_; const unsigned dst_ = (unsigned)__builtin_amdgcn_readfirstlane((int)(lds_base + (ldsoff))); \
        asm volatile("s_mov_b32 %0, m0\n\ts_mov_b32 m0, %2\n\ts_nop 0\n\tglobal_load_lds_dwordx4 %1, off\n\ts_mov_b32 m0, %0" : "=&s"(keep_) : "v"(gsrc), "s"(dst_) : "memory"); } while (0)
#define ATT_TILE(t) ({ int tt_ = (t) + toff; if (tt_ >= NT) tt_ -= NT; if (tt_ >= NT) tt_ -= NT; tt_; })
#define ATT_DMAK(t, sl) do { const size_t ko_ = (size_t)ATT_TILE(t) * 64 * HD; \
        GLDS16(K0g + ko_, KR + (sl) * KSL + wbase); GLDS16(K1g + ko_, KR + (sl) * KSL + 8192 + wbase); } while (0)
#define ATT_DMAV(t, sl) do { const size_t vo_ = (size_t)ATT_TILE(t) * 64 * VD; \
        GLDS16(Vg0 + vo_, VR + (sl) * VSL + wbase); GLDS16(Vg1 + vo_, VR + (sl) * VSL + 8192 + wbase); } while (0)
#define ATT_WAITBAR(N) do { asm volatile("s_waitcnt vmcnt(%0)" :: "n"(N) : "memory"); __builtin_amdgcn_s_barrier(); } while (0)
    static_assert(PD == 3, "the DMA schedule below is written for PD = 3 (4-slot rings)");
    ATT_DMAK(0, 0); ATT_DMAK(1, 1); ATT_DMAK(2, 2); ATT_DMAK(3, 3); ATT_DMAV(0, 0); ATT_DMAV(1, 1);
    bf16x8 qr[4];
#pragma unroll
    for (int d0 = 0; d0 < 4; ++d0) qr[d0] = *(const bf16x8*)(Qp + d0 * 16);
    f32x16 o[4];
#pragma unroll
    for (int e = 0; e < 4; ++e) o[e] = (f32x16){};
    float mrun, lsum = 0.f;
    int kro4[4];
#pragma unroll
    for (int d0 = 0; d0 < 4; ++d0) kro4[d0] = cm * 8192 + r32 * 128 + (((2 * d0 + hi) ^ ((r32 >> 1) & 7)) * 16);
    const int vro = VR + ((lane >> 4) & 1) * 32 + (lane & 3) * 8 + (4 * hi + ((lane & 15) >> 2)) * 64;
#define ATT_QK(P0, P1, so) do { P0 = (f32x16){}; P1 = (f32x16){}; _Pragma("unroll") for (int d0 = 0; d0 < 4; ++d0) { \
        const bf16x8 k0_ = *(const LAS bf16x8*)(lds + (so) + kro4[d0]); const bf16x8 k1_ = *(const LAS bf16x8*)(lds + (so) + kro4[d0] + 4096); \
        P0 = __builtin_amdgcn_mfma_f32_32x32x16_bf16(k0_, qr[d0], P0, 0, 0, 0); P1 = __builtin_amdgcn_mfma_f32_32x32x16_bf16(k1_, qr[d0], P1, 0, 0, 0); } } while (0)
    f32x16 pA0, pA1, pB0, pB1;
    ATT_WAITBAR(10);
    ATT_QK(pA0, pA1, KR);
    { float a_ = -1e30f;
#pragma unroll
      for (int j = 0; j < 16; ++j) a_ = MX3(a_, pA0[j], pA1[j]);
      mrun = xmax(a_);
#pragma unroll
      for (int j = 0; j < 16; ++j) { pA0[j] = __builtin_amdgcn_exp2f(pA0[j] - mrun); pA1[j] = __builtin_amdgcn_exp2f(pA1[j] - mrun); lsum += pA0[j] + pA1[j]; } }
    f32x16 negm;
#pragma unroll
    for (int j = 0; j < 16; ++j) negm[j] = -mrun;
    ATT_WAITBAR(0);
    bf16x8 kf[8];
#pragma unroll
    for (int d0 = 0; d0 < 4; ++d0) { kf[2 * d0] = *(const LAS bf16x8*)(lds + KR + 1 * KSL + kro4[d0]); kf[2 * d0 + 1] = *(const LAS bf16x8*)(lds + KR + 1 * KSL + kro4[d0] + 4096); }
    asm volatile("s_waitcnt lgkmcnt(0)" ::: "memory"); __builtin_amdgcn_s_barrier();
    int sl0 = 0, sl1 = 1;
#define SBAR() __builtin_amdgcn_sched_barrier(0)
#define VTR(ks, eb, half) __builtin_bit_cast(s16x4, __builtin_amdgcn_ds_read_tr16_b64_v4i16((LAS s16x4*)(lds + sl0 * VSL + vro + (eb) * 4096 + (ks) * 1024 + (half) * 512)))
#define ATT_STEP(P0, P1, N0, N1, t, FIRST) do { \
        if (FIRST) { ATT_DMAK((t) + 4, sl0); ATT_DMAK((t) + 5, sl1); ATT_DMAV((t) + 2, (sl1 == NS - 1 ? 0 : sl1 + 1)); ATT_DMAV((t) + 3, (sl0 == 0 ? NS - 1 : sl0 - 1)); } \
        const int sl2_ = (sl1 == NS - 1) ? 0 : sl1 + 1; \
        s16x4 vl_[4][4], vh_[4][4]; \
        _Pragma("unroll") for (int eb = 0; eb < 4; ++eb) { vl_[0][eb] = VTR(0, eb, 0); vh_[0][eb] = VTR(0, eb, 1); } \
        SBAR(); \
        unsigned w0_[8], w1_[8]; float lsb_ = 0.f; \
        _Pragma("unroll") for (int i = 0; i < 8; ++i) { \
            if (i == 0)            N0 = __builtin_amdgcn_mfma_f32_32x32x16_bf16(kf[i], qr[i >> 1], negm, 0, 0, 0); \
            else if (i == 1)       N1 = __builtin_amdgcn_mfma_f32_32x32x16_bf16(kf[i], qr[i >> 1], negm, 0, 0, 0); \
            else if ((i & 1) == 0) N0 = __builtin_amdgcn_mfma_f32_32x32x16_bf16(kf[i], qr[i >> 1], N0, 0, 0, 0); \
            else                   N1 = __builtin_amdgcn_mfma_f32_32x32x16_bf16(kf[i], qr[i >> 1], N1, 0, 0, 0); \
            if ((t) > 0) lsb_ = fadd_s(fadd_s(lsb_, P1[2 * i]), P1[2 * i + 1]); \
            w0_[i] = cvt_pk_bf16(P0[2 * i], P0[2 * i + 1]); w1_[i] = cvt_pk_bf16(P1[2 * i], P1[2 * i + 1]); \
            SBAR(); } \
        lsum += lsb_; \
        bf16x8 pa_[4]; \
        pa_[0] = __builtin_bit_cast(bf16x8, (u32x4){w0_[0], w0_[1], w0_[2], w0_[3]}); pa_[1] = __builtin_bit_cast(bf16x8, (u32x4){w0_[4], w0_[5], w0_[6], w0_[7]}); \
        pa_[2] = __builtin_bit_cast(bf16x8, (u32x4){w1_[0], w1_[1], w1_[2], w1_[3]}); pa_[3] = __builtin_bit_cast(bf16x8, (u32x4){w1_[4], w1_[5], w1_[6], w1_[7]}); \
        float al_ = 1.f; bool resc_ = false; float mxn_ = -1e30f, lsa_ = 0.f; \
        _Pragma("unroll") for (int ks = 0; ks < 4; ++ks) { \
            _Pragma("unroll") for (int eb = 0; eb < 4; ++eb) { \
                const bf16x8 vf_ = (bf16x8){vl_[ks][eb][0], vl_[ks][eb][1], vl_[ks][eb][2], vl_[ks][eb][3], vh_[ks][eb][0], vh_[ks][eb][1], vh_[ks][eb][2], vh_[ks][eb][3]}; \
                o[eb] = __builtin_amdgcn_mfma_f32_32x32x16_bf16(vf_, pa_[ks], o[eb], 0, 0, 0); \
                if (ks < 3) { vl_[ks + 1][eb] = VTR(ks + 1, eb, 0); vh_[ks + 1][eb] = VTR(ks + 1, eb, 1); } \
                if (ks == 0) { _Pragma("unroll") for (int j = 0; j < 4; ++j) mxn_ = MX3(mxn_, N0[eb * 4 + j], N1[eb * 4 + j]); } \
                if (ks == 1 || ks == 2) { const int i_ = (ks - 1) * 4 + eb; \
                    N0[2 * i_] = __builtin_amdgcn_exp2f(N0[2 * i_]); N0[2 * i_ + 1] = __builtin_amdgcn_exp2f(N0[2 * i_ + 1]); \
                    N1[2 * i_] = __builtin_amdgcn_exp2f(N1[2 * i_]); N1[2 * i_ + 1] = __builtin_amdgcn_exp2f(N1[2 * i_ + 1]); } \
                if (ks == 3) { lsa_ = fadd_s(fadd_s(fadd_s(fadd_s(lsa_, N0[4 * eb]), N0[4 * eb + 1]), N0[4 * eb + 2]), N0[4 * eb + 3]); } \
                if (ks == 2) { kf[2 * eb] = *(const LAS bf16x8*)(lds + KR + sl2_ * KSL + kro4[eb]); kf[2 * eb + 1] = *(const LAS bf16x8*)(lds + KR + sl2_ * KSL + kro4[eb] + 4096); } \
                SBAR(); } \
            if (ks == 0) { mxn_ = xmax(mxn_); \
                if ((t) + 1 < NT && __any(mxn_ > THR)) { const float dl_ = fmaxf(mxn_, 0.f); al_ = __builtin_amdgcn_exp2f(-dl_); mrun += dl_; lsum *= al_; resc_ = true; \
                    _Pragma("unroll") for (int j = 0; j < 16; ++j) { N0[j] -= dl_; N1[j] -= dl_; negm[j] = -mrun; } } \
                SBAR(); } } \
        if (resc_) { _Pragma("unroll") for (int e = 0; e < 4; ++e) _Pragma("unroll") for (int i = 0; i < 16; ++i) o[e][i] *= al_; } \
        if ((t) + 1 < NT) lsum += lsa_;               \
        SBAR(); \
        if (!(FIRST)) { asm volatile("s_waitcnt vmcnt(0) lgkmcnt(0)" ::: "memory"); __builtin_amdgcn_s_barrier(); } \
        SBAR(); \
        sl0 = sl1; sl1 = sl2_; \
    } while (0)
    if (cm == 1) __builtin_amdgcn_s_setprio(1);
    for (int t = 0; t < NT; t += 2) {
        ATT_STEP(pA0, pA1, pB0, pB1, t, true);
        ATT_STEP(pB0, pB1, pA0, pA1, t + 1, false);
    }
    __builtin_amdgcn_s_setprio(0);
    asm volatile("s_waitcnt vmcnt(0)" ::: "memory"); __builtin_amdgcn_s_barrier();
#undef SBAR
#undef VTR
#undef ATT_STEP
#undef ATT_QK
#undef ATT_DMAK
#undef ATT_TILE
#undef GLDS16
#undef ATT_DMAV
#undef ATT_WAITBAR
    const float linv = 1.f / xsum(lsum);
    LAS float* xch = (LAS float*)(lds + XCH) + wq * 64 * 64 + lane;
    if (cm == 1) {
#pragma unroll
        for (int e = 0; e < 4; ++e)
#pragma unroll
            for (int i = 0; i < 16; ++i) xch[(e * 16 + i) * 64] = o[e][i] * linv;
    }
    __syncthreads();
    if (cm == 0) {
        const float lam = *(const LAS float*)(lds + LAMO);
        float ss = 0.f;
#pragma unroll
        for (int e = 0; e < 4; ++e)
#pragma unroll
            for (int i = 0; i < 16; ++i) { const float v = o[e][i] * linv - lam * xch[(e * 16 + i) * 64]; o[e][i] = v; ss += v * v; }
        ss = xsum(ss);
        const float rn = __builtin_amdgcn_rsqf(ss * (1.f / VD) + RMS_EPS);
        const LAS float* sg = (const LAS float*)(lds + SUBG);
        LAS unsigned char* stg = lds + OST + wq * (32 * 272);
#pragma unroll
        for (int e = 0; e < 4; ++e)
#pragma unroll
            for (int i4 = 0; i4 < 4; ++i4) { const int e0 = 32 * e + 8 * i4 + 4 * hi;
                const f32x4 g4 = *(const LAS f32x4*)(sg + e0);
                u32x2 w; w.x = cvt_pk_bf16(o[e][4 * i4] * rn * g4[0], o[e][4 * i4 + 1] * rn * g4[1]); w.y = cvt_pk_bf16(o[e][4 * i4 + 2] * rn * g4[2], o[e][4 * i4 + 3] * rn * g4[3]);
                *(LAS u32x2*)(stg + r32 * 272 + e0 * 2) = w; }
        asm volatile("s_waitcnt lgkmcnt(0)" ::: "memory");
        bf16_t* Ow = O + ((size_t)(b * SEQ + qb * 128 + wq * 32)) * D + h * VD;
#pragma unroll
        for (int it = 0; it < 8; ++it) { const int id = it * 64 + lane, row = id >> 4, ch = id & 15;
            const u32x4 v = *(const LAS u32x4*)(stg + row * 272 + ch * 16);
            *(u32x4*)(Ow + (size_t)row * D + ch * 8) = v; }
    }
    __syncthreads();
}
}

#define XB_TMO      128
#define XB_XCNT(j)  (256  + 64 * (j))
#define XB_XSUB(j)  (1280 + 64 * (j))
#define XB_XGEN(j)  (2304 + 64 * (j))
#define XB_TOP      3328
#define XB_TOPGEN   3392
#define XCD_BAR_WORDS 3456
#define XB_SPIN_CAP (1u << 20)
__device__ __forceinline__ unsigned xb_ld(unsigned* p)              { return __hip_atomic_load(p, __ATOMIC_RELAXED, __HIP_MEMORY_SCOPE_AGENT); }
__device__ __forceinline__ unsigned xb_add(unsigned* p, unsigned v) { return __hip_atomic_fetch_add(p, v, __ATOMIC_RELAXED, __HIP_MEMORY_SCOPE_AGENT); }
__device__ __forceinline__ unsigned xb_xcc_id() { return (unsigned)__builtin_amdgcn_s_getreg((3 << 11) | 20) & 0xFu; }
#define XB_SPIN(cond, bar) do { unsigned _sp = 0; while (cond) { __builtin_amdgcn_s_sleep(1); \
    if ((++_sp & 255u) == 0u) { if (xb_ld(&(bar)[XB_TMO])) break; if (_sp > XB_SPIN_CAP) { atomicAdd(&(bar)[XB_TMO], 1u); break; } } } } while (0)
__device__ __forceinline__ void xcd_barrier_complete(unsigned* bar, unsigned x, unsigned& nloc, unsigned& nx) {
    const unsigned G = gridDim.x;
    unsigned sum, cnt, mine, sp = 0u;
    for (;;) {
        sum = 0u; cnt = 0u; mine = 0u;
#pragma unroll
        for (unsigned j = 0; j < 16; ++j) { const unsigned c = xb_ld(&bar[XB_XCNT(j)]); sum += c; cnt += (c > 0u) ? 1u : 0u; mine = (j == x) ? c : mine; }
        if (sum == G) break;
        __builtin_amdgcn_s_sleep(1);
        if ((++sp & 255u) == 0u) { if (xb_ld(&bar[XB_TMO])) break; if (sp > XB_SPIN_CAP) { atomicAdd(&bar[XB_TMO], 1u); break; } }
    }
    nloc = mine > 0u ? mine : 1u; nx = cnt > 0u ? cnt : 1u;
}
__device__ __forceinline__ void xcd_barrier(unsigned* bar, volatile LAS unsigned* st) {
    asm volatile("s_waitcnt vmcnt(0)" ::: "memory");
    __syncthreads();
    if (threadIdx.x == 0) {
        const unsigned x = xb_xcc_id();
        __builtin_amdgcn_s_waitcnt(0);
        unsigned nloc = st[0], nx = st[1];
        if (nloc == 0u) { xcd_barrier_complete(bar, x, nloc, nx); st[0] = nloc; st[1] = nx; }
        const unsigned old = xb_add(&bar[XB_XSUB(x)], 1u);
        const unsigned gen = old / nloc;
        if (old + 1u == (gen + 1u) * nloc) {
            __builtin_amdgcn_fence(__ATOMIC_RELEASE, "agent");
            asm volatile("s_waitcnt vmcnt(0)" ::: "memory");
            const unsigned og = xb_add(&bar[XB_TOP], 1u);
            const unsigned tg = og / nx;
            if (og + 1u == (tg + 1u) * nx) xb_add(&bar[XB_TOPGEN], 1u);
            else XB_SPIN(xb_ld(&bar[XB_TOPGEN]) == tg, bar);
            __builtin_amdgcn_fence(__ATOMIC_ACQUIRE, "agent");
            xb_add(&bar[XB_XGEN(x)], 1u);
            asm volatile("s_waitcnt vmcnt(0)" ::: "memory");
        } else {
            XB_SPIN(xb_ld(&bar[XB_XGEN(x)]) == gen, bar);
            __builtin_amdgcn_fence(__ATOMIC_ACQUIRE, "agent");
            asm volatile("s_waitcnt vmcnt(0)" ::: "memory");
        }
    }
    __syncthreads();
}
constexpr int LDS_BARST = 140 * 1024;

#ifndef PH_MASK
#define PH_MASK 0xFFFFFFu
#endif
#ifndef REP_ATT
#define REP_ATT 1
#endif
#ifndef REP_GU
#define REP_GU 1
#endif
#ifndef REP_SYNC
#define REP_SYNC 0
#endif
#ifndef REP_ROW
#define REP_ROW 1
#endif
#ifndef REP_P0
#define REP_P0 1
#endif
#define PH(k) if constexpr ((PH_MASK >> (k)) & 1u)
struct Args {
    const float *x, *c, *ctx, *c_ctx, *mod_w, *mod_b, *norm_g, *w_gu, *w_dn, *w_qkv, *w_o, *lam, *subg, *w_in, *w_out;
    float* out; unsigned char* ws;
};

__device__ __forceinline__ void transpose_item(const float* W, int K, int Nsrc, int Ndst, bf16_t* WT, int mode, LAS float* scr, int item, int lane) {
    const int nblk = Ndst / 32, kb = item / nblk, nb = item % nblk, k0 = 64 * kb, n0 = 32 * nb, i = lane & 31;
    int src;
    if (mode == 1 && n0 < 4096) src = n0 + ((i >> 2) & 1) * 16 + ((i >> 3) & 3) * 4 + (i & 3);
    else if (mode == 2) { const int tile = n0 >> 8, r0 = n0 & 255; src = (r0 < 128 ? tile * 128 + r0 : FF + tile * 128 + r0 - 128) + i; }
    else src = n0 + i;
#pragma unroll 8
    for (int q = 0; q < 32; ++q) { const int kk = 2 * q + (lane >> 5); scr[kk * 33 + i] = W[(size_t)(k0 + kk) * Nsrc + src]; }
    asm volatile("s_waitcnt lgkmcnt(0)" ::: "memory");
    const int c = lane & 7;
#pragma unroll
    for (int j = 0; j < 4; ++j) { const int n = (lane >> 3) + 8 * j; const LAS float* s = scr + (8 * c) * 33 + n;
        u32x4 o; o.x = cvt_pk_bf16(s[0 * 33], s[1 * 33]); o.y = cvt_pk_bf16(s[2 * 33], s[3 * 33]); o.z = cvt_pk_bf16(s[4 * 33], s[5 * 33]); o.w = cvt_pk_bf16(s[6 * 33], s[7 * 33]);
        *(u32x4*)(WT + (size_t)(n0 + n) * K + k0 + 8 * c) = o; }
    asm volatile("s_waitcnt lgkmcnt(0)" ::: "memory");
}

__device__ __forceinline__ void row_op(int lane, const bf16_t* y, const float* xin, const float* gate, const float* gy, float* xout,
                                       const float* gh, const float* sh, const float* sc, bf16_t* hb) {
    asm volatile("" : "+v"(lane));
    f32x4 v[8];
#pragma unroll
    for (int j = 0; j < 8; ++j) v[j] = *(const f32x4*)(xin + j * 256 + lane * 4);
    if (y) {
        u32x2 yw[8]; float ss = 0.f;
#pragma unroll
        for (int j = 0; j < 8; ++j) { yw[j] = *(const u32x2*)(y + j * 256 + lane * 4);
            const float a = bflo(yw[j].x), b = bfhi(yw[j].x), c = bflo(yw[j].y), d = bfhi(yw[j].y); ss += (a * a + b * b) + (c * c + d * d); }
        const float ry = __builtin_amdgcn_rsqf(wave_sum(ss) * (1.f / D) + RMS_EPS);
#pragma unroll
        for (int j = 0; j < 8; ++j) { const f32x4 g4 = *(const f32x4*)(gate + j * 256 + lane * 4), w4 = *(const f32x4*)(gy + j * 256 + lane * 4);
            const f32x4 yv = {bflo(yw[j].x), bfhi(yw[j].x), bflo(yw[j].y), bfhi(yw[j].y)};
            v[j] = v[j] + g4 * (yv * ry * w4); }
#pragma unroll
        for (int j = 0; j < 8; ++j) *(f32x4*)(xout + j * 256 + lane * 4) = v[j];
    }
    if (hb) {
        float ss = 0.f;
#pragma unroll
        for (int j = 0; j < 8; ++j) ss += (v[j].x * v[j].x + v[j].y * v[j].y) + (v[j].z * v[j].z + v[j].w * v[j].w);
        const float r = __builtin_amdgcn_rsqf(wave_sum(ss) * (1.f / D) + RMS_EPS);
#pragma unroll
        for (int j = 0; j < 8; ++j) { const f32x4 g4 = *(const f32x4*)(gh + j * 256 + lane * 4), s4 = *(const f32x4*)(sh + j * 256 + lane * 4), c4 = *(const f32x4*)(sc + j * 256 + lane * 4);
            const f32x4 hv = v[j] * r * g4 * (c4 + 1.f) + s4;
            u32x2 w; w.x = cvt_pk_bf16(hv.x, hv.y); w.y = cvt_pk_bf16(hv.z, hv.w);
            *(u32x2*)(hb + j * 256 + lane * 4) = w; }
    }
}

template <bool HAS_Y, bool HAS_H, bool XIN_BF = false, bool XOUT_BF = false>
__device__ __forceinline__ void row_phase(int lane, int gw, int NGW, const bf16_t* Y, const void* Xin_, void* Xout_, const float* ada_layer, int cg, const float* gy,
                                          const float* gh, int csh, int csc, bf16_t* Hout, bool perm, const float* ada_mod = nullptr) {
    const float* Xin = (const float*)Xin_; float* Xout = (float*)Xout_; const bf16_t* XinB = (const bf16_t*)Xin_; bf16_t* XoutB = (bf16_t*)Xout_;
    asm volatile("" : "+v"(lane));
    const int b = gw & 3;
    const float* ad = ada_layer + (size_t)b * 6 * D;
    const float* adm = (ada_mod ? ada_mod : ada_layer) + (size_t)b * 6 * D;
    f32x4 pa[8], pb[8], pc[8];
#pragma unroll
    for (int j = 0; j < 8; ++j) { const int c = j * 256 + lane * 4;
        if (HAS_Y) pa[j] = *(const f32x4*)(ad + cg * D + c) * *(const f32x4*)(gy + c);
        if (HAS_H) { pb[j] = *(const f32x4*)(gh + c) * (*(const f32x4*)(adm + csc * D + c) + 1.f); pc[j] = *(const f32x4*)(adm + csh * D + c); } }
    for (int idx = gw; idx < M; idx += NGW) {
        const int t = idx >> 2; const size_t row = (size_t)b * SEQ + t;
        f32x4 v[8];
        if (XIN_BF) {
#pragma unroll
            for (int j = 0; j < 8; ++j) { const u32x2 xw = *(const u32x2*)(XinB + row * D + j * 256 + lane * 4); v[j] = (f32x4){bflo(xw.x), bfhi(xw.x), bflo(xw.y), bfhi(xw.y)}; }
        } else {
#pragma unroll
            for (int j = 0; j < 8; ++j) v[j] = *(const f32x4*)(Xin + row * D + j * 256 + lane * 4);
        }
        if (HAS_Y) {
            u32x2 yw[8]; float ss = 0.f;
#pragma unroll
            for (int j = 0; j < 8; ++j) { yw[j] = *(const u32x2*)(Y + row * D + j * 256 + lane * 4);
                const float a0 = bflo(yw[j].x), a1 = bfhi(yw[j].x), a2 = bflo(yw[j].y), a3 = bfhi(yw[j].y); ss += (a0 * a0 + a1 * a1) + (a2 * a2 + a3 * a3); }
            const float ry = __builtin_amdgcn_rsqf(wave_sum(ss) * (1.f / D) + RMS_EPS);
#pragma unroll
            for (int j = 0; j < 8; ++j) { const f32x4 yv = {bflo(yw[j].x), bfhi(yw[j].x), bflo(yw[j].y), bfhi(yw[j].y)};
                v[j] = v[j] + pa[j] * (yv * ry);
                if (XOUT_BF) { u32x2 w; w.x = cvt_pk_bf16(v[j].x, v[j].y); w.y = cvt_pk_bf16(v[j].z, v[j].w); *(u32x2*)(XoutB + row * D + j * 256 + lane * 4) = w;
                    v[j] = (f32x4){bflo(w.x), bfhi(w.x), bflo(w.y), bfhi(w.y)}; }
                else *(f32x4*)(Xout + row * D + j * 256 + lane * 4) = v[j]; }
        }
        if (HAS_H) {
            float ss = 0.f;
#pragma unroll
            for (int j = 0; j < 8; ++j) ss += (v[j].x * v[j].x + v[j].y * v[j].y) + (v[j].z * v[j].z + v[j].w * v[j].w);
            const float r = __builtin_amdgcn_rsqf(wave_sum(ss) * (1.f / D) + RMS_EPS);
            const size_t hrow = perm ? (size_t)b * SEQ + (t & 63) * 64 + (t >> 6) : row;
#pragma unroll
            for (int j = 0; j < 8; ++j) { const f32x4 hv = v[j] * r * pb[j] + pc[j];
                u32x2 w; w.x = cvt_pk_bf16(hv.x, hv.y); w.y = cvt_pk_bf16(hv.z, hv.w);
                *(u32x2*)(Hout + hrow * D + j * 256 + lane * 4) = w; }
        }
    }
}

__global__ void __launch_bounds__(512, 2) fwd_megakernel(Args a) {
    extern __shared__ __attribute__((aligned(16))) unsigned char lds_raw[];
    LAS unsigned char* lds = (LAS unsigned char*)lds_raw;
    cg::grid_group grid = cg::this_grid();
    const int tid = threadIdx.x, lane = tid & 63, wave = __builtin_amdgcn_readfirstlane(tid >> 6);
    const int G = gridDim.x, bx = blockIdx.x;
    const int gw = bx * 8 + wave, NGW = G * 8;
    if (tid < 2) ((LAS unsigned*)(lds + LDS_BARST))[tid] = 0u;
    if (tid == 0) (void)xb_add(&((unsigned*)a.ws)[XB_XCNT(xb_xcc_id())], 1u);
    __syncthreads();
#define GRID_BAR() xcd_barrier((unsigned*)WSB, (volatile LAS unsigned*)(lds + LDS_BARST))
#define WSB ({ unsigned char* _w = a.ws; asm volatile("" : "+s"(_w)); _w; })
#define ADA ((float*)(WSB + WS_ADA))
#define ROPE ((float*)(WSB + WS_ROPE))
#define D1T ((bf16_t*)(WSB + WS_D1))
#define D2T ((bf16_t*)(WSB + WS_D2))
#define CS2 ((bf16_t*)(WSB + WS_CS2))
#define TWT ((f32x2*)(WSB + WS_TW))
#define Wqkv ((bf16_t*)(WSB + WS_WQKV))
#define Wo ((bf16_t*)(WSB + WS_WO))
#define Win ((bf16_t*)(WSB + WS_WIN))
#define Wout ((bf16_t*)(WSB + WS_WOUT))
#define Wgu ((bf16_t*)(WSB + WS_WGU))
#define Wdn ((bf16_t*)(WSB + WS_WDN))
#define HB ((bf16_t*)(WSB + WS_HB))
#define YB ((bf16_t*)(WSB + WS_YB))
#define Qb ((bf16_t*)(WSB + WS_Q))
#define Kb ((bf16_t*)(WSB + WS_K))
#define Vb ((bf16_t*)(WSB + WS_V))
#define Ob ((bf16_t*)(WSB + WS_O))
#define HID ((bf16_t*)(WSB + WS_HID))
#define Ub ((bf16_t*)(WSB + WS_U))
#define A2b ((bf16_t*)(WSB + WS_A2))
#define Xb ((bf16_t*)(WSB + WS_X))
#define Fb ((bf16_t*)(WSB + WS_F))
#define XR ((bf16_t*)(WSB + WS_XR))
#define XSLOT(e) ((unsigned long long*)(WSB + WS_SLOT) + (size_t)((e) & 1) * M * 8)
#define XCNT(e) ((unsigned*)(WSB + WS_XCNT) + (size_t)(e) * 64 * 64)
#define XTMO ((unsigned*)(WSB + WS_XTMO))
#define XLDS (lds + 131072)

    for (int rep0 = 0; rep0 < REP_P0; ++rep0) {
        LAS float* sl = (LAS float*)(lds + 69632);
        LAS float* red = (LAS float*)lds;
        if (bx < 192) {
            for (int i = tid; i < 5 * D; i += 512) { const float cv = (i < 4 * D) ? a.c[i] : a.c_ctx[i - 4 * D]; sl[i] = silu_f(cv); }
            __syncthreads();
            for (int it = bx; it < 192; it += G) {
                const int layer = it / 96, n0 = (it % 96) * 128;
                const float* wp = a.mod_w + (size_t)layer * D * 6 * D + (size_t)(wave * 256) * 6 * D + n0 + lane * 2;
                float ac[5][2];
#pragma unroll
                for (int r = 0; r < 5; ++r) { ac[r][0] = 0.f; ac[r][1] = 0.f; }
#pragma unroll 8
                for (int k = 0; k < 256; ++k) { const f32x2 w = *(const f32x2*)(wp + (size_t)k * 6 * D);
#pragma unroll
                    for (int r = 0; r < 5; ++r) { const float s = sl[r * D + wave * 256 + k]; ac[r][0] += s * w.x; ac[r][1] += s * w.y; } }
#pragma unroll
                for (int r = 0; r < 5; ++r) { red[(wave * 5 + r) * 128 + lane * 2] = ac[r][0]; red[(wave * 5 + r) * 128 + lane * 2 + 1] = ac[r][1]; }
                __syncthreads();
                for (int i = tid; i < 5 * 128; i += 512) { const int r = i >> 7, cc = i & 127; float s = a.mod_b[layer * 6 * D + n0 + cc];
#pragma unroll
                    for (int w = 0; w < 8; ++w) s += red[(w * 5 + r) * 128 + cc];
                    ADA[(size_t)(layer * 5 + r) * 6 * D + n0 + cc] = s; }
                __syncthreads();
            }
        }
        __syncthreads();
        LAS float* scr = (LAS float*)(lds + wave * 8704);
        constexpr int I_QKV = 32 * 192, I_SQ = 32 * 64, I_GU = 32 * 352, I_DN = 88 * 64;
        constexpr int NITEMS = I_QKV + 3 * I_SQ + 2 * I_GU + 2 * I_DN;
        for (int it = gw; it < NITEMS; it += NGW) {
            int r = it;
            if (r < I_QKV) { transpose_item(a.w_qkv, D, NQKV, NQKV, Wqkv, 1, scr, r, lane); continue; } r -= I_QKV;
            if (r < I_SQ) { transpose_item(a.w_o, D, D, D, Wo, 0, scr, r, lane); continue; } r -= I_SQ;
            if (r < I_SQ) { transpose_item(a.w_in, D, D, D, Win, 0, scr, r, lane); continue; } r -= I_SQ;
            if (r < I_SQ) { transpose_item(a.w_out, D, D, D, Wout, 0, scr, r, lane); continue; } r -= I_SQ;
            if (r < 2 * I_GU) { const int l = r / I_GU; transpose_item(a.w_gu + (size_t)l * D * NGU, D, NGU, NGU, Wgu + (size_t)l * NGU * D, 2, scr, r % I_GU, lane); continue; } r -= 2 * I_GU;
            { const int l = r / I_DN; transpose_item(a.w_dn + (size_t)l * FF * D, FF, D, D, Wdn + (size_t)l * D * FF, 0, scr, r % I_DN, lane); }
        }
        const int gt = bx * 512 + tid, NGT = G * 512;
        if (gt < 1024) { const int pos = gt >> 4, f = gt & 15; const float inv = powf(10000.f, -(float)f / 16.f); const float ang = (float)pos * inv;
            ROPE[gt] = cosf(ang); ROPE[1024 + gt] = sinf(ang); }
        for (int i = gt; i < 256 * 128; i += NGT) { const int m = i >> 7, k = i & 127, part = m >> 7, rp = (m >> 6) & 1, k1 = m & 63, rp2 = k >> 6, aa = k & 63;
            float sv, cv; sincospif((float)((k1 * aa) & 63) * (1.f / 32.f), &sv, &cv); const float v = (rp == rp2) ? (part ? -sv : cv) * 0.125f : 0.f;
            D1T[i] = (bf16_t)(cvt_pk_bf16(v, v) & 0xffffu); }
        for (int i = gt; i < 256 * 256; i += NGT) { const int m = i >> 8, k = i & 255, kp = m >> 7, po = (m >> 6) & 1, k2 = m & 63, kp2 = k >> 7, part = (k >> 6) & 1, rp = (k >> 5) & 1, r = 2 * (k & 31) + rp;
            float sv, cv; sincospif((float)((k2 * r) & 63) * (1.f / 32.f), &sv, &cv);
            const float v = (kp == kp2) ? (po == 0 ? (part == 0 ? cv : sv) : (part == 0 ? -sv : cv)) * 0.125f : 0.f;
            D2T[i] = (bf16_t)(cvt_pk_bf16(v, v) & 0xffffu); }
        for (int i = gt; i < 256 * 512; i += NGT) { const int kc = i >> 9, k = i & 511, part = k >> 8, cc = k & 255;
            float sv, cv; sincospif((float)((kc * cc) & 255) * (1.f / 128.f), &sv, &cv); const float v = (part ? sv : cv) * (1.f / 16.f);
            CS2[i] = (bf16_t)(cvt_pk_bf16(v, v) & 0xffffu); }
        for (int i = gt; i < 4096; i += NGT) { float sv, cv; sincospif((float)i * (1.f / 2048.f), &sv, &cv); TWT[i] = (f32x2){cv, sv}; }
    }
    grid.sync();

    for (int rs = 0; rs < REP_SYNC; ++rs) GRID_BAR();
    row_phase<false, true>(lane, gw, NGW, nullptr, a.x, nullptr, ADA, 0, nullptr, a.norm_g, 0, 1, HB, false);
    for (int row = M + gw; row < MT; row += NGW) { const float* ad = ADA + (size_t)4 * 6 * D;
        row_op(lane, nullptr, a.ctx + (size_t)(row - M) * D, nullptr, nullptr, nullptr, a.norm_g, ad, ad + D, HB + (size_t)row * D); }
    GRID_BAR();

    PH(0) { pg8::Gemm g{HB, Wqkv, D, D, D}; pg8::SchedQKV S{G, bx}; pg8::EpiQKV E{Qb, Kb, Vb, ROPE};
      pg8::gemm_phase(lds, g, S, E); }
    GRID_BAR();

    {
        if (tid < 128) ((LAS float*)(lds + att::SUBG))[tid] = a.subg[tid] * 0.8f;
        if (wave == 0) { const float p01 = wave_sum(a.lam[lane] * a.lam[64 + lane]), p23 = wave_sum(a.lam[128 + lane] * a.lam[192 + lane]);
            if (lane == 0) *(LAS float*)(lds + att::LAMO) = expf(p01) - expf(p23) + 0.2f; }
        __syncthreads();
        for (int rep = 0; rep < REP_ATT; ++rep)
        if (G == 256) { for (int i = 0; i < 8; ++i) { const int bh = (bx & 7) * 8 + i, qb = bx >> 3; att::attn_unit(bh >> 4, bh & 15, qb, Qb, Kb, Vb, Ob, lds); } }
        else { for (int u = bx; u < 2048; u += G) { const int bh = u >> 5, qb = u & 31; att::attn_unit(bh >> 4, bh & 15, qb, Qb, Kb, Vb, Ob, lds); } }
    }
    GRID_BAR();

    if (G == 256) {
        PH(1) { pg8::Gemm g{Ob, Wo, D, D, D}; pg8::SchedPanel S{bx, D, D};
            pg8::EpiNormRes<false, true, false> E{a.x, XR, nullptr, ADA + 2 * D, a.norm_g + D, HB, a.norm_g + 2 * D, ADA + 3 * D, ADA + 4 * D, false, {XSLOT(0), 1u, XTMO}, {XSLOT(1), 2u, XTMO}, XLDS};
            pg8::gemm_phase(lds, g, S, E); }
        GRID_BAR();
    } else {
        PH(1) { pg8::Gemm g{Ob, Wo, D, D, D}; pg8::SchedStd S{64, 8, G, bx, D, D, D}; pg8::EpiPlain E{YB, D}; pg8::gemm_phase(lds, g, S, E); }
        GRID_BAR();
        row_phase<true, true, false, true>(lane, gw, NGW, YB, a.x, XR, ADA, 2, a.norm_g + D, a.norm_g + 2 * D, 3, 4, HB, false);
        GRID_BAR();
    }

    for (int repg = 0; repg < REP_GU; ++repg)
    PH(2) { pg8::Gemm g{HB, Wgu, D, D, D}; pg8::SchedStd S{64, 44, G, bx, D, D, 0}; pg8::EpiSwiGLU E{HID}; pg8::gemm_phase(lds, g, S, E); }
    GRID_BAR();
    if (G == 256) {
        PH(3) { pg8::Gemm g{HID, Wdn, FF, FF, FF}; pg8::SchedPanel S{bx, FF, FF}; const float* ada1 = ADA + (size_t)5 * 6 * D;
            pg8::EpiNormRes<true, true, false> E{XR, XR, nullptr, ADA + 5 * D, a.norm_g + 3 * D, HB, a.norm_g + 4 * D, ada1, ada1 + D, true, {XSLOT(2), 3u, XTMO}, {XSLOT(3), 4u, XTMO}, XLDS};
            pg8::gemm_phase(lds, g, S, E); }
        GRID_BAR();
    } else {
        PH(3) { pg8::Gemm g{HID, Wdn, FF, FF, FF}; pg8::SchedStd S{64, 8, G, bx, FF, FF, D}; pg8::EpiPlain E{YB, D}; pg8::gemm_phase(lds, g, S, E); }
        GRID_BAR();
        row_phase<true, true, true, true>(lane, gw, NGW, YB, XR, XR, ADA, 5, a.norm_g + 3 * D, a.norm_g + 4 * D, 0, 1, HB, true, ADA + (size_t)5 * 6 * D);
        GRID_BAR();
    }

    PH(4) { pg8::Gemm g{Win, HB, D, D, D}; pg8::SchedInT S{G, bx}; pg8::EpiPlain E{Ub, SEQ}; pg8::gemm_phase(lds, g, S, E); }
    GRID_BAR();
    PH(5) { pg8::Gemm g{D1T, Ub, 128, 128, 128}; pg8::SchedCols S{G, bx, 1024, 128}; pg8::EpiFft1 E{A2b, TWT}; pg8::gemm_phase(lds, g, S, E); }
    GRID_BAR();
    PH(6) { pg8::Gemm g{D2T, A2b, 256, 256, 256}; pg8::SchedCols S{G, bx, 1024, 256}; pg8::EpiFft2 E{Xb}; pg8::gemm_phase(lds, g, S, E); }
    GRID_BAR();
    PH(10) { pg8::Gemm g{Xb, CS2, 4096, 512, 512}; pg8::SchedChan S{G, bx}; pg8::EpiPlain E{Fb, D}; pg8::gemm_phase(lds, g, S, E); }
    GRID_BAR();
    if (G == 256) {
        PH(7) { pg8::Gemm g{Fb, Wout, D, D, D}; pg8::SchedPanel S{bx, D, D}; const float* ada1 = ADA + (size_t)5 * 6 * D;
            pg8::EpiNormRes<true, true, false> E{XR, XR, nullptr, ada1 + 2 * D, a.norm_g + 5 * D, HB, a.norm_g + 6 * D, ada1 + 3 * D, ada1 + 4 * D, false, {XSLOT(4), 5u, XTMO}, {XSLOT(5), 6u, XTMO}, XLDS};
            pg8::gemm_phase(lds, g, S, E); }
        GRID_BAR();
    } else {
        PH(7) { pg8::Gemm g{Fb, Wout, D, D, D}; pg8::SchedStd S{64, 8, G, bx, D, D, D}; pg8::EpiPlain E{YB, D}; pg8::gemm_phase(lds, g, S, E); }
        GRID_BAR();
        row_phase<true, true, true, true>(lane, gw, NGW, YB, XR, XR, ADA + (size_t)5 * 6 * D, 2, a.norm_g + 5 * D, a.norm_g + 6 * D, 3, 4, HB, false);
        GRID_BAR();
    }

    PH(8) { pg8::Gemm g{HB, Wgu + (size_t)NGU * D, D, D, D}; pg8::SchedStd S{64, 44, G, bx, D, D, 0}; pg8::EpiSwiGLU E{HID}; pg8::gemm_phase(lds, g, S, E); }
    GRID_BAR();
    if (G == 256) {
        PH(9) { pg8::Gemm g{HID, Wdn + (size_t)D * FF, FF, FF, FF}; pg8::SchedPanel S{bx, FF, FF}; const float* ada1 = ADA + (size_t)5 * 6 * D;
            pg8::EpiNormRes<true, false, true> E{XR, nullptr, a.out, ada1 + 5 * D, a.norm_g + 7 * D, nullptr, nullptr, nullptr, nullptr, false, {XSLOT(6), 7u, XTMO}, {XSLOT(6), 7u, XTMO}, XLDS};
            pg8::gemm_phase(lds, g, S, E); }
    } else {
        PH(9) { pg8::Gemm g{HID, Wdn + (size_t)D * FF, FF, FF, FF}; pg8::SchedStd S{64, 8, G, bx, FF, FF, D}; pg8::EpiPlain E{YB, D}; pg8::gemm_phase(lds, g, S, E); }
        GRID_BAR();
        row_phase<true, false, true, false>(lane, gw, NGW, YB, XR, a.out, ADA + (size_t)5 * 6 * D, 5, a.norm_g + 7 * D, nullptr, 0, 0, nullptr, false);
    }
}

extern "C" void kernel_launch(void* const* d_in, const int* in_sizes, int n_in, void* d_out, int out_size, void* d_ws, size_t ws_size, hipStream_t stream) {
    static int grid = 0;
    if (grid == 0) {
        if (n_in != 15 || in_sizes[0] != M * D || out_size != M * D || ws_size < WS_END) {
            fprintf(stderr, "kernel_launch: unexpected shapes / workspace (n_in %d, in0 %d, out %d, ws %zu, need %zu)\n", n_in, n_in > 0 ? in_sizes[0] : -1, out_size, ws_size, (size_t)WS_END);
            grid = -1; return; }
        int dev = 0, cus = 0, per_cu = 0;
        hipGetDevice(&dev);
        hipDeviceGetAttribute(&cus, hipDeviceAttributeMultiprocessorCount, dev);
        if (hipFuncSetAttribute((const void*)fwd_megakernel, hipFuncAttributeMaxDynamicSharedMemorySize, LDS_BYTES) != hipSuccess) { fprintf(stderr, "kernel_launch: hipFuncSetAttribute failed\n"); grid = -1; return; }
        hipOccupancyMaxActiveBlocksPerMultiprocessor(&per_cu, (const void*)fwd_megakernel, 512, LDS_BYTES);
        if (per_cu < 1) { fprintf(stderr, "kernel_launch: occupancy query says %d blocks per CU\n", per_cu); per_cu = 1; }
        (void)hipGetLastError();
        grid = cus * 1;
    }
    if (grid < 0) return;
    if (hipMemsetAsync((unsigned char*)d_ws + WS_SLOT, 0, WS_SLOT_BYTES, stream) != hipSuccess) { fprintf(stderr, "kernel_launch: hipMemsetAsync of the exchange slots failed\n"); return; }
    if (hipMemsetAsync(d_ws, 0, WS_ZERO_BYTES, stream) != hipSuccess) { fprintf(stderr, "kernel_launch: hipMemsetAsync of the barrier words failed\n"); return; }
    Args a{};
    a.x = (const float*)d_in[0]; a.c = (const float*)d_in[1]; a.ctx = (const float*)d_in[2]; a.c_ctx = (const float*)d_in[3];
    a.mod_w = (const float*)d_in[4]; a.mod_b = (const float*)d_in[5]; a.norm_g = (const float*)d_in[6]; a.w_gu = (const float*)d_in[7]; a.w_dn = (const float*)d_in[8];
    a.w_qkv = (const float*)d_in[9]; a.w_o = (const float*)d_in[10]; a.lam = (const float*)d_in[11]; a.subg = (const float*)d_in[12]; a.w_in = (const float*)d_in[13]; a.w_out = (const float*)d_in[14];
    a.out = (float*)d_out; a.ws = (unsigned char*)d_ws;
    void* args[] = {&a};
    hipError_t e = hipLaunchCooperativeKernel((const void*)fwd_megakernel, dim3(grid), dim3(512), args, LDS_BYTES, stream);
    if (e != hipSuccess) fprintf(stderr, "cooperative launch failed: %s (grid %d)\n", hipGetErrorString(e), grid);
}
```
